# Optimizing an MI355X kernel written in HIP

```python
import math
import jax, jax.numpy as jnp
from jax import lax
import numpy as np

D_MODEL = 1024
BATCH = 8
SEQ = 2048
DEPTH = 1
DEC_BATCH = 128
DEC_SEQ = 1
PAST_LEN = 16384
PAGE_SIZE = 128

D_MIX = D_MODEL
D_GDN = D_MIX // 2
D_SGU = D_MIX - D_GDN
GDN_HEADS = 4
GDN_DK = D_GDN // GDN_HEADS
GDN_DV = D_GDN // GDN_HEADS
GDN_CHUNK = 64
CONV_W = 4
D_QKV = 3 * D_GDN
SGU_HEADS = 4
SGU_DH = D_SGU // SGU_HEADS
SGU_CHUNK = 128
D_FF = 4 * D_MODEL
D_PLE = 256
D_IN = D_QKV + D_GDN + 2 * GDN_HEADS + 2 * D_SGU
EPS = 1e-6

kernel_name = 'hybrid_gdn_chunkmlp_decode_step'


def rms_norm(x, gain):
    xf = x.astype(jnp.float32)
    y = xf * lax.rsqrt(jnp.mean(xf * xf, axis=-1, keepdims=True) + EPS)
    return (y * gain.astype(jnp.float32)).astype(x.dtype)


def layer_norm(x, gain, bias):
    xf = x.astype(jnp.float32)
    mu = jnp.mean(xf, axis=-1, keepdims=True)
    var = jnp.mean(jnp.square(xf - mu), axis=-1, keepdims=True)
    y = (xf - mu) * lax.rsqrt(var + EPS)
    return (y * gain.astype(jnp.float32) + bias.astype(jnp.float32)).astype(x.dtype)


def l2_normalize(x):
    return x * lax.rsqrt(jnp.sum(x * x, axis=-1, keepdims=True) + 1e-6)


def causal_short_conv(x, hist, w):
    l = x.shape[1]
    xx = jnp.concatenate([hist.astype(x.dtype), x], axis=1)
    y = sum(xx[:, j:j + l] * w[j] for j in range(CONV_W))
    return jax.nn.silu(y), xx[:, l:]


def gated_delta_chunked(q, k, v, g, beta, s0):
    b, l, h, dk = q.shape
    dv = v.shape[-1]
    c = GDN_CHUNK
    pad = (-l) % c
    n = (l + pad) // c

    def blocks4(t):
        t = jnp.pad(t, ((0, 0), (0, pad), (0, 0), (0, 0))).reshape(b, n, c, h, t.shape[-1])
        return jnp.transpose(t, (1, 0, 3, 2, 4))

    def blocks3(t):
        t = jnp.pad(t, ((0, 0), (0, pad), (0, 0))).reshape(b, n, c, h)
        return jnp.transpose(t, (1, 0, 3, 2))

    q = blocks4(q) * (dk ** -0.5)
    k = blocks4(k)
    v = blocks4(v)
    beta = blocks3(beta)
    gc = jnp.cumsum(blocks3(g), axis=-1)
    incl = jnp.tril(jnp.ones((c, c), bool))
    strict = jnp.tril(jnp.ones((c, c), bool), -1)
    decay = jnp.exp(jnp.where(incl, gc[..., :, None] - gc[..., None, :], -jnp.inf))
    kb = k * beta[..., None]
    a_mat = jnp.where(strict, jnp.einsum('nbhcd,nbhsd->nbhcs', kb, k) * decay, 0.0)
    lhs = a_mat + jnp.eye(c, dtype=a_mat.dtype)
    rhs = jnp.concatenate([v * beta[..., None], kb * jnp.exp(gc)[..., None]], axis=-1)
    sol = lax.linalg.triangular_solve(lhs, rhs, left_side=True, lower=True, unit_diagonal=True)
    u_wy = sol[..., :dv]
    w_wy = sol[..., dv:]
    attn = jnp.where(incl, jnp.einsum('nbhcd,nbhsd->nbhcs', q, k) * decay, 0.0)

    def step(s, inp):
        qi, ki, ui, wi, gi, ai = inp
        v_new = ui - jnp.einsum('bhcd,bhde->bhce', wi, s)
        o = (jnp.einsum('bhcd,bhde->bhce', qi * jnp.exp(gi)[..., None], s)
             + jnp.einsum('bhcs,bhse->bhce', ai, v_new))
        g_last = gi[..., -1]
        s = (s * jnp.exp(g_last)[..., None, None]
             + jnp.einsum('bhcd,bhce->bhde', ki * jnp.exp(g_last[..., None] - gi)[..., None], v_new))
        return s, o

    s_fin, o = lax.scan(step, s0, (q, k, u_wy, w_wy, gc, attn))
    o = jnp.transpose(o, (1, 0, 3, 2, 4)).reshape(b, n * c, h, dv)[:, :l]
    return o, s_fin


def chunk_spatial_gate(u, v, w_s, b_s):
    b, l, h, dh = u.shape
    c = SGU_CHUNK
    pad = (-l) % c
    n = (l + pad) // c
    vp = jnp.pad(v, ((0, 0), (0, pad), (0, 0), (0, 0))).reshape(b, n, c, h, dh)
    w = jnp.where(jnp.tril(jnp.ones((c, c), bool))[None], w_s, 0.0)
    mix = jnp.einsum('hts,bnshd->bnthd', w, vp) + jnp.transpose(b_s)[None, None, :, :, None]
    return u * mix.reshape(b, n * c, h, dh)[:, :l]


def hybrid_layer(x, p, conv_hist, s0, g_mix, w_in, w_conv, a_log, dt_bias, gdn_norm,
                 sgu_ln_g, sgu_ln_b, w_s, b_s, w_out, g_ff, w_up, w_down, g_ple, w_ple, w_ple_gate):
    bsz, l, _ = x.shape
    f32 = jnp.float32
    h = rms_norm(x, g_mix)
    proj = h @ w_in
    o0 = D_QKV
    o1 = o0 + D_GDN
    o2 = o1 + GDN_HEADS
    o3 = o2 + GDN_HEADS
    qkv, new_hist = causal_short_conv(proj[..., :o0], conv_hist, w_conv)
    qkv = qkv.astype(f32).reshape(bsz, l, 3, GDN_HEADS, GDN_DK)
    q = l2_normalize(qkv[:, :, 0])
    k = l2_normalize(qkv[:, :, 1])
    v = qkv[:, :, 2]
    z = proj[..., o0:o1].astype(f32).reshape(bsz, l, GDN_HEADS, GDN_DV)
    beta = jax.nn.sigmoid(proj[..., o1:o2].astype(f32))
    g = -jnp.exp(a_log.astype(f32)) * jax.nn.softplus(proj[..., o2:o3].astype(f32) + dt_bias.astype(f32))
    o, s_new = gated_delta_chunked(q, k, v, g, beta, s0.astype(f32))
    o = (rms_norm(o, gdn_norm) * jax.nn.silu(z)).astype(x.dtype).reshape(bsz, l, D_GDN)
    uv = jax.nn.gelu(proj[..., o3:])
    u = uv[..., :D_SGU]
    vg = layer_norm(uv[..., D_SGU:], sgu_ln_g, sgu_ln_b)
    sg = chunk_spatial_gate(u.reshape(bsz, l, SGU_HEADS, SGU_DH), vg.reshape(bsz, l, SGU_HEADS, SGU_DH),
                            w_s, b_s).reshape(bsz, l, D_SGU)
    x = x + jnp.concatenate([o, sg.astype(x.dtype)], axis=-1) @ w_out
    x = x + jnp.square(jax.nn.relu(rms_norm(x, g_ff) @ w_up)) @ w_down
    x = x + (p @ w_ple) * jax.nn.sigmoid(rms_norm(x, g_ple) @ w_ple_gate)
    return x, new_hist, s_new.astype(x.dtype), vg


def setup_inputs(seed: int = 0) -> dict:
    key = jax.random.key(seed)
    ks = jax.random.split(key, 32)
    nrm = lambda k, shape, scale: jax.random.normal(k, shape, jnp.float32) * scale
    gain = lambda k, shape: 1.0 + 0.02 * jax.random.normal(k, shape, jnp.float32)
    dt = jnp.exp(jax.random.uniform(ks[9], (DEPTH, GDN_HEADS), jnp.float32,
                                    minval=math.log(1e-3), maxval=math.log(1e-1)))
    return {
        'x_prompt': nrm(ks[0], (BATCH, SEQ, D_MODEL), 1.0),
        'x_sample': nrm(ks[1], (DEC_BATCH, DEC_SEQ, D_MODEL), 1.0),
        'state_conv': nrm(ks[2], (DEPTH, DEC_BATCH, CONV_W - 1, D_QKV), 1.0),
        'state_gdn': nrm(ks[3], (DEPTH, DEC_BATCH, GDN_HEADS, GDN_DK, GDN_DV), GDN_DK ** -0.5),
        'p_prompt': nrm(ks[4], (DEPTH, BATCH, SEQ, D_PLE), 1.0),
        'p_sample': nrm(ks[5], (DEPTH, DEC_BATCH, DEC_SEQ, D_PLE), 1.0),
        'g_mix': gain(ks[6], (DEPTH, D_MODEL)),
        'w_in': nrm(ks[7], (DEPTH, D_MODEL, D_IN), D_MODEL ** -0.5),
        'w_conv': nrm(ks[8], (DEPTH, CONV_W, D_QKV), CONV_W ** -0.5),
        'a_log': jnp.log(jax.random.uniform(ks[10], (DEPTH, GDN_HEADS), jnp.float32, minval=1.0, maxval=16.0)),
        'dt_bias': dt + jnp.log(-jnp.expm1(-dt)),
        'gdn_norm': gain(ks[11], (DEPTH, GDN_DV)),
        'sgu_ln_g': gain(ks[12], (DEPTH, D_SGU)),
        'sgu_ln_b': nrm(ks[13], (DEPTH, D_SGU), 0.02),
        'w_s': nrm(ks[14], (DEPTH, SGU_HEADS, SGU_CHUNK, SGU_CHUNK), SGU_CHUNK ** -0.5),
        'b_s': gain(ks[15], (DEPTH, SGU_HEADS, SGU_CHUNK)),
        'w_out': nrm(ks[16], (DEPTH, D_MIX, D_MODEL), D_MIX ** -0.5),
        'g_ff': gain(ks[17], (DEPTH, D_MODEL)),
        'w_up': nrm(ks[18], (DEPTH, D_MODEL, D_FF), D_MODEL ** -0.5),
        'w_down': nrm(ks[19], (DEPTH, D_FF, D_MODEL), D_FF ** -0.5),
        'g_ple': gain(ks[20], (DEPTH, D_MODEL)),
        'w_ple': nrm(ks[21], (DEPTH, D_PLE, D_MODEL), D_PLE ** -0.5),
        'w_ple_gate': nrm(ks[22], (DEPTH, D_MODEL, D_MODEL), D_MODEL ** -0.5),
        'g_final': gain(ks[23], (D_MODEL,)),
    }


def reference(x_prompt, x_sample, state_conv, state_gdn, p_prompt, p_sample, g_mix, w_in, w_conv,
              a_log, dt_bias, gdn_norm, sgu_ln_g, sgu_ln_b, w_s, b_s, w_out, g_ff, w_up, w_down,
              g_ple, w_ple, w_ple_gate, g_final):
    hp = x_prompt
    hs = x_sample
    bp = x_prompt.shape[0]
    zero_hist = jnp.zeros((bp, CONV_W - 1, D_QKV), x_prompt.dtype)
    zero_state = jnp.zeros((bp, GDN_HEADS, GDN_DK, GDN_DV), jnp.float32)
    conv_p, gdn_p, conv_s, gdn_s, v_s = [], [], [], [], []
    for i in range(DEPTH):
        lw = (g_mix[i], w_in[i], w_conv[i], a_log[i], dt_bias[i], gdn_norm[i], sgu_ln_g[i], sgu_ln_b[i],
              w_s[i], b_s[i], w_out[i], g_ff[i], w_up[i], w_down[i], g_ple[i], w_ple[i], w_ple_gate[i])
        hp, c_p, s_p, _ = hybrid_layer(hp, p_prompt[i], zero_hist, zero_state, *lw)
        hs, c_s, s_s, vg_s = hybrid_layer(hs, p_sample[i], state_conv[i], state_gdn[i], *lw)
        conv_p.append(c_p)
        gdn_p.append(s_p)
        conv_s.append(c_s)
        gdn_s.append(s_s)
        v_s.append(vg_s)
    y_prompt = rms_norm(hp, g_final)
    y_sample = rms_norm(hs, g_final)
    return (y_prompt, y_sample, jnp.stack(conv_p), jnp.stack(gdn_p), jnp.stack(conv_s), jnp.stack(gdn_s), jnp.stack(v_s))
```

```cpp
#include <hip/hip_runtime.h>
#include <cstdio>
#include <cstdint>
namespace pg8 {
#define PG8_LAS __attribute__((address_space(3)))
typedef unsigned short bf16_t;
typedef short bf16x8 __attribute__((ext_vector_type(8)));
typedef float f32x4 __attribute__((ext_vector_type(4)));
typedef unsigned u32x4 __attribute__((ext_vector_type(4)));
constexpr int BM = 256, BK = 64, HALF = 128, HTB = HALF * BK * 2  , STAGE_BYTES = 8 * HTB, NXCD = 8, WGM = 8;

__host__ __device__ __forceinline__ int lds_byte(int r, int c) { const int st = (r >> 4) * 2 + (c >> 5), rr = r & 15, cc = c & 31, ob = rr * 64 + cc * 2; return st * 1024 + (ob ^ (((ob >> 9) & 1) << 5)); }
__host__ __device__ __forceinline__ void stage_rc(int b, int& R, int& C) { const int st = b / 1024, sb = b % 1024, swz = sb ^ (((sb >> 9) & 1) << 5); R = (st >> 1) * 16 + swz / 64; C = (st & 1) * 32 + (swz % 64) / 2; }
__host__ __device__ __forceinline__ int perm32(int rho) { const int n = rho >> 4, i = rho & 15; return 8 * (i >> 2) + 4 * n + (i & 3); }

struct Unit { int pm, pn; };
struct Gemm { const bf16_t* A; const bf16_t* Bt; int M, N, K; };

struct StaticOrder {
    int nM, nN, nwg, G, c;
    __host__ __device__ void init(int M, int N, int G_, int c_) { nM = M / BM; nN = N / BM; nwg = nM * nN; G = G_; c = c_; }
    __host__ __device__ bool next(int i, Unit& u) const {
        const long L = (long)i * G + c; if (L >= nwg) return false;
        int wgid = (int)L; { const int q = nwg / NXCD, r = nwg % NXCD, xcd = wgid % NXCD, off = wgid / NXCD; wgid = (xcd < r ? xcd * (q + 1) : r * (q + 1) + (xcd - r) * q) + off; }
        const int nig = WGM * nN, gid = wgid / nig, fm = gid * WGM, gsz = (nM - fm) < WGM ? (nM - fm) : WGM;
        u.pm = fm + ((wgid % nig) % gsz); u.pn = (wgid % nig) / gsz; return true;
    }
    __device__ __forceinline__ void a_ready(const Unit&) const {}
    __device__ __forceinline__ void done(const Unit&) const {}
};

__device__ __forceinline__ unsigned cvt_pk_bf16(float lo, float hi) { unsigned r; asm volatile("v_cvt_pk_bf16_f32 %0, %1, %2" : "=v"(r) : "v"(lo), "v"(hi)); return r; }
template <class Epi, class Sched, bool ALIGN_EPI = false, bool SP2 = false>
__device__ __forceinline__ void gemm_phase(PG8_LAS unsigned char* lds, const Gemm g, const Sched& S, const Epi& E) {
    int tid_ = threadIdx.x; asm volatile("" : "+v"(tid_));
    const int tid = tid_, wid = __builtin_amdgcn_readfirstlane(tid >> 6), lane = tid & 63, wr = wid >> 2, wc = wid & 3, fr = lane & 15, fq = lane >> 4;
    const int K = g.K, nt = K / BK;
    unsigned voffA[2], voffB[2];
#pragma unroll
    for (int i = 0; i < 2; ++i) { int R, C; stage_rc(tid * 16 + i * 8192, R, C); const int Rb = Epi::PERM ? ((R & ~31) + perm32(R & 31)) : R;
        voffA[i] = (unsigned)(R * K + C) * 2u; voffB[i] = (unsigned)(Rb * K + C) * 2u; }
    const size_t kstep = (size_t)(BK * 2);
    const size_t hstep = (size_t)HALF * K * 2;
    const size_t tstep = 2 * hstep;
    const unsigned ldsw = (unsigned)wid * 1024u;
    const int aoff = lds_byte(wr * 64 + fr, fq * 8), boff = lds_byte(wc * 32 + fr, fq * 8);
#define PG8_SA(b, h) (((b) * 2 + (h)) * HTB)
#define PG8_SB(b, h) ((4 + (b) * 2 + (h)) * HTB)
#define PG8_STAGE(bufoff, gbase, voff) do { _Pragma("unroll") for (int _i = 0; _i < 2; ++_i) \
        __builtin_amdgcn_global_load_lds((const unsigned*)((const char*)(gbase) + (voff)[_i]), (PG8_LAS unsigned*)(lds + (bufoff) + ldsw + _i * 8192), 16, 0, 0); } while (0)
#define PG8_LDA(dst, b, h) do { _Pragma("unroll") for (int m = 0; m < 4; ++m) _Pragma("unroll") for (int k = 0; k < 2; ++k) dst[m][k] = *(const PG8_LAS bf16x8*)(lds + PG8_SA(b, h) + aoff + m * 2048 + k * 1024); } while (0)
#define PG8_LDB(dst, b, h) do { _Pragma("unroll") for (int n = 0; n < 2; ++n) _Pragma("unroll") for (int k = 0; k < 2; ++k) dst[n][k] = *(const PG8_LAS bf16x8*)(lds + PG8_SB(b, h) + boff + n * 2048 + k * 1024); } while (0)
#define PG8_MMA(ai, bj, At, Bt) do { __builtin_amdgcn_s_setprio(1); _Pragma("unroll") for (int m = 0; m < 4; ++m) _Pragma("unroll") for (int n = 0; n < 2; ++n) _Pragma("unroll") for (int k = 0; k < 2; ++k) \
        acc[ai][bj][m][n] = __builtin_amdgcn_mfma_f32_16x16x32_bf16(Bt[n][k], At[m][k], acc[ai][bj][m][n], 0, 0, 0); __builtin_amdgcn_s_setprio(0); } while (0)
#define PG8_WAIT_V(n) asm volatile("s_waitcnt vmcnt(" #n ")" ::: "memory")
#define PG8_WAIT_L(n) asm volatile("s_waitcnt lgkmcnt(" #n ")" ::: "memory")
#define PG8_BAR __builtin_amdgcn_s_barrier()
#define PG8_SCHED __builtin_amdgcn_sched_barrier(0)
    Unit cur, nxt; int ui = 0;
    if (!S.next(0, cur)) return;
    f32x4 acc[2][2][4][2];
#pragma unroll
    for (int a = 0; a < 2; ++a)
#pragma unroll
        for (int b = 0; b < 2; ++b)
#pragma unroll
            for (int m = 0; m < 4; ++m)
#pragma unroll
                for (int n = 0; n < 2; ++n) acc[a][b][m][n] = (f32x4){0.f, 0.f, 0.f, 0.f};
    bf16x8 At[4][2], B0[2][2], B1[2][2];
    const char* cA = (const char*)g.A + (size_t)cur.pm * tstep; const char* cB = (const char*)g.Bt + (size_t)cur.pn * tstep;
    S.a_ready(cur);
    if constexpr (SP2) {
        PG8_STAGE(PG8_SB(0, 0), cB, voffB); PG8_STAGE(PG8_SB(0, 1), cB + hstep, voffB); PG8_STAGE(PG8_SA(0, 0), cA, voffA); PG8_STAGE(PG8_SA(0, 1), cA + hstep, voffA);
        if (wr == 1) PG8_BAR;
        PG8_WAIT_V(2); PG8_BAR;
        PG8_STAGE(PG8_SB(1, 0), cB + kstep, voffB); PG8_STAGE(PG8_SA(1, 0), cA + kstep, voffA); PG8_STAGE(PG8_SB(1, 1), cB + hstep + kstep, voffB);
        PG8_WAIT_V(6); PG8_BAR;
    } else {
        PG8_STAGE(PG8_SB(0, 0), cB, voffB); PG8_STAGE(PG8_SA(0, 0), cA, voffA); PG8_STAGE(PG8_SB(0, 1), cB + hstep, voffB); PG8_STAGE(PG8_SA(0, 1), cA + hstep, voffA);
        if (wr == 1) PG8_BAR;
        PG8_WAIT_V(4); PG8_BAR;
        PG8_STAGE(PG8_SB(1, 0), cB + kstep, voffB); PG8_STAGE(PG8_SA(1, 0), cA + kstep, voffA); PG8_STAGE(PG8_SB(1, 1), cB + hstep + kstep, voffB);
        PG8_WAIT_V(6); PG8_BAR;
    }
    for (;;) {
        const bool has_next = S.next(ui + 1, nxt);
        const char* nA = has_next ? (const char*)g.A + (size_t)nxt.pm * tstep : cA; const char* nB = has_next ? (const char*)g.Bt + (size_t)nxt.pn * tstep : cB;
        for (int t = 0; t < nt; t += 2) {
            const bool last = (t == nt - 2);
            const char* a1 = cA + (size_t)(t + 1) * kstep;
            const char* a2 = last ? nA : cA + (size_t)(t + 2) * kstep; const char* b2 = last ? nB : cB + (size_t)(t + 2) * kstep;
            const char* a3 = a2 + kstep; const char* b3 = b2 + kstep;
            if (last && has_next) S.a_ready(nxt);
            if constexpr (SP2) {
            PG8_LDB(B0, 0, 0); PG8_LDB(B1, 0, 1); PG8_SCHED; PG8_LDA(At, 0, 0); PG8_STAGE(PG8_SA(1, 1), a1 + hstep, voffA);
            PG8_WAIT_V(8); PG8_WAIT_L(0); PG8_BAR; PG8_MMA(0, 0, At, B0); PG8_MMA(0, 1, At, B1); PG8_BAR; PG8_SCHED;
            PG8_LDA(At, 0, 1); PG8_STAGE(PG8_SB(0, 0), b2, voffB); PG8_STAGE(PG8_SB(0, 1), b2 + hstep, voffB); PG8_STAGE(PG8_SA(0, 0), a2, voffA);
            PG8_WAIT_V(8); PG8_WAIT_L(0); PG8_BAR; PG8_MMA(1, 0, At, B0); PG8_MMA(1, 1, At, B1); PG8_BAR; PG8_SCHED;
            PG8_LDB(B0, 1, 0); PG8_LDB(B1, 1, 1); PG8_SCHED; PG8_LDA(At, 1, 0); PG8_STAGE(PG8_SA(0, 1), a2 + hstep, voffA);
            PG8_WAIT_V(8); PG8_WAIT_L(0); PG8_BAR; PG8_MMA(0, 0, At, B0); PG8_MMA(0, 1, At, B1); PG8_BAR; PG8_SCHED;
            PG8_LDA(At, 1, 1); PG8_STAGE(PG8_SB(1, 0), b3, voffB); PG8_STAGE(PG8_SB(1, 1), b3 + hstep, voffB); PG8_STAGE(PG8_SA(1, 0), a3, voffA);
            PG8_WAIT_V(8); PG8_WAIT_L(0); PG8_BAR; PG8_MMA(1, 0, At, B0); PG8_MMA(1, 1, At, B1); PG8_BAR; PG8_SCHED;
            } else {
            PG8_LDB(B0, 0, 0); PG8_SCHED; PG8_LDA(At, 0, 0); PG8_STAGE(PG8_SA(1, 1), a1 + hstep, voffA);
            PG8_WAIT_L(8); PG8_BAR; PG8_WAIT_L(0); PG8_MMA(0, 0, At, B0); PG8_BAR; PG8_SCHED;
            PG8_LDB(B1, 0, 1); PG8_STAGE(PG8_SB(0, 0), b2, voffB);
            PG8_BAR; PG8_WAIT_L(0); PG8_MMA(0, 1, At, B1); PG8_BAR;
            PG8_LDA(At, 0, 1); PG8_STAGE(PG8_SA(0, 0), a2, voffA);
            PG8_BAR; PG8_WAIT_L(0); PG8_MMA(1, 0, At, B0); PG8_BAR; PG8_SCHED;
            PG8_STAGE(PG8_SB(0, 1), b2 + hstep, voffB);
            PG8_WAIT_V(6); PG8_BAR; PG8_MMA(1, 1, At, B1); PG8_BAR;
            PG8_LDB(B0, 1, 0); PG8_SCHED; PG8_LDA(At, 1, 0); PG8_STAGE(PG8_SA(0, 1), a2 + hstep, voffA);
            PG8_WAIT_L(8); PG8_BAR; PG8_WAIT_L(0); PG8_MMA(0, 0, At, B0); PG8_BAR; PG8_SCHED;
            PG8_LDB(B1, 1, 1); PG8_STAGE(PG8_SB(1, 0), b3, voffB);
            PG8_BAR; PG8_WAIT_L(0); PG8_MMA(0, 1, At, B1); PG8_BAR;
            PG8_LDA(At, 1, 1); PG8_STAGE(PG8_SA(1, 0), a3, voffA);
            PG8_BAR; PG8_WAIT_L(0); PG8_MMA(1, 0, At, B0); PG8_BAR; PG8_SCHED;
            PG8_STAGE(PG8_SB(1, 1), b3 + hstep, voffB);
            PG8_WAIT_V(6); PG8_BAR; PG8_MMA(1, 1, At, B1); PG8_BAR;
            }
        }
        if constexpr (ALIGN_EPI) { if (wr == 0) PG8_BAR; }
        if constexpr (!Epi::AFTER_DRAIN) { E(acc, cur, wr, wc, fr, fq); S.done(cur); }
        if (!has_next) break;
#pragma unroll
        for (int a = 0; a < 2; ++a)
#pragma unroll
            for (int b = 0; b < 2; ++b)
#pragma unroll
                for (int m = 0; m < 4; ++m)
#pragma unroll
                    for (int n = 0; n < 2; ++n) acc[a][b][m][n] = (f32x4){0.f, 0.f, 0.f, 0.f};
        cur = nxt; cA = nA; cB = nB; ++ui;
        if constexpr (ALIGN_EPI) { if (wr == 1) PG8_BAR; }
    }
    PG8_WAIT_V(0);
    if constexpr (!ALIGN_EPI) { if (wr == 0) PG8_BAR; }
    PG8_BAR;
    if constexpr (Epi::AFTER_DRAIN) { E.fused(acc, cur, wr, wc, fr, fq, lds, wid, lane); S.done(cur); }
#undef PG8_SA
#undef PG8_SB
#undef PG8_STAGE
#undef PG8_LDA
#undef PG8_LDB
#undef PG8_MMA
#undef PG8_WAIT_V
#undef PG8_WAIT_L
#undef PG8_BAR
#undef PG8_SCHED
}
}

#define LAS __attribute__((address_space(3)))
typedef unsigned short bf16;
typedef float f32x4 __attribute__((ext_vector_type(4)));
typedef short bf16x8 __attribute__((ext_vector_type(8)));
typedef unsigned u32x4 __attribute__((ext_vector_type(4)));
typedef unsigned u32x2 __attribute__((ext_vector_type(2)));
#define LDS_WAIT() asm volatile("s_waitcnt lgkmcnt(0)" ::: "memory")
#define VM_WAIT() asm volatile("s_waitcnt vmcnt(0)" ::: "memory")

constexpr int MPR = 16384, MSA = 128, MT = MPR + MSA, DM = 1024, NIN = 3072, FF = 4096, DPLE = 256, SRCN = 3080;
constexpr float EPS = 1e-6f, QSCALE = 0.08838834764831845f;
constexpr int LDS_BYTES = 147456;
constexpr size_t MiB = 1u << 20;
constexpr size_t WS_RS0 = 0, WS_BETA = 128 * 1024, WS_G = 448 * 1024, WS_WSB = 1 * MiB, WS_SS1 = 2 * MiB, WS_SS2 = 3 * MiB + 256 * 1024, WS_SS3 = 4 * MiB + 512 * 1024;
constexpr size_t WS_WIN = 6 * MiB, WS_WOUT = 12 * MiB, WS_WUP = 14 * MiB, WS_WDN = 22 * MiB, WS_WG = 30 * MiB, WS_WPLE = 32 * MiB;
constexpr size_t WS_PB = 33 * MiB, WS_XB = 42 * MiB, WS_MIX = 75 * MiB, WS_PROJ = 108 * MiB, WS_HID = 108 * MiB, WS_AT = 205 * MiB, WS_O = 213 * MiB, WS_DECF = 246 * MiB, WS_XBUF = 247 * MiB, WS_CTL = 255 * MiB;
constexpr size_t CTL_BYTES = 32768;
constexpr size_t O_Y = 0, O_NCP = 16908288, O_NGP = 16945152, O_NCS = 17469440, O_NGS = 18059264, O_NSV = 26447872;
constexpr size_t FR_W = 0, FR_QG = 8 * MiB, FR_KG = 16 * MiB, FR_U = 24 * MiB;

__device__ __forceinline__ unsigned f2bf(float f) { unsigned u = __builtin_bit_cast(unsigned, f); return (u + 0x7fffu + ((u >> 16) & 1u)) >> 16; }
typedef float f32x2_t_ __attribute__((ext_vector_type(2))); typedef __bf16 bf16x2_t_ __attribute__((ext_vector_type(2)));
__device__ __forceinline__ unsigned pk2(float lo, float hi) { const f32x2_t_ v = {lo, hi}; const bf16x2_t_ b = __builtin_convertvector(v, bf16x2_t_); return __builtin_bit_cast(unsigned, b); }
__device__ __forceinline__ float bflo(unsigned u) { return __builtin_bit_cast(float, u << 16); }
__device__ __forceinline__ float bfhi(unsigned u) { return __builtin_bit_cast(float, u & 0xffff0000u); }
__device__ __forceinline__ float bf2f(bf16 v) { return __builtin_bit_cast(float, (unsigned)v << 16); }
__device__ __forceinline__ float sigmoidf_(float x) { return __builtin_amdgcn_rcpf(1.f + __expf(-x)); }
__device__ __forceinline__ float siluf_(float x) { return x * __builtin_amdgcn_rcpf(1.f + __expf(-x)); }
__device__ __forceinline__ float geluf_(float x) { const float u = 1.5957691216057308f * (x + 0.044715f * x * x * x); return x * __builtin_amdgcn_rcpf(1.f + __expf(-u)); }
template <int CTRL, int ROWMASK> __device__ __forceinline__ float dpp_get(float v) { return __builtin_bit_cast(float, __builtin_amdgcn_update_dpp(0, __builtin_bit_cast(int, v), CTRL, ROWMASK, 0xF, false)); }
__device__ __forceinline__ float wave_sum(float v) {
    v += dpp_get<0xB1, 0xF>(v); v += dpp_get<0x4E, 0xF>(v); v += dpp_get<0x141, 0xF>(v); v += dpp_get<0x140, 0xF>(v);
    v += dpp_get<0x142, 0xA>(v); v += dpp_get<0x143, 0xC>(v);
    return __builtin_bit_cast(float, __builtin_amdgcn_readlane(__builtin_bit_cast(int, v), 63));
}
__device__ __forceinline__ f32x4 mfma16(bf16x8 a, bf16x8 b, f32x4 c) { return __builtin_amdgcn_mfma_f32_16x16x32_bf16(a, b, c, 0, 0, 0); }
__device__ __forceinline__ bf16x8 pack8(f32x4 a, f32x4 b) { u32x4 w; w.x = pk2(a.x, a.y); w.y = pk2(a.z, a.w); w.z = pk2(b.x, b.y); w.w = pk2(b.z, b.w); return __builtin_bit_cast(bf16x8, w); }

struct Params { const float* in[24]; float* out; unsigned char* ws; };

template <class F> struct EpiGen {
    static constexpr bool PERM = false, AFTER_DRAIN = false;
    F f;
    __device__ __forceinline__ void operator()(const pg8::f32x4 (&acc)[2][2][4][2], const pg8::Unit& u, int wr, int wc, int fr, int fq) const {
#pragma unroll
        for (int ai = 0; ai < 2; ++ai)
#pragma unroll
            for (int m = 0; m < 4; ++m) {
                const int row = u.pm * 256 + ai * 128 + wr * 64 + m * 16 + fr;
                const float ctx = f.rowctx(row); float ss = 0.f;
#pragma unroll
                for (int bj = 0; bj < 2; ++bj)
#pragma unroll
                    for (int n = 0; n < 2; ++n) ss += f(row, u.pn * 256 + bj * 128 + wc * 32 + n * 16 + 4 * fq, acc[ai][bj][m][n], ctx);
                if (F::STATS) { ss += __shfl_xor(ss, 16); ss += __shfl_xor(ss, 32); if (fq == 0) f.ss[(size_t)row * 16 + u.pn * 4 + wc] = ss; }
            }
    }
};
template <class F> struct EpiGen8 {
    static constexpr bool PERM = true, AFTER_DRAIN = false;
    F f;
    __device__ __forceinline__ void operator()(const pg8::f32x4 (&acc)[2][2][4][2], const pg8::Unit& u, int wr, int wc, int fr, int fq) const {
#pragma unroll
        for (int ai = 0; ai < 2; ++ai)
#pragma unroll
            for (int m = 0; m < 4; ++m) {
                const int row = u.pm * 256 + ai * 128 + wr * 64 + m * 16 + fr; const float ctx = f.rowctx(row); float ss = 0.f;
#pragma unroll
                for (int bj = 0; bj < 2; ++bj) ss += f.op8(row, u.pn * 256 + bj * 128 + wc * 32 + 8 * fq, acc[ai][bj][m][0], acc[ai][bj][m][1], ctx);
                if (F::STATS) { ss += __shfl_xor(ss, 16); ss += __shfl_xor(ss, 32); if (fq == 0) f.ss[(size_t)row * 16 + u.pn * 4 + wc] = ss; }
            }
    }
};
__device__ __forceinline__ float sum16(const float* p) { const f32x4 a = *(const f32x4*)p, b = *(const f32x4*)(p + 4), c = *(const f32x4*)(p + 8), d = *(const f32x4*)(p + 12);
    return ((a.x + a.y) + (a.z + a.w)) + ((b.x + b.y) + (b.z + b.w)) + ((c.x + c.y) + (c.z + c.w)) + ((d.x + d.y) + (d.z + d.w)); }
__device__ __forceinline__ void st_bf4(bf16* p, f32x4 v) { u32x2 w; w.x = pk2(v.x, v.y); w.y = pk2(v.z, v.w); *(u32x2*)p = w; }
__device__ __forceinline__ float dot4(f32x4 v) { return (v.x * v.x + v.y * v.y) + (v.z * v.z + v.w * v.w); }

struct F1 { static constexpr bool STATS = false; float* ss; const float* rs0; bf16* proj;
    __device__ __forceinline__ float rowctx(int row) const { return rs0[row]; }
    __device__ __forceinline__ float operator()(int row, int col, f32x4 a, float rs) const { f32x4 v = a * rs;
        if (col >= 2048) { v.x = geluf_(v.x); v.y = geluf_(v.y); v.z = geluf_(v.z); v.w = geluf_(v.w); }
        st_bf4(proj + (size_t)row * NIN + col, v); return 0.f; }
    __device__ __forceinline__ float op8(int row, int col, f32x4 a0, f32x4 a1, float rs) const { f32x4 v0 = a0 * rs, v1 = a1 * rs;
        if (col >= 2048) { v0.x = geluf_(v0.x); v0.y = geluf_(v0.y); v0.z = geluf_(v0.z); v0.w = geluf_(v0.w); v1.x = geluf_(v1.x); v1.y = geluf_(v1.y); v1.z = geluf_(v1.z); v1.w = geluf_(v1.w); }
        u32x4 w; w.x = pk2(v0.x, v0.y); w.y = pk2(v0.z, v0.w); w.z = pk2(v1.x, v1.y); w.w = pk2(v1.z, v1.w); *(u32x4*)(proj + (size_t)row * NIN + col) = w; return 0.f; } };
struct F2 { static constexpr bool STATS = true; float* ss; bf16* xb;
    __device__ __forceinline__ float rowctx(int) const { return 0.f; }
    __device__ __forceinline__ float operator()(int row, int col, f32x4 a, float) const { bf16* p = xb + (size_t)row * DM + col; const u32x2 r = *(const u32x2*)p;
        const f32x4 x = (f32x4){bflo(r.x) + a.x, bfhi(r.x) + a.y, bflo(r.y) + a.z, bfhi(r.y) + a.w}; st_bf4(p, x); return dot4(x); }
    __device__ __forceinline__ float op8(int row, int col, f32x4 a0, f32x4 a1, float) const { bf16* p = xb + (size_t)row * DM + col; const u32x4 r = *(const u32x4*)p;
        const f32x4 x0 = (f32x4){bflo(r.x) + a0.x, bfhi(r.x) + a0.y, bflo(r.y) + a0.z, bfhi(r.y) + a0.w}, x1 = (f32x4){bflo(r.z) + a1.x, bfhi(r.z) + a1.y, bflo(r.w) + a1.z, bfhi(r.w) + a1.w};
        u32x4 w; w.x = pk2(x0.x, x0.y); w.y = pk2(x0.z, x0.w); w.z = pk2(x1.x, x1.y); w.w = pk2(x1.z, x1.w); *(u32x4*)p = w; return dot4(x0) + dot4(x1); } };
struct F3 { static constexpr bool STATS = false; float* ss; const float* ss1; bf16* hid;
    __device__ __forceinline__ float rowctx(int row) const { return rsqrtf(sum16(ss1 + (size_t)row * 16) * (1.f / DM) + EPS); }
    __device__ __forceinline__ float operator()(int row, int col, f32x4 a, float rs) const { f32x4 v = a * rs; v.x = fmaxf(v.x, 0.f); v.y = fmaxf(v.y, 0.f); v.z = fmaxf(v.z, 0.f); v.w = fmaxf(v.w, 0.f);
        st_bf4(hid + (size_t)row * FF + col, v * v); return 0.f; }
    __device__ __forceinline__ float op8(int row, int col, f32x4 a0, f32x4 a1, float rs) const { f32x4 v0 = a0 * rs, v1 = a1 * rs;
        v0.x = fmaxf(v0.x, 0.f); v0.y = fmaxf(v0.y, 0.f); v0.z = fmaxf(v0.z, 0.f); v0.w = fmaxf(v0.w, 0.f); v1.x = fmaxf(v1.x, 0.f); v1.y = fmaxf(v1.y, 0.f); v1.z = fmaxf(v1.z, 0.f); v1.w = fmaxf(v1.w, 0.f);
        v0 = v0 * v0; v1 = v1 * v1; u32x4 w; w.x = pk2(v0.x, v0.y); w.y = pk2(v0.z, v0.w); w.z = pk2(v1.x, v1.y); w.w = pk2(v1.z, v1.w); *(u32x4*)(hid + (size_t)row * FF + col) = w; return 0.f; } };
struct F4 { static constexpr bool STATS = true; float* ss; bf16* xb;
    __device__ __forceinline__ float rowctx(int) const { return 0.f; }
    __device__ __forceinline__ float operator()(int row, int col, f32x4 a, float) const { bf16* p = xb + (size_t)row * DM + col; const u32x2 r = *(const u32x2*)p;
        const f32x4 x = (f32x4){bflo(r.x) + a.x, bfhi(r.x) + a.y, bflo(r.y) + a.z, bfhi(r.y) + a.w}; st_bf4(p, x); return dot4(x); }
    __device__ __forceinline__ float op8(int row, int col, f32x4 a0, f32x4 a1, float) const { bf16* p = xb + (size_t)row * DM + col; const u32x4 r = *(const u32x4*)p;
        const f32x4 x0 = (f32x4){bflo(r.x) + a0.x, bfhi(r.x) + a0.y, bflo(r.y) + a0.z, bfhi(r.y) + a0.w}, x1 = (f32x4){bflo(r.z) + a1.x, bfhi(r.z) + a1.y, bflo(r.w) + a1.z, bfhi(r.w) + a1.w};
        u32x4 w; w.x = pk2(x0.x, x0.y); w.y = pk2(x0.z, x0.w); w.z = pk2(x1.x, x1.y); w.w = pk2(x1.z, x1.w); *(u32x4*)p = w; return dot4(x0) + dot4(x1); } };
struct F5a { static constexpr bool STATS = false; float* ss; bf16* pp;
    __device__ __forceinline__ float rowctx(int) const { return 0.f; }
    __device__ __forceinline__ float operator()(int row, int col, f32x4 a, float) const { st_bf4(pp + (size_t)row * DM + col, a); return 0.f; }
    __device__ __forceinline__ float op8(int row, int col, f32x4 a0, f32x4 a1, float) const { u32x4 w; w.x = pk2(a0.x, a0.y); w.y = pk2(a0.z, a0.w); w.z = pk2(a1.x, a1.y); w.w = pk2(a1.z, a1.w);
        *(u32x4*)(pp + (size_t)row * DM + col) = w; return 0.f; } };
struct F5b { static constexpr bool STATS = true; float* ss; const float* ss2; const bf16* xb; const bf16* pp; bf16* x3;
    __device__ __forceinline__ float rowctx(int row) const { return rsqrtf(sum16(ss2 + (size_t)row * 16) * (1.f / DM) + EPS); }
    __device__ __forceinline__ float operator()(int row, int col, f32x4 a, float rs) const { const size_t o = (size_t)row * DM + col; const u32x2 pr = *(const u32x2*)(pp + o), xr = *(const u32x2*)(xb + o);
        f32x4 x; x.x = bflo(xr.x) + bflo(pr.x) * sigmoidf_(a.x * rs); x.y = bfhi(xr.x) + bfhi(pr.x) * sigmoidf_(a.y * rs); x.z = bflo(xr.y) + bflo(pr.y) * sigmoidf_(a.z * rs); x.w = bfhi(xr.y) + bfhi(pr.y) * sigmoidf_(a.w * rs);
        st_bf4(x3 + o, x); return dot4(x); } };

struct EpiFinal {
    static constexpr bool PERM = true, AFTER_DRAIN = true;
    const float* ss2; const bf16* xb; const bf16* pp; float* out; const float* gfin; unsigned* xbuf; unsigned* cnt;
    __device__ __forceinline__ void fused(pg8::f32x4 (&acc)[2][2][4][2], const pg8::Unit& u, int wr, int wc, int fr, int fq, LAS unsigned char* lds, int wid, int lane) const {
        LAS float* Pt = (LAS float*)lds; LAS float* St = (LAS float*)(lds + 4096);
#pragma unroll
        for (int ai = 0; ai < 2; ++ai)
#pragma unroll
            for (int m = 0; m < 4; ++m) {
                const int row_l = ai * 128 + wr * 64 + m * 16 + fr; const size_t row = (size_t)u.pm * 256 + row_l;
                const float rs = rsqrtf(sum16(ss2 + row * 16) * (1.f / DM) + EPS); float ss = 0.f;
#pragma unroll
                for (int bj = 0; bj < 2; ++bj) { const size_t o = row * DM + u.pn * 256 + bj * 128 + wc * 32 + 8 * fq; const u32x4 pr = *(const u32x4*)(pp + o), xr = *(const u32x4*)(xb + o);
                    const f32x4 a0 = acc[ai][bj][m][0], a1 = acc[ai][bj][m][1]; f32x4 x0, x1;
                    x0.x = bflo(xr.x) + bflo(pr.x) * sigmoidf_(a0.x * rs); x0.y = bfhi(xr.x) + bfhi(pr.x) * sigmoidf_(a0.y * rs); x0.z = bflo(xr.y) + bflo(pr.y) * sigmoidf_(a0.z * rs); x0.w = bfhi(xr.y) + bfhi(pr.y) * sigmoidf_(a0.w * rs);
                    x1.x = bflo(xr.z) + bflo(pr.z) * sigmoidf_(a1.x * rs); x1.y = bfhi(xr.z) + bfhi(pr.z) * sigmoidf_(a1.y * rs); x1.z = bflo(xr.w) + bflo(pr.w) * sigmoidf_(a1.z * rs); x1.w = bfhi(xr.w) + bfhi(pr.w) * sigmoidf_(a1.w * rs);
                    acc[ai][bj][m][0] = x0; acc[ai][bj][m][1] = x1; ss += dot4(x0) + dot4(x1); }
                ss += __shfl_xor(ss, 16); ss += __shfl_xor(ss, 32);
                if (fq == 0) Pt[row_l * 4 + wc] = ss;
            }
        asm volatile("s_waitcnt lgkmcnt(0)" ::: "memory"); __builtin_amdgcn_s_barrier(); asm volatile("" ::: "memory");
        const int rl = wid * 32 + (lane & 31);
        if (lane < 32) { const f32x4 p4 = *(const LAS f32x4*)(Pt + rl * 4); const float tot = (p4.x + p4.y) + (p4.z + p4.w);
            __hip_atomic_store(xbuf + ((size_t)u.pm * 256 + rl) * 4 + u.pn, __builtin_bit_cast(unsigned, tot), __ATOMIC_RELAXED, __HIP_MEMORY_SCOPE_AGENT); }
        asm volatile("s_waitcnt vmcnt(0)" ::: "memory");
        if (lane == 0) __hip_atomic_fetch_add(cnt + 64 * u.pm, 1u, __ATOMIC_RELAXED, __HIP_MEMORY_SCOPE_AGENT);
        if (wid == 0) {
            unsigned sp = 0;
            while ((unsigned)__builtin_amdgcn_readfirstlane(__hip_atomic_load(cnt + 64 * u.pm, __ATOMIC_RELAXED, __HIP_MEMORY_SCOPE_AGENT)) < 32u) { __builtin_amdgcn_s_sleep(2); if (++sp > (1u << 22)) break; }
            __builtin_amdgcn_fence(__ATOMIC_ACQUIRE, "agent");
        }
        asm volatile("s_waitcnt vmcnt(0) lgkmcnt(0)" ::: "memory"); __builtin_amdgcn_s_barrier(); asm volatile("" ::: "memory");
        if (lane < 32) { float t = 0.f;
#pragma unroll
            for (int k = 0; k < 4; ++k) t += __builtin_bit_cast(float, __hip_atomic_load(xbuf + ((size_t)u.pm * 256 + rl) * 4 + k, __ATOMIC_RELAXED, __HIP_MEMORY_SCOPE_AGENT));
            St[rl] = rsqrtf(t * (1.f / DM) + EPS); }
        asm volatile("s_waitcnt lgkmcnt(0)" ::: "memory"); __builtin_amdgcn_s_barrier(); asm volatile("" ::: "memory");
#pragma unroll
        for (int ai = 0; ai < 2; ++ai)
#pragma unroll
            for (int m = 0; m < 4; ++m) {
                const int row_l = ai * 128 + wr * 64 + m * 16 + fr; const size_t row = (size_t)u.pm * 256 + row_l; const float r = St[row_l];
#pragma unroll
                for (int bj = 0; bj < 2; ++bj)
#pragma unroll
                    for (int n = 0; n < 2; ++n) { const int col = u.pn * 256 + bj * 128 + wc * 32 + 8 * fq + 4 * n;
                        *(f32x4*)(out + row * DM + col) = acc[ai][bj][m][n] * r * *(const f32x4*)(gfin + col); }
            }
    }
};

template <int RT, int UNR, class F> __device__ __forceinline__ void small_gemm(const bf16* A, const bf16* Bt, int N, int K, const F& f, LAS unsigned char* lds, int bid, int G, int wave, int lane) {
    const int c = lane & 15, q = lane >> 4; constexpr int NMH = 8 / RT; const int ntask = NMH * (N >> 6); const int kw = K >> 3;
    LAS f32x4* red = (LAS f32x4*)lds;
    for (int t = bid; t < ntask; t += G) {
        const int mh = t % NMH, ns = t / NMH;
        const bf16* ap = A + (size_t)(mh * RT * 16 + c) * K + wave * kw + 8 * q;
        const bf16* bp = Bt + (size_t)(ns * 64 + c) * K + wave * kw + 8 * q;
        f32x4 acc[RT][4];
#pragma unroll
        for (int i = 0; i < RT; ++i)
#pragma unroll
            for (int j = 0; j < 4; ++j) acc[i][j] = (f32x4){0.f, 0.f, 0.f, 0.f};
#pragma unroll UNR
        for (int k = 0; k < kw; k += 32) {
            bf16x8 a[RT], b[4];
#pragma unroll
            for (int i = 0; i < RT; ++i) a[i] = *(const bf16x8*)(ap + (size_t)i * 16 * K + k);
#pragma unroll
            for (int j = 0; j < 4; ++j) b[j] = *(const bf16x8*)(bp + (size_t)j * 16 * K + k);
#pragma unroll
            for (int i = 0; i < RT; ++i)
#pragma unroll
                for (int j = 0; j < 4; ++j) acc[i][j] = mfma16(b[j], a[i], acc[i][j]);
        }
#pragma unroll
        for (int i = 0; i < RT; ++i)
#pragma unroll
            for (int j = 0; j < 4; ++j) red[(wave * (RT * 4) + i * 4 + j) * 64 + lane] = acc[i][j];
        __syncthreads();
        if (wave < RT) {
            const int i = wave; const int row = MPR + mh * RT * 16 + i * 16 + c; const float ctx = f.rowctx(row); float ss = 0.f;
#pragma unroll
            for (int j = 0; j < 4; ++j) { f32x4 s = red[(i * 4 + j) * 64 + lane];
#pragma unroll
                for (int w = 1; w < 8; ++w) s += red[(w * (RT * 4) + i * 4 + j) * 64 + lane];
                ss += f(row, ns * 64 + j * 16 + 4 * q, s, ctx); }
            if (F::STATS) { ss += __shfl_xor(ss, 16); ss += __shfl_xor(ss, 32); if (q == 0) f.ss[(size_t)row * 16 + ns] = ss; }
        }
        __syncthreads();
    }
}

__device__ __forceinline__ void tr_item(const float* __restrict__ W, int N, int src_c0, bf16* WT, int K, int dst_r0, const float* __restrict__ gain, LAS float* scr, int k0, int lane) {
    const float gv = gain ? gain[k0 + lane] : 1.f;
    f32x4 wv[8];
#pragma unroll
    for (int i = 0; i < 8; ++i) wv[i] = *(const f32x4*)(W + (size_t)(k0 + 8 * i + (lane >> 3)) * N + src_c0 + 4 * (lane & 7));
#pragma unroll
    for (int i = 0; i < 8; ++i) {
        float g = 0.f;
#pragma unroll
        for (int r = 0; r < 8; ++r) { const float gr = __builtin_bit_cast(float, __builtin_amdgcn_readlane(__builtin_bit_cast(int, gv), 8 * i + r)); g = ((lane >> 3) == r) ? gr : g; }
        LAS float* d = scr + (8 * i + (lane >> 3)) * 33 + 4 * (lane & 7);
        d[0] = wv[i].x * g; d[1] = wv[i].y * g; d[2] = wv[i].z * g; d[3] = wv[i].w * g;
    }
    LDS_WAIT();
    const int c = lane & 7;
#pragma unroll
    for (int j = 0; j < 4; ++j) { const int n = (lane >> 3) + 8 * j; const LAS float* s = scr + (8 * c) * 33 + n;
        u32x4 o; o.x = pk2(s[0], s[33]); o.y = pk2(s[66], s[99]); o.z = pk2(s[132], s[165]); o.w = pk2(s[198], s[231]);
        *(u32x4*)(WT + (size_t)(dst_r0 + n) * K + k0 + 8 * c) = o; }
    LDS_WAIT();
}

__device__ __forceinline__ void weight_items(const Params& P, LAS float* scr, int lane, int first, int last, int start, int stride) {
    unsigned char* ws = P.ws; const float* w_in = P.in[7]; const float* g_mix = P.in[6];
    for (int it = first + start; it < last; it += stride) {
        int r = it;
        if (r < 1536) { const int nb = r >> 4, kb = r & 15; tr_item(w_in, SRCN, nb * 32 + (nb >= 64 ? 8 : 0), (bf16*)(ws + WS_WIN), 1024, nb * 32, g_mix, scr, kb * 64, lane); continue; } r -= 1536;
        if (r < 512) { const int nb = r >> 4, kb = r & 15; tr_item(P.in[16], 1024, nb * 32, (bf16*)(ws + WS_WOUT), 1024, nb * 32, nullptr, scr, kb * 64, lane); continue; } r -= 512;
        if (r < 2048) { const int nb = r >> 4, kb = r & 15; tr_item(P.in[18], 4096, nb * 32, (bf16*)(ws + WS_WUP), 1024, nb * 32, P.in[17], scr, kb * 64, lane); continue; } r -= 2048;
        if (r < 2048) { const int nb = r >> 6, kb = r & 63; tr_item(P.in[19], 1024, nb * 32, (bf16*)(ws + WS_WDN), 4096, nb * 32, nullptr, scr, kb * 64, lane); continue; } r -= 2048;
        if (r < 512) { const int nb = r >> 4, kb = r & 15; tr_item(P.in[22], 1024, nb * 32, (bf16*)(ws + WS_WG), 1024, nb * 32, P.in[20], scr, kb * 64, lane); continue; } r -= 512;
        { const int nb = r >> 2, kb = r & 3; tr_item(P.in[21], 1024, nb * 32, (bf16*)(ws + WS_WPLE), 256, nb * 32, nullptr, scr, kb * 64, lane); }
    }
}

__device__ __forceinline__ void phase0(const Params& P, LAS unsigned char* lds, int tid, int lane, int wave, int bid, int G) {
    unsigned char* ws = P.ws; const int gw = bid * 8 + wave, NGW = G * 8, gt = bid * 512 + tid, NGT = G * 512;
    const float* w_in = P.in[7]; const float* g_mix = P.in[6];
    LAS f32x4* W8 = (LAS f32x4*)(lds + 67584);
    for (int idx = tid; idx < 2048; idx += 512) {
        const int l = idx & 63, half = (idx >> 6) & 1, je = idx >> 7; const int k = 256 * (je >> 2) + 4 * l + (je & 3);
        const float g = g_mix[k]; const float* s = w_in + (size_t)k * SRCN + 2048 + 4 * half;
        W8[idx] = (f32x4){s[0] * g, s[1] * g, s[2] * g, s[3] * g};
    }
    { const float* w_s = P.in[14]; bf16* WSB = (bf16*)(ws + WS_WSB);
      for (int i = gt; i < 65536; i += NGT) { const int t = (i >> 7) & 127, s = i & 127; WSB[i] = (bf16)f2bf(s <= t ? w_s[i] : 0.f); } }
    { bf16* PB = (bf16*)(ws + WS_PB); const float* pp = P.in[4]; const float* ps = P.in[5];
      for (int i = gt; i < MT * 32; i += NGT) { const int row = i >> 5, c8 = i & 31; const float* src = row < MPR ? pp + (size_t)row * DPLE + c8 * 8 : ps + (size_t)(row - MPR) * DPLE + c8 * 8;
          const f32x4 a = *(const f32x4*)src, b = *(const f32x4*)(src + 4); u32x4 o; o.x = pk2(a.x, a.y); o.y = pk2(a.z, a.w); o.z = pk2(b.x, b.y); o.w = pk2(b.z, b.w); *(u32x4*)(PB + (size_t)i * 8) = o; } }
    weight_items(P, (LAS float*)(lds + wave * 8448), lane, 0, 1536, gw, NGW);
    __syncthreads();
    float* RS0 = (float*)(ws + WS_RS0); float* BETA = (float*)(ws + WS_BETA); float* GG = (float*)(ws + WS_G); bf16* XB = (bf16*)(ws + WS_XB);
    const float* a_log = P.in[9]; const float* dt_bias = P.in[10];
    f32x4 vnx[4];
    { const int row = gw < MT ? gw : MT - 1; const float* xr = row < MPR ? P.in[0] + (size_t)row * DM : P.in[1] + (size_t)(row - MPR) * DM;
#pragma unroll
      for (int j = 0; j < 4; ++j) vnx[j] = *(const f32x4*)(xr + 256 * j + 4 * lane); }
    for (int row = gw; row < MT; row += NGW) {
        f32x4 v[4]; float ss = 0.f;
#pragma unroll
        for (int j = 0; j < 4; ++j) { v[j] = vnx[j]; ss += dot4(v[j]); }
        { const int rn = (row + NGW < MT) ? row + NGW : row; const float* xr = rn < MPR ? P.in[0] + (size_t)rn * DM : P.in[1] + (size_t)(rn - MPR) * DM;
#pragma unroll
          for (int j = 0; j < 4; ++j) vnx[j] = *(const f32x4*)(xr + 256 * j + 4 * lane); }
#pragma unroll
        for (int j = 0; j < 4; ++j) st_bf4(XB + (size_t)row * DM + 256 * j + 4 * lane, v[j]);
        f32x4 d0 = (f32x4){0.f, 0.f, 0.f, 0.f}, d1 = d0;
#pragma unroll
        for (int j = 0; j < 4; ++j)
#pragma unroll
            for (int e = 0; e < 4; ++e) { const float xv = v[j][e]; d0 += W8[((j * 4 + e) * 2 + 0) * 64 + lane] * xv; d1 += W8[((j * 4 + e) * 2 + 1) * 64 + lane] * xv; }
        const bool b0 = lane & 1, b1 = lane & 2, b2 = lane & 4;
        float t0 = (b0 ? d1.x : d0.x) + __shfl_xor(b0 ? d0.x : d1.x, 1), t1 = (b0 ? d1.y : d0.y) + __shfl_xor(b0 ? d0.y : d1.y, 1);
        float t2 = (b0 ? d1.z : d0.z) + __shfl_xor(b0 ? d0.z : d1.z, 1), t3 = (b0 ? d1.w : d0.w) + __shfl_xor(b0 ? d0.w : d1.w, 1);
        float u0 = (b1 ? t2 : t0) + __shfl_xor(b1 ? t0 : t2, 2), u1 = (b1 ? t3 : t1) + __shfl_xor(b1 ? t1 : t3, 2);
        float w = (b2 ? u1 : u0) + __shfl_xor(b2 ? u0 : u1, 4);
        w += __shfl_xor(w, 8); w += __shfl_xor(w, 16); w += __shfl_xor(w, 32);
        ss = wave_sum(ss); const float rs = rsqrtf(ss * (1.f / DM) + EPS);
        if (lane < 8) { const int hh = 2 * ((lane >> 1) & 1) + ((lane >> 2) & 1);
            if (!(lane & 1)) BETA[(size_t)row * 4 + hh] = sigmoidf_(w * rs);
            else { const float xa = w * rs + dt_bias[hh]; const float sp = fmaxf(xa, 0.f) + log1pf(expf(-fabsf(xa))); GG[(size_t)row * 4 + hh] = -expf(a_log[hh]) * sp; } }
        if (lane == 0) RS0[row] = rs;
    }
}

__device__ __forceinline__ void gdn_prep(const Params& P, LAS unsigned char* lds, int tid, int lane, int wave, int bid, int G) {
    unsigned char* ws = P.ws; const bf16* PROJ = (const bf16*)(ws + WS_PROJ); const float* BETA = (const float*)(ws + WS_BETA); const float* GG = (const float*)(ws + WS_G);
    bf16* FRB = (bf16*)P.out; bf16* ATf = (bf16*)(ws + WS_AT); float* DECF = (float*)(ws + WS_DECF); const float* wconv = P.in[8];
    const int tid0 = tid;
    for (int u0 = bid * 2; u0 < 1024; u0 += G * 2) {
        int tid = tid0; asm volatile("" : "+v"(tid));
        const int lane = tid & 63, wv = __builtin_amdgcn_readfirstlane(tid >> 6), hb = wv >> 2, t = tid & 255, w4 = wv & 3, c = lane & 15, q = lane >> 4;
        LAS unsigned char* base = lds + hb * 70656;
        LAS bf16* q_l = (LAS bf16*)base; LAS bf16* k_l = (LAS bf16*)(base + 17408); LAS bf16* v_l = (LAS bf16*)(base + 34816);
        LAS float* A_l = (LAS float*)(base + 52224); LAS float* gc = (LAS float*)(base + 69632); LAS float* bt = gc + 64;
        const int unit = u0 + hb, cg = unit >> 2, h = unit & 3, n = cg & 31; const int row0 = cg * 64, tokb = 16 * w4;
        float y[3][16][2];
#pragma unroll
        for (int g3 = 0; g3 < 3; ++g3) {
            const int col = g3 * 512 + h * 128 + 2 * lane;
            const float w0a = wconv[col], w0b = wconv[col + 1], w1a = wconv[1536 + col], w1b = wconv[1536 + col + 1], w2a = wconv[3072 + col], w2b = wconv[3072 + col + 1], w3a = wconv[4608 + col], w3b = wconv[4608 + col + 1];
            const bf16* src = PROJ + (size_t)(row0 + tokb) * NIN + col;
            unsigned raw[19];
            const bool nohist = (n == 0 && w4 == 0);
#pragma unroll
            for (int i = 0; i < 19; ++i) raw[i] = (i < 3 && nohist) ? 0u : *(const unsigned*)(src + (ptrdiff_t)(i - 3) * NIN);
#pragma unroll
            for (int i = 0; i < 16; ++i) {
                const float ya = w0a * bflo(raw[i]) + w1a * bflo(raw[i + 1]) + w2a * bflo(raw[i + 2]) + w3a * bflo(raw[i + 3]);
                const float yb = w0b * bfhi(raw[i]) + w1b * bfhi(raw[i + 1]) + w2b * bfhi(raw[i + 2]) + w3b * bfhi(raw[i + 3]);
                y[g3][i][0] = siluf_(ya); y[g3][i][1] = siluf_(yb);
            }
        }
#pragma unroll
        for (int g3 = 0; g3 < 2; ++g3)
#pragma unroll
            for (int i = 0; i < 16; ++i) { const float s = wave_sum(y[g3][i][0] * y[g3][i][0] + y[g3][i][1] * y[g3][i][1]); const float r = rsqrtf(s + 1e-6f); y[g3][i][0] *= r; y[g3][i][1] *= r; }
#pragma unroll
        for (int i = 0; i < 16; ++i) {
            *(LAS unsigned*)(q_l + (tokb + i) * 136 + 2 * lane) = pk2(y[0][i][0], y[0][i][1]);
            *(LAS unsigned*)(k_l + (tokb + i) * 136 + 2 * lane) = pk2(y[1][i][0], y[1][i][1]);
            *(LAS unsigned*)(v_l + (tokb + i) * 136 + 2 * lane) = pk2(y[2][i][0], y[2][i][1]);
        }
        if (w4 == 0) {
            int lane = tid; asm volatile("" : "+v"(lane)); lane &= 63;
            float g = GG[(size_t)(row0 + lane) * 4 + h];
#pragma unroll
            for (int o = 1; o < 64; o <<= 1) { const float tt = __shfl_up(g, o); if (lane >= o) g += tt; }
            gc[lane] = g; bt[lane] = BETA[(size_t)(row0 + lane) * 4 + h];
            const float dl = __expf(__shfl(g, 63));
            *(f32x4*)(DECF + (size_t)unit * 256 + lane * 4) = (f32x4){dl, dl, dl, dl};
        }
        __syncthreads();
        {
            const int it = w4; bf16x8 qf[4], kif[4];
#pragma unroll
            for (int kd = 0; kd < 4; ++kd) { qf[kd] = *(const LAS bf16x8*)(q_l + (16 * it + c) * 136 + 32 * kd + 8 * q); kif[kd] = *(const LAS bf16x8*)(k_l + (16 * it + c) * 136 + 32 * kd + 8 * q); }
            const int ii = 16 * it + c; const float gci = gc[ii];
            float atv[2][8];
#pragma unroll
            for (int jt = 0; jt < 4; ++jt) {
                if (jt <= it) {
                    f32x4 aq = (f32x4){0.f, 0.f, 0.f, 0.f}, ak = aq;
#pragma unroll
                    for (int kd = 0; kd < 4; ++kd) { const bf16x8 kjf = *(const LAS bf16x8*)(k_l + (16 * jt + c) * 136 + 32 * kd + 8 * q); aq = mfma16(kjf, qf[kd], aq); ak = mfma16(kif[kd], kjf, ak); }
                    const f32x4 gj = *(const LAS f32x4*)(gc + 16 * jt + 4 * q); f32x4 av;
                    const f32x4 gi4 = *(const LAS f32x4*)(gc + 16 * it + 4 * q), bi4 = *(const LAS f32x4*)(bt + 16 * it + 4 * q); const float gcj = gc[16 * jt + c];
#pragma unroll
                    for (int r = 0; r < 4; ++r) { const int j = 16 * jt + 4 * q + r; const float dec = (j <= ii) ? __expf(gci - gj[r]) : 0.f;
                        atv[jt >> 1][(jt & 1) * 4 + r] = aq[r] * dec * QSCALE;
                        const int i2 = 16 * it + 4 * q + r, j2 = 16 * jt + c; av[r] = (j2 < i2) ? ak[r] * bi4[r] * __expf(gi4[r] - gcj) : 0.f; }
                    *(LAS f32x4*)(A_l + (16 * jt + c) * 68 + 16 * it + 4 * q) = av;
                } else {
#pragma unroll
                    for (int r = 0; r < 4; ++r) atv[jt >> 1][(jt & 1) * 4 + r] = 0.f;
                }
            }
#pragma unroll
            for (int ks = 0; ks < 2; ++ks) { u32x4 o; o.x = pk2(atv[ks][0], atv[ks][1]); o.y = pk2(atv[ks][2], atv[ks][3]); o.z = pk2(atv[ks][4], atv[ks][5]); o.w = pk2(atv[ks][6], atv[ks][7]);
                *(u32x4*)(ATf + ((size_t)unit * 8 + it * 2 + ks) * 512 + lane * 8) = o; }
        }
        {
            const float gl = gc[63];
#pragma unroll
            for (int e = 0; e < 4; ++e) {
                const int f = w4 + 4 * e;
                { const int mt = f >> 2, ks = f & 3, tok = 16 * mt + c; const float sc = __expf(gc[tok]) * QSCALE;
                  const u32x2 lo = *(const LAS u32x2*)(q_l + tok * 136 + 32 * ks + 4 * q), hi = *(const LAS u32x2*)(q_l + tok * 136 + 32 * ks + 16 + 4 * q);
                  u32x4 o; o.x = pk2(bflo(lo.x) * sc, bfhi(lo.x) * sc); o.y = pk2(bflo(lo.y) * sc, bfhi(lo.y) * sc); o.z = pk2(bflo(hi.x) * sc, bfhi(hi.x) * sc); o.w = pk2(bflo(hi.y) * sc, bfhi(hi.y) * sc);
                  *(u32x4*)(FRB + FR_QG + (size_t)unit * 8192 + f * 512 + lane * 8) = o; }
                { const int mt = f >> 1, ks2 = f & 1; float kv[8];
#pragma unroll
                  for (int jj = 0; jj < 8; ++jj) { const int tok = 32 * ks2 + 16 * (jj >> 2) + 4 * q + (jj & 3); kv[jj] = bf2f(k_l[tok * 136 + 16 * mt + c]) * __expf(gl - gc[tok]); }
                  u32x4 o; o.x = pk2(kv[0], kv[1]); o.y = pk2(kv[2], kv[3]); o.z = pk2(kv[4], kv[5]); o.w = pk2(kv[6], kv[7]);
                  *(u32x4*)(FRB + FR_KG + (size_t)unit * 8192 + f * 512 + lane * 8) = o; }
            }
        }
        int t5 = t; asm volatile("" : "+v"(t5));
        const int col = t5 & 127, kind = __builtin_amdgcn_readfirstlane(t5 >> 7);
        float sol[64];
        {
            const LAS bf16* srcl = kind ? k_l : v_l;
#pragma unroll
            for (int i = 0; i < 64; ++i) { const float m = kind ? bt[i] * __expf(gc[i]) : bt[i]; sol[i] = bf2f(srcl[i * 136 + col]) * m; }
        }
        __syncthreads();
        {
#pragma unroll
            for (int j = 0; j < 63; ++j) {
                f32x4 avc[16];
#pragma unroll
                for (int v = (j + 1) >> 2; v < 16; ++v) avc[v] = *(const LAS f32x4*)(A_l + j * 68 + 4 * v);
                __builtin_amdgcn_sched_barrier(0);
                const float sj = sol[j];
#pragma unroll
                for (int v = (j + 1) >> 2; v < 16; ++v) { const f32x4 a = avc[v];
                    if (4 * v + 0 > j) sol[4 * v + 0] -= a.x * sj; if (4 * v + 1 > j) sol[4 * v + 1] -= a.y * sj; if (4 * v + 2 > j) sol[4 * v + 2] -= a.z * sj; if (4 * v + 3 > j) sol[4 * v + 3] -= a.w * sj; }
                __builtin_amdgcn_sched_barrier(0);
            }
        }
        {
            LAS bf16* dstl = kind ? k_l : v_l;
#pragma unroll
            for (int i = 0; i < 64; ++i) dstl[i * 136 + col] = (bf16)f2bf(sol[i]);
        }
        __syncthreads();
        { int l7 = tid; asm volatile("" : "+v"(l7)); const int c = l7 & 15, q = (l7 >> 4) & 3, lane = l7 & 63;
#pragma unroll
        for (int e = 0; e < 4; ++e) { const int f = w4 + 4 * e, mt = f >> 2, ks = f & 3, tok = 16 * mt + c;
            const u32x2 lo = *(const LAS u32x2*)(k_l + tok * 136 + 32 * ks + 4 * q), hi = *(const LAS u32x2*)(k_l + tok * 136 + 32 * ks + 16 + 4 * q);
            *(u32x4*)(FRB + FR_W + (size_t)unit * 8192 + f * 512 + lane * 8) = (u32x4){lo.x, lo.y, hi.x, hi.y}; }
#pragma unroll
        for (int e = 0; e < 8; ++e) { const int f = w4 + 4 * e, sl = f >> 2, mt = f & 3; const LAS bf16* s = v_l + (16 * mt + 4 * q) * 136 + 16 * sl + c;
            u32x2 o; o.x = (unsigned)s[0] | ((unsigned)s[136] << 16); o.y = (unsigned)s[272] | ((unsigned)s[408] << 16);
            *(u32x2*)(FRB + FR_U + ((size_t)unit * 32 + f) * 256 + lane * 4) = o; }
        }
        __syncthreads();
    }
}

__device__ __forceinline__ void sgu_prompt(const Params& P, LAS unsigned char* lds, int tid, int lane, int wave, int bid, int G) {
    asm volatile("" : "+v"(tid)); lane = tid & 63;
    unsigned char* ws = P.ws; const bf16* PROJ = (const bf16*)(ws + WS_PROJ); bf16* MIX = (bf16*)(ws + WS_MIX); const bf16* WSB = (const bf16*)(ws + WS_WSB);
    const float* lng = P.in[12]; const float* lnb = P.in[13]; const float* b_s = P.in[15];
    LAS bf16* vgT = (LAS bf16*)lds; const int c = lane & 15, q = lane >> 4;
    float lg[8], lb[8];
#pragma unroll
    for (int e = 0; e < 8; ++e) { lg[e] = lng[8 * lane + e]; lb[e] = lnb[8 * lane + e]; }
    for (int su = bid; su < 256; su += G) {
        const int b = su >> 5, n = (su >> 1) & 15, hp = su & 1; const int row0 = b * 2048 + n * 128;
        u32x4 rawv[16];
#pragma unroll
        for (int i = 0; i < 16; ++i) rawv[i] = *(const u32x4*)(PROJ + (size_t)(row0 + 16 * wave + i) * NIN + 2560 + 8 * lane);
        unsigned pkv[8][8];
#pragma unroll
        for (int i2 = 0; i2 < 8; ++i2) {
            float xa[8], xb2[8];
#pragma unroll
            for (int hh = 0; hh < 2; ++hh) {
                const u32x4 raw = rawv[2 * i2 + hh];
                float x[8] = {bflo(raw.x), bfhi(raw.x), bflo(raw.y), bfhi(raw.y), bflo(raw.z), bfhi(raw.z), bflo(raw.w), bfhi(raw.w)};
                float s = 0.f;
#pragma unroll
                for (int e = 0; e < 8; ++e) s += x[e];
                const float mean = wave_sum(s) * (1.f / 512.f); float s2 = 0.f;
#pragma unroll
                for (int e = 0; e < 8; ++e) { x[e] -= mean; s2 += x[e] * x[e]; }
                const float rstd = rsqrtf(wave_sum(s2) * (1.f / 512.f) + EPS);
#pragma unroll
                for (int e = 0; e < 8; ++e) { const float vn_ = x[e] * rstd * lg[e] + lb[e]; if (hh == 0) xa[e] = vn_; else xb2[e] = vn_; }
            }
#pragma unroll
            for (int e = 0; e < 8; ++e) pkv[e][i2] = pk2(xa[e], xb2[e]);
        }
        if ((q >> 1) == hp) {
#pragma unroll
            for (int e = 0; e < 8; ++e) {
                LAS bf16* rowp = vgT + (q & 1) * 17408 + (8 * c + e) * 136;
                *(LAS u32x4*)(rowp + 8 * ((2 * wave) ^ c)) = (u32x4){pkv[e][0], pkv[e][1], pkv[e][2], pkv[e][3]};
                *(LAS u32x4*)(rowp + 8 * ((2 * wave + 1) ^ c)) = (u32x4){pkv[e][4], pkv[e][5], pkv[e][6], pkv[e][7]};
            }
        }
        __syncthreads();
#pragma unroll 1
        for (int hh = 0; hh < 2; ++hh) { const int h = 2 * hp + hh; const LAS bf16* vgh = vgT + hh * 17408;
        f32x4 acc[8]; u32x2 upre[8]; const float bias_pre = b_s[h * 128 + 16 * wave + c];
#pragma unroll
        for (int nt = 0; nt < 8; ++nt) { acc[nt] = (f32x4){0.f, 0.f, 0.f, 0.f}; upre[nt] = *(const u32x2*)(PROJ + ((size_t)row0 + 16 * wave + c) * NIN + 2048 + h * 128 + 16 * nt + 4 * q); }
        for (int ks = 0; ks <= (wave >> 1); ++ks) {
            const bf16x8 bfr = *(const bf16x8*)(WSB + (size_t)(h * 128 + 16 * wave + c) * 128 + 32 * ks + 8 * q);
#pragma unroll
            for (int nt = 0; nt < 8; ++nt) { const int d = 16 * nt + c; const bf16x8 afr = *(const LAS bf16x8*)(vgh + d * 136 + 8 * ((4 * ks + q) ^ ((d >> 3) & 15))); acc[nt] = mfma16(afr, bfr, acc[nt]); }
        }
        { const int tt = 16 * wave + c; const size_t row = (size_t)row0 + tt; const float bias = bias_pre;
#pragma unroll
          for (int nt = 0; nt < 8; ++nt) { const int d0 = 16 * nt + 4 * q; const u32x2 ur = upre[nt];
              f32x4 o; o.x = bflo(ur.x) * (acc[nt].x + bias); o.y = bfhi(ur.x) * (acc[nt].y + bias); o.z = bflo(ur.y) * (acc[nt].z + bias); o.w = bfhi(ur.y) * (acc[nt].w + bias);
              st_bf4(MIX + row * DM + 512 + h * 128 + d0, o); } }
        }
        __syncthreads();
    }
}

__device__ __forceinline__ void sample_gdn(const Params& P, LAS unsigned char* lds, int tid, int lane, int wave, int bid, int G) {
    asm volatile("" : "+v"(tid)); lane = tid & 63;
    unsigned char* ws = P.ws; const bf16* PROJ = (const bf16*)(ws + WS_PROJ); bf16* MIX = (bf16*)(ws + WS_MIX); const float* BETA = (const float*)(ws + WS_BETA); const float* GG = (const float*)(ws + WS_G);
    const float* sconv = P.in[2]; const float* sgdn = P.in[3]; const float* wconv = P.in[8]; const float* gnorm = P.in[11];
    float* NCS = P.out + O_NCS; float* NGS = P.out + O_NGS;
    LAS float* sm = (LAS float*)lds; LAS float* scal = sm + 384; LAS f32x4* red = (LAS f32x4*)(sm + 512);
    const int dv4 = tid & 31, dkg = tid >> 5;
    for (int su = bid; su < 512; su += G) {
        const int bs = su >> 2, h = su & 3; const size_t srow = (size_t)MPR + bs;
        const float* S0 = sgdn + (size_t)(bs * 4 + h) * 16384 + (size_t)(8 * dkg) * 128 + 4 * dv4;
        f32x4 s0[8];
#pragma unroll
        for (int i = 0; i < 8; ++i) s0[i] = *(const f32x4*)(S0 + (size_t)i * 128);
        if (tid < 384) { const int g3 = tid >> 7, ch = tid & 127, col = g3 * 512 + h * 128 + ch;
            const float x = bf2f(PROJ[srow * NIN + col]); const float h0 = sconv[(size_t)(bs * 3 + 0) * 1536 + col], h1 = sconv[(size_t)(bs * 3 + 1) * 1536 + col], h2 = sconv[(size_t)(bs * 3 + 2) * 1536 + col];
            const float yv = siluf_(wconv[col] * h0 + wconv[1536 + col] * h1 + wconv[3072 + col] * h2 + wconv[4608 + col] * x);
            NCS[(size_t)(bs * 3 + 0) * 1536 + col] = h1; NCS[(size_t)(bs * 3 + 1) * 1536 + col] = h2; NCS[(size_t)(bs * 3 + 2) * 1536 + col] = x;
            sm[g3 * 128 + ch] = yv; }
        __syncthreads();
        if (wave < 2) { const float a = sm[wave * 128 + lane], b2 = sm[wave * 128 + 64 + lane]; const float s = wave_sum(a * a + b2 * b2); if (lane == 0) scal[wave] = rsqrtf(s + 1e-6f); }
        __syncthreads();
        const float qn = scal[0], kn = scal[1];
        const float beta = BETA[srow * 4 + h], eg = __expf(GG[srow * 4 + h]);
        float kk[8], qq[8]; f32x4 p = (f32x4){0.f, 0.f, 0.f, 0.f};
#pragma unroll
        for (int i = 0; i < 8; ++i) { kk[i] = sm[128 + 8 * dkg + i] * kn; qq[i] = sm[8 * dkg + i] * qn; p += s0[i] * kk[i]; }
        red[dkg * 32 + dv4] = p;
        __syncthreads();
        f32x4 kS = red[dv4];
#pragma unroll
        for (int g = 1; g < 16; ++g) kS += red[g * 32 + dv4];
        const f32x4 v4 = *(const LAS f32x4*)(sm + 256 + 4 * dv4); const f32x4 vnew = (v4 - kS * eg) * beta;
        __syncthreads();
        f32x4 po = (f32x4){0.f, 0.f, 0.f, 0.f}; float* S1 = NGS + (size_t)(bs * 4 + h) * 16384 + (size_t)(8 * dkg) * 128 + 4 * dv4;
#pragma unroll
        for (int i = 0; i < 8; ++i) { const f32x4 s1 = s0[i] * eg + vnew * kk[i]; *(f32x4*)(S1 + (size_t)i * 128) = s1; po += s1 * qq[i]; }
        red[dkg * 32 + dv4] = po;
        __syncthreads();
        if (tid < 32) { f32x4 o = red[dv4];
#pragma unroll
            for (int g = 1; g < 16; ++g) o += red[g * 32 + dv4];
            o = o * QSCALE; float s = dot4(o); s += __shfl_xor(s, 1); s += __shfl_xor(s, 2); s += __shfl_xor(s, 4); s += __shfl_xor(s, 8); s += __shfl_xor(s, 16);
            const float rs = rsqrtf(s * (1.f / 128.f) + EPS); const u32x2 zr = *(const u32x2*)(PROJ + srow * NIN + 1536 + h * 128 + 4 * dv4); const f32x4 gn = *(const f32x4*)(gnorm + 4 * dv4);
            f32x4 m; m.x = o.x * rs * gn.x * siluf_(bflo(zr.x)); m.y = o.y * rs * gn.y * siluf_(bfhi(zr.x)); m.z = o.z * rs * gn.z * siluf_(bflo(zr.y)); m.w = o.w * rs * gn.w * siluf_(bfhi(zr.y));
            st_bf4(MIX + srow * DM + h * 128 + 4 * dv4, m); }
        __syncthreads();
    }
}

__device__ __forceinline__ void phase2_misc(const Params& P, int tid, int lane, int wave, int bid, int G) {
    unsigned char* ws = P.ws; const bf16* PROJ = (const bf16*)(ws + WS_PROJ); bf16* MIX = (bf16*)(ws + WS_MIX);
    { float* NCP = P.out + O_NCP; for (int i = bid * 512 + tid; i < 36864; i += G * 512) { const int b = i / 4608, rem = i - b * 4608, j = rem / 1536, col = rem - j * 1536; NCP[i] = bf2f(PROJ[(size_t)(b * 2048 + 2045 + j) * NIN + col]); } }
    const int gw = bid * 8 + wave;
    if (gw < MSA) { const int bs = gw; const size_t srow = (size_t)MPR + bs; const float* lng = P.in[12]; const float* lnb = P.in[13]; float* NSV = P.out + O_NSV;
        const u32x4 raw = *(const u32x4*)(PROJ + srow * NIN + 2560 + 8 * lane); const u32x4 uraw = *(const u32x4*)(PROJ + srow * NIN + 2048 + 8 * lane);
        float x[8] = {bflo(raw.x), bfhi(raw.x), bflo(raw.y), bfhi(raw.y), bflo(raw.z), bfhi(raw.z), bflo(raw.w), bfhi(raw.w)};
        const float uu[8] = {bflo(uraw.x), bfhi(uraw.x), bflo(uraw.y), bfhi(uraw.y), bflo(uraw.z), bfhi(uraw.z), bflo(uraw.w), bfhi(uraw.w)};
        float s = 0.f;
#pragma unroll
        for (int e = 0; e < 8; ++e) s += x[e];
        const float mean = wave_sum(s) * (1.f / 512.f); float s2 = 0.f;
#pragma unroll
        for (int e = 0; e < 8; ++e) { x[e] -= mean; s2 += x[e] * x[e]; }
        const float rstd = rsqrtf(wave_sum(s2) * (1.f / 512.f) + EPS); const int h = lane >> 4; const float w00 = P.in[14][(size_t)h * 16384], b0 = P.in[15][h * 128];
        float vg[8], sg[8];
#pragma unroll
        for (int e = 0; e < 8; ++e) { vg[e] = x[e] * rstd * lng[8 * lane + e] + lnb[8 * lane + e]; sg[e] = uu[e] * (w00 * vg[e] + b0); }
        *(f32x4*)(NSV + (size_t)bs * 512 + 8 * lane) = (f32x4){vg[0], vg[1], vg[2], vg[3]}; *(f32x4*)(NSV + (size_t)bs * 512 + 8 * lane + 4) = (f32x4){vg[4], vg[5], vg[6], vg[7]};
        u32x4 o; o.x = pk2(sg[0], sg[1]); o.y = pk2(sg[2], sg[3]); o.z = pk2(sg[4], sg[5]); o.w = pk2(sg[6], sg[7]); *(u32x4*)(MIX + srow * DM + 512 + 8 * lane) = o; }
}

constexpr int ST_BYTES = 60416;
__device__ __forceinline__ void glds16(const void* g, LAS unsigned char* l) { __builtin_amdgcn_global_load_lds((const unsigned*)g, (LAS unsigned*)l, 16, 0, 0); }
__device__ __forceinline__ void scan_issue1(const bf16* FRB, const bf16* ATf, const float* DECF, int unit, int sl, LAS unsigned char* L, int lane) {
    const bf16* w = FRB + FR_W + (size_t)unit * 8192 + lane * 8; const bf16* at = ATf + (size_t)unit * 4096 + lane * 8; const bf16* uu = FRB + FR_U + ((size_t)unit * 8 + sl) * 1024 + lane * 8;
#pragma unroll
    for (int f = 0; f < 16; ++f) glds16(w + f * 512, L + f * 1024);
#pragma unroll
    for (int f = 0; f < 8; ++f) glds16(at + f * 512, L + 49152 + f * 1024);
    glds16(uu, L + 57344); glds16(uu + 512, L + 58368);
    glds16(DECF + (size_t)unit * 256 + lane * 4, L + 59392);
}
__device__ __forceinline__ void scan_issue2(const bf16* FRB, int unit, LAS unsigned char* L, int lane) {
    const bf16* qg = FRB + FR_QG + (size_t)unit * 8192 + lane * 8; const bf16* kg = FRB + FR_KG + (size_t)unit * 8192 + lane * 8;
#pragma unroll
    for (int f = 0; f < 16; ++f) glds16(qg + f * 512, L + 16384 + f * 1024);
#pragma unroll
    for (int f = 0; f < 16; ++f) glds16(kg + f * 512, L + 32768 + f * 1024);
}
__device__ __forceinline__ void gdn_scan(const Params& P, LAS unsigned char* lds, volatile LAS unsigned* flg, int lane, int wave, int bid, int G) {
    if (wave > 2) return;
    if (wave == 0) __builtin_amdgcn_s_setprio(3); else __builtin_amdgcn_s_setprio(2);
    asm volatile("" : "+v"(lane));
    unsigned char* ws = P.ws; const bf16* FRB = (const bf16*)P.out; const bf16* ATf = (const bf16*)(ws + WS_AT); const float* DECF = (const float*)(ws + WS_DECF);
    bf16* O = (bf16*)(ws + WS_O); float* NGP = P.out + O_NGP; const int c = lane & 15, q = lane >> 4;
    int gs = 0;
    for (int job = bid; job < 256; job += G, gs += 32) {
        const int bh = (job & 7) + 8 * (job >> 6), sl = (job >> 3) & 7, b = bh >> 2, h = bh & 3;
        if (wave != 0) {
            for (int n = 0; n < 32; ++n) {
                const int s_ = gs + n; LAS unsigned char* L = lds + (s_ & 1) * ST_BYTES;
                while ((int)flg[0] < s_ - 1) __builtin_amdgcn_s_sleep(1);
                asm volatile("" ::: "memory");
                if (wave == 1) scan_issue1(FRB, ATf, DECF, (b * 32 + n) * 4 + h, sl, L, lane); else scan_issue2(FRB, (b * 32 + n) * 4 + h, L, lane);
                asm volatile("s_waitcnt vmcnt(0)" ::: "memory");
                if (lane == 0) flg[wave] = (unsigned)(s_ + 1);
                asm volatile("s_waitcnt lgkmcnt(0)" ::: "memory");
            }
            continue;
        }
        f32x4 S[8];
#pragma unroll
        for (int i = 0; i < 8; ++i) S[i] = (f32x4){0.f, 0.f, 0.f, 0.f};
        for (int n = 0; n < 32; ++n) {
            const int s_ = gs + n; LAS unsigned char* L = lds + (s_ & 1) * ST_BYTES;
            while ((int)flg[1] < s_ + 1 || (int)flg[2] < s_ + 1) __builtin_amdgcn_s_sleep(1);
            asm volatile("" ::: "memory");
            bf16x8 Wfr[16], QGfr[16]; u32x2 Ufr[4];
#pragma unroll
            for (int f = 0; f < 16; ++f) Wfr[f] = *(const LAS bf16x8*)(L + f * 1024 + lane * 16);
#pragma unroll
            for (int mt = 0; mt < 4; ++mt) Ufr[mt] = *(const LAS u32x2*)(L + 57344 + mt * 512 + lane * 8);
#pragma unroll
            for (int f = 0; f < 16; ++f) QGfr[f] = *(const LAS bf16x8*)(L + 16384 + f * 1024 + lane * 16);
            __builtin_amdgcn_sched_barrier(0);
            bf16x8 Sb[4];
#pragma unroll
            for (int ks = 0; ks < 4; ++ks) Sb[ks] = pack8(S[2 * ks], S[2 * ks + 1]);
            f32x4 va[4], oa[4];
#pragma unroll
            for (int mt = 0; mt < 4; ++mt) { va[mt] = (f32x4){0.f, 0.f, 0.f, 0.f}; oa[mt] = va[mt]; }
#pragma unroll
            for (int ks = 0; ks < 4; ++ks)
#pragma unroll
                for (int mt = 0; mt < 4; ++mt) va[mt] = mfma16(Wfr[mt * 4 + ks], Sb[ks], va[mt]);
            __builtin_amdgcn_sched_barrier(0);
            bf16x8 ATfr[8];
#pragma unroll
            for (int f = 0; f < 8; ++f) ATfr[f] = *(const LAS bf16x8*)(L + 49152 + f * 1024 + lane * 16);
            const float dec = *(const LAS float*)(L + 59392 + lane * 4);
            __builtin_amdgcn_sched_barrier(0);
#pragma unroll
            for (int ks = 0; ks < 4; ++ks)
#pragma unroll
                for (int mt = 0; mt < 4; ++mt) oa[mt] = mfma16(QGfr[mt * 4 + ks], Sb[ks], oa[mt]);
            __builtin_amdgcn_sched_barrier(0);
            bf16x8 KGfr[16];
#pragma unroll
            for (int f = 0; f < 16; ++f) KGfr[f] = *(const LAS bf16x8*)(L + 32768 + f * 1024 + lane * 16);
            __builtin_amdgcn_sched_barrier(0);
            f32x4 vn[4];
#pragma unroll
            for (int mt = 0; mt < 4; ++mt) vn[mt] = (f32x4){bflo(Ufr[mt].x) - va[mt].x, bfhi(Ufr[mt].x) - va[mt].y, bflo(Ufr[mt].y) - va[mt].z, bfhi(Ufr[mt].y) - va[mt].w};
            bf16x8 vb[2];
#pragma unroll
            for (int k2 = 0; k2 < 2; ++k2) vb[k2] = pack8(vn[2 * k2], vn[2 * k2 + 1]);
#pragma unroll
            for (int mt = 0; mt < 8; ++mt) S[mt] = S[mt] * dec;
#pragma unroll
            for (int k2 = 0; k2 < 2; ++k2) {
#pragma unroll
                for (int mt = 0; mt < 8; ++mt) S[mt] = mfma16(KGfr[mt * 2 + k2], vb[k2], S[mt]);
#pragma unroll
                for (int mt = 0; mt < 4; ++mt) oa[mt] = mfma16(ATfr[mt * 2 + k2], vb[k2], oa[mt]);
            }
#pragma unroll
            for (int mt = 0; mt < 4; ++mt) {
                const bool od = lane & 1; const float t0 = dpp_get<0xB1, 0xF>(od ? oa[mt].x : oa[mt].z), t1 = dpp_get<0xB1, 0xF>(od ? oa[mt].y : oa[mt].w);
                unsigned* op = (unsigned*)(O + ((size_t)(b * 2048 + n * 64 + 16 * mt + 4 * q + (od ? 2 : 0))) * 512 + h * 128 + 16 * sl + (c & ~1));
                op[0] = od ? pk2(t0, oa[mt].z) : pk2(oa[mt].x, t0); op[256] = od ? pk2(t1, oa[mt].w) : pk2(oa[mt].y, t1); }
            asm volatile("s_waitcnt lgkmcnt(0)" ::: "memory");
            if (lane == 0) flg[0] = (unsigned)(s_ + 1);
            asm volatile("" ::: "memory");
        }
#pragma unroll
        for (int mt = 0; mt < 8; ++mt) { float* sp = NGP + ((size_t)(b * 4 + h) * 128 + 16 * mt + 4 * q) * 128 + 16 * sl + c; sp[0] = S[mt].x; sp[128] = S[mt].y; sp[256] = S[mt].z; sp[384] = S[mt].w; }
        asm volatile("s_waitcnt vmcnt(0)" ::: "memory");
    }
    __builtin_amdgcn_s_setprio(0);
}

__device__ __forceinline__ void gdn_gate(const Params& P, int lane, int wave, int bid, int G) {
    unsigned char* ws = P.ws; const bf16* PROJ = (const bf16*)(ws + WS_PROJ); bf16* MIX = (bf16*)(ws + WS_MIX); const bf16* O = (const bf16*)(ws + WS_O); const float* gnorm = P.in[11];
    float gn[8];
#pragma unroll
    for (int e = 0; e < 8; ++e) gn[e] = gnorm[8 * (lane & 15) + e];
    for (int row0 = bid * 8 + wave; row0 < MPR; row0 += G * 32) {
        f32x4 a[4], b[4]; u32x4 zr[4];
#pragma unroll
        for (int u = 0; u < 4; ++u) { const int row = min(row0 + u * G * 8, MPR - 1); const u32x4 orw = *(const u32x4*)(O + (size_t)row * 512 + 8 * lane);
            a[u] = (f32x4){bflo(orw.x), bfhi(orw.x), bflo(orw.y), bfhi(orw.y)}; b[u] = (f32x4){bflo(orw.z), bfhi(orw.z), bflo(orw.w), bfhi(orw.w)};
            zr[u] = *(const u32x4*)(PROJ + (size_t)row * NIN + 1536 + 8 * lane); }
#pragma unroll
        for (int u = 0; u < 4; ++u) { const int row = row0 + u * G * 8;
            float s = dot4(a[u]) + dot4(b[u]); s += dpp_get<0xB1, 0xF>(s); s += dpp_get<0x4E, 0xF>(s); s += dpp_get<0x141, 0xF>(s); s += dpp_get<0x140, 0xF>(s);
            const float rs = rsqrtf(s * (1.f / 128.f) + EPS);
            u32x4 o; o.x = pk2(a[u].x * rs * gn[0] * siluf_(bflo(zr[u].x)), a[u].y * rs * gn[1] * siluf_(bfhi(zr[u].x))); o.y = pk2(a[u].z * rs * gn[2] * siluf_(bflo(zr[u].y)), a[u].w * rs * gn[3] * siluf_(bfhi(zr[u].y)));
            o.z = pk2(b[u].x * rs * gn[4] * siluf_(bflo(zr[u].z)), b[u].y * rs * gn[5] * siluf_(bfhi(zr[u].z))); o.w = pk2(b[u].z * rs * gn[6] * siluf_(bflo(zr[u].w)), b[u].w * rs * gn[7] * siluf_(bfhi(zr[u].w)));
            if (row < MPR) *(u32x4*)(MIX + (size_t)row * DM + 8 * lane) = o; }
    }
}
__device__ __forceinline__ void final_norm(const Params& P, int lane, int wave, int bid, int G) {
    const float* SS3 = (const float*)(P.ws + WS_SS3); const float* gf = P.in[23]; float* out = P.out; const bf16* X3 = (const bf16*)(P.ws + WS_HID);
    f32x4 g4[4];
#pragma unroll
    for (int j = 0; j < 2; ++j) { g4[2 * j] = *(const f32x4*)(gf + 512 * j + 8 * lane); g4[2 * j + 1] = *(const f32x4*)(gf + 512 * j + 8 * lane + 4); }
    for (int row0 = MPR + bid * 8 + wave; row0 < MT; row0 += G * 32) {
        u32x4 v[4][2]; float rs[4];
#pragma unroll
        for (int u = 0; u < 4; ++u) { const int row = min(row0 + u * G * 8, MT - 1); rs[u] = sum16(SS3 + (size_t)row * 16);
#pragma unroll
            for (int j = 0; j < 2; ++j) v[u][j] = *(const u32x4*)(X3 + (size_t)row * DM + 512 * j + 8 * lane); }
#pragma unroll
        for (int u = 0; u < 4; ++u) { const int row = row0 + u * G * 8; const float r = rsqrtf(rs[u] * (1.f / DM) + EPS);
            if (row < MT) {
#pragma unroll
                for (int j = 0; j < 2; ++j) { const u32x4 w = v[u][j]; float* o = out + (size_t)row * DM + 512 * j + 8 * lane;
                    *(f32x4*)o = (f32x4){bflo(w.x), bfhi(w.x), bflo(w.y), bfhi(w.y)} * r * g4[2 * j];
                    *(f32x4*)(o + 4) = (f32x4){bflo(w.z), bfhi(w.z), bflo(w.w), bfhi(w.w)} * r * g4[2 * j + 1]; } } }
    }
}
#define XB_TMO      128
#define XB_XCNT(j)  (256  + 64 * (j))
#define XB_XSUB(j)  (1280 + 64 * (j))
#define XB_XGEN(j)  (2304 + 64 * (j))
#define XB_TOP      3328
#define XB_TOPGEN   3392
#define XCD_BAR_WORDS 3456
#define XB_SPIN_CAP (1u << 18)

__device__ __forceinline__ unsigned xb_ld(unsigned* p)              { return __hip_atomic_load(p, __ATOMIC_RELAXED, __HIP_MEMORY_SCOPE_AGENT); }
__device__ __forceinline__ unsigned xb_add(unsigned* p, unsigned v) { return __hip_atomic_fetch_add(p, v, __ATOMIC_RELAXED, __HIP_MEMORY_SCOPE_AGENT); }
__device__ __forceinline__ unsigned xb_xcc_id() { return (unsigned)__builtin_amdgcn_s_getreg((3 << 11) | 20) & 0xFu; }
#define XB_SPIN(cond, bar) do { unsigned _sp = 0; while (cond) { __builtin_amdgcn_s_sleep(1); \
    if ((++_sp & 255u) == 0u) { if (xb_ld(&(bar)[XB_TMO])) break; if (_sp > XB_SPIN_CAP) { atomicAdd(&(bar)[XB_TMO], 1u); break; } } } } while (0)

struct XcdBarrier {
    unsigned* bar; unsigned x;
    volatile LAS unsigned* st;
};

__device__ __forceinline__ XcdBarrier xcd_barrier_post(unsigned* bar, volatile LAS unsigned* st) {
    XcdBarrier b; b.bar = bar; b.x = xb_xcc_id(); b.st = st;
    if (threadIdx.x == 0) (void)xb_add(&bar[XB_XCNT(b.x)], 1u);
    return b;
}
__device__ __forceinline__ void xcd_barrier_complete(unsigned* bar, unsigned x, unsigned& nloc, unsigned& nx) {
    const unsigned G = gridDim.x * gridDim.y * gridDim.z;
    unsigned sum, cnt, mine, sp = 0u;
    for (;;) {
        sum = 0u; cnt = 0u; mine = 0u;
#pragma unroll
        for (unsigned j = 0; j < 16; ++j) { const unsigned c = xb_ld(&bar[XB_XCNT(j)]); sum += c; cnt += (c > 0u) ? 1u : 0u; mine = (j == x) ? c : mine; }
        if (sum == G) break;
        __builtin_amdgcn_s_sleep(1);
        if ((++sp & 255u) == 0u) { if (xb_ld(&bar[XB_TMO])) break; if (sp > XB_SPIN_CAP) { atomicAdd(&bar[XB_TMO], 1u); break; } }
    }
    nloc = mine > 0u ? mine : 1u; nx = cnt > 0u ? cnt : 1u;
}

__device__ __forceinline__ void xcd_barrier(const XcdBarrier& b) {
    asm volatile("s_waitcnt vmcnt(0)" ::: "memory");
    __syncthreads();
    if (threadIdx.x == 0) {
        unsigned* bar = b.bar;
        __builtin_amdgcn_s_waitcnt(0);
        unsigned nloc = b.st[0], nx = b.st[1];
        if (nloc == 0u) { xcd_barrier_complete(bar, b.x, nloc, nx); b.st[0] = nloc; b.st[1] = nx; }
        const unsigned old = xb_add(&bar[XB_XSUB(b.x)], 1u);
        const unsigned gen = old / nloc;
        if (old + 1u == (gen + 1u) * nloc) {
            __builtin_amdgcn_fence(__ATOMIC_RELEASE, "agent");
            asm volatile("s_waitcnt vmcnt(0)" ::: "memory");
            const unsigned og = xb_add(&bar[XB_TOP], 1u);
            const unsigned tg = og / nx;
            if (og + 1u == (tg + 1u) * nx) xb_add(&bar[XB_TOPGEN], 1u);
            else XB_SPIN(xb_ld(&bar[XB_TOPGEN]) == tg, bar);
            __builtin_amdgcn_fence(__ATOMIC_ACQUIRE, "agent");
            xb_add(&bar[XB_XGEN(b.x)], 1u);
            asm volatile("s_waitcnt vmcnt(0)" ::: "memory");
        } else {
            XB_SPIN(xb_ld(&bar[XB_XGEN(b.x)]) == gen, bar);
            __builtin_amdgcn_fence(__ATOMIC_ACQUIRE, "agent");
            asm volatile("s_waitcnt vmcnt(0)" ::: "memory");
        }
    }
    __syncthreads();
}

__global__ void __launch_bounds__(512, 2) mega_fwd(Params P) {
    extern __shared__ __attribute__((aligned(16))) unsigned char lds_raw[];
    LAS unsigned char* lds = (LAS unsigned char*)lds_raw;
    const int bid = blockIdx.x, G = gridDim.x;
#define FRESH() int tid = threadIdx.x; asm volatile("" : "+v"(tid)); const int lane = tid & 63, wave = __builtin_amdgcn_readfirstlane(tid >> 6), gw = bid * 8 + wave, NGW = G * 8; (void)gw; (void)NGW; (void)lane

    volatile LAS unsigned* st = (volatile LAS unsigned*)(lds + LDS_BYTES - 64);
    if (threadIdx.x < 16) st[threadIdx.x] = 0u;
    __syncthreads();
    unsigned char* ws = P.ws;
    XcdBarrier bar = xcd_barrier_post((unsigned*)(ws + WS_CTL), st);
#define GRID_BAR() xcd_barrier(bar)
    bf16* XB = (bf16*)(ws + WS_XB); bf16* MIX = (bf16*)(ws + WS_MIX); bf16* PROJ = (bf16*)(ws + WS_PROJ); bf16* HID = (bf16*)(ws + WS_HID); bf16* PB = (bf16*)(ws + WS_PB);
    float* SS1 = (float*)(ws + WS_SS1); float* SS2 = (float*)(ws + WS_SS2); float* SS3 = (float*)(ws + WS_SS3);

    { FRESH(); phase0(P, lds, tid, lane, wave, bid, G); }
    GRID_BAR();
    {   FRESH();
        pg8::Gemm g{XB, (const bf16*)(ws + WS_WIN), MPR, NIN, DM}; pg8::StaticOrder S; S.init(MPR, NIN, G, bid);
        EpiGen<F1> E{F1{nullptr, (const float*)(ws + WS_RS0), PROJ}}; EpiGen8<F1> E8{E.f};
        pg8::gemm_phase<EpiGen8<F1>, pg8::StaticOrder, true, true>(lds, g, S, E8);
        small_gemm<2, 4>(XB + (size_t)MPR * DM, (const bf16*)(ws + WS_WIN), NIN, DM, E.f, lds, bid, G, wave, lane);
    }
    GRID_BAR();
    if ((bid & 3) == 1) { FRESH(); sample_gdn(P, lds, tid, lane, wave, bid, G); }
    if ((bid & 3) == 2) { FRESH(); sgu_prompt(P, lds, tid, lane, wave, bid, G); }
    { FRESH(); gdn_prep(P, lds, tid, lane, wave, bid, G); }
    if ((bid & 3) != 2) { FRESH(); sgu_prompt(P, lds, tid, lane, wave, bid, G); }
    if ((bid & 3) != 1) { FRESH(); sample_gdn(P, lds, tid, lane, wave, bid, G); }
    { FRESH(); phase2_misc(P, tid, lane, wave, bid, G); }
    GRID_BAR();
    { FRESH(); gdn_scan(P, lds, st + 4, lane, wave, bid, G);
      if (wave >= 3 && wave <= 5) weight_items(P, (LAS float*)(lds + 2 * ST_BYTES + (wave - 3) * 8448), lane, 1536, 6784, bid * 3 + (wave - 3), G * 3); }
    GRID_BAR();
    { FRESH(); gdn_gate(P, lane, wave, bid, G); }
    GRID_BAR();
    {   FRESH();
        pg8::Gemm g{MIX, (const bf16*)(ws + WS_WOUT), MPR, DM, DM}; pg8::StaticOrder S; S.init(MPR, DM, G, bid);
        EpiGen<F2> E{F2{SS1, XB}}; EpiGen8<F2> E8{E.f};
        pg8::gemm_phase<EpiGen8<F2>, pg8::StaticOrder, false, true>(lds, g, S, E8);
        small_gemm<2, 4>(MIX + (size_t)MPR * DM, (const bf16*)(ws + WS_WOUT), DM, DM, E.f, lds, bid, G, wave, lane);
    }
    GRID_BAR();
    {   FRESH();
        pg8::Gemm g{XB, (const bf16*)(ws + WS_WUP), MPR, FF, DM}; pg8::StaticOrder S; S.init(MPR, FF, G, bid);
        EpiGen<F3> E{F3{nullptr, SS1, HID}}; EpiGen8<F3> E8{E.f};
        pg8::gemm_phase<EpiGen8<F3>, pg8::StaticOrder, true, true>(lds, g, S, E8);
        small_gemm<2, 4>(XB + (size_t)MPR * DM, (const bf16*)(ws + WS_WUP), FF, DM, E.f, lds, bid, G, wave, lane);
    }
    GRID_BAR();
    {   FRESH();
        pg8::Gemm g{HID, (const bf16*)(ws + WS_WDN), MPR, DM, FF}; pg8::StaticOrder S; S.init(MPR, DM, G, bid);
        EpiGen<F4> E{F4{SS2, XB}}; EpiGen8<F4> E8{E.f};
        pg8::gemm_phase<EpiGen8<F4>, pg8::StaticOrder, false, true>(lds, g, S, E8);
        small_gemm<2, 4>(HID + (size_t)MPR * FF, (const bf16*)(ws + WS_WDN), DM, FF, E.f, lds, bid, G, wave, lane);
    }
    GRID_BAR();
    {   FRESH();
        bf16* PP = MIX;
        { pg8::Gemm g{PB, (const bf16*)(ws + WS_WPLE), MPR, DM, DPLE}; pg8::StaticOrder S; S.init(MPR, DM, G, bid);
          EpiGen<F5a> E{F5a{nullptr, PP}}; EpiGen8<F5a> E8{E.f};
          pg8::gemm_phase<EpiGen8<F5a>, pg8::StaticOrder, false, true>(lds, g, S, E8);
          small_gemm<2, 4>(PB + (size_t)MPR * DPLE, (const bf16*)(ws + WS_WPLE), DM, DPLE, E.f, lds, bid, G, wave, lane); }
        { pg8::Gemm g{XB, (const bf16*)(ws + WS_WG), MPR, DM, DM}; pg8::StaticOrder S; S.init(MPR, DM, G, bid);
          EpiGen<F5b> E{F5b{SS3, SS2, XB, PP, HID}};
          EpiFinal EF{SS2, XB, PP, P.out, P.in[23], (unsigned*)(ws + WS_XBUF), (unsigned*)(ws + WS_CTL + 16384)};
          pg8::gemm_phase<EpiFinal, pg8::StaticOrder, false, true>(lds, g, S, EF);
          small_gemm<2, 4>(XB + (size_t)MPR * DM, (const bf16*)(ws + WS_WG), DM, DM, E.f, lds, bid, G, wave, lane); }
    }
    GRID_BAR();
    { FRESH(); final_norm(P, lane, wave, bid, G); }
}

extern "C" void kernel_launch(void* const* d_in, const int* in_sizes, int n_in, void* d_out, int out_size, void* d_ws, size_t ws_size, hipStream_t stream) {
    static int grid = 0;
    if (grid == 0) {
        int dev = 0, cus = 0;
        if (hipGetDevice(&dev) != hipSuccess || hipDeviceGetAttribute(&cus, hipDeviceAttributeMultiprocessorCount, dev) != hipSuccess) { fprintf(stderr, "kernel_launch: device query failed\n"); grid = -1; return; }
        if (hipFuncSetAttribute((const void*)mega_fwd, hipFuncAttributeMaxDynamicSharedMemorySize, LDS_BYTES) != hipSuccess) { fprintf(stderr, "kernel_launch: hipFuncSetAttribute failed\n"); grid = -1; return; }
        int per_cu = 0;
        if (hipOccupancyMaxActiveBlocksPerMultiprocessor(&per_cu, (const void*)mega_fwd, 512, LDS_BYTES) != hipSuccess || per_cu < 1) fprintf(stderr, "kernel_launch: occupancy query reports %d\n", per_cu);
        (void)hipGetLastError();
        grid = cus < 256 ? cus : 256;
        if (n_in != 24 || ws_size < 256 * MiB) fprintf(stderr, "kernel_launch: unexpected n_in %d / ws %zu\n", n_in, ws_size);
    }
    if (grid < 0) return;
    (void)hipMemsetAsync((char*)d_ws + WS_CTL, 0, CTL_BYTES, stream);
    Params p{};
    for (int i = 0; i < 24; ++i) p.in[i] = (const float*)d_in[i];
    p.out = (float*)d_out; p.ws = (unsigned char*)d_ws;
    hipLaunchKernelGGL(mega_fwd, dim3(grid), dim3(512), LDS_BYTES, stream, p);
}
```

```cpp
#include <hip/hip_runtime.h>
#include <cstdio>
#include <cstdint>
namespace pg8 {
#define PG8_LAS __attribute__((address_space(3)))
typedef unsigned short bf16_t;
typedef short bf16x8 __attribute__((ext_vector_type(8)));
typedef float f32x4 __attribute__((ext_vector_type(4)));
typedef unsigned u32x4 __attribute__((ext_vector_type(4)));
constexpr int BM = 256, BK = 64, HALF = 128, HTB = HALF * BK * 2  , STAGE_BYTES = 8 * HTB, NXCD = 8, WGM = 8;

__host__ __device__ __forceinline__ int lds_byte(int r, int c) { const int st = (r >> 4) * 2 + (c >> 5), rr = r & 15, cc = c & 31, ob = rr * 64 + cc * 2; return st * 1024 + (ob ^ (((ob >> 9) & 1) << 5)); }
__host__ __device__ __forceinline__ void stage_rc(int b, int& R, int& C) { const int st = b / 1024, sb = b % 1024, swz = sb ^ (((sb >> 9) & 1) << 5); R = (st >> 1) * 16 + swz / 64; C = (st & 1) * 32 + (swz % 64) / 2; }
__host__ __device__ __forceinline__ int perm32(int rho) { const int n = rho >> 4, i = rho & 15; return 8 * (i >> 2) + 4 * n + (i & 3); }

struct Unit { int pm, pn; };
struct Gemm { const bf16_t* A; const bf16_t* Bt; int M, N, K; };

struct StaticOrder {
    int nM, nN, nwg, G, c;
    __host__ __device__ void init(int M, int N, int G_, int c_) { nM = M / BM; nN = N / BM; nwg = nM * nN; G = G_; c = c_; }
    __host__ __device__ bool next(int i, Unit& u) const {
        const long L = (long)i * G + c; if (L >= nwg) return false;
        int wgid = (int)L; { const int q = nwg / NXCD, r = nwg % NXCD, xcd = wgid % NXCD, off = wgid / NXCD; wgid = (xcd < r ? xcd * (q + 1) : r * (q + 1) + (xcd - r) * q) + off; }
        const int nig = WGM * nN, gid = wgid / nig, fm = gid * WGM, gsz = (nM - fm) < WGM ? (nM - fm) : WGM;
        u.pm = fm + ((wgid % nig) % gsz); u.pn = (wgid % nig) / gsz; return true;
    }
    __device__ __forceinline__ void a_ready(const Unit&) const {}
    __device__ __forceinline__ void done(const Unit&) const {}
};

__device__ __forceinline__ unsigned cvt_pk_bf16(float lo, float hi) { unsigned r; asm volatile("v_cvt_pk_bf16_f32 %0, %1, %2" : "=v"(r) : "v"(lo), "v"(hi)); return r; }
template <class Epi, class Sched, bool ALIGN_EPI = false, bool SP2 = false>
__device__ __forceinline__ void gemm_phase(PG8_LAS unsigned char* lds, const Gemm g, const Sched& S, const Epi& E) {
    int tid_ = threadIdx.x; asm volatile("" : "+v"(tid_));
    const int tid = tid_, wid = __builtin_amdgcn_readfirstlane(tid >> 6), lane = tid & 63, wr = wid >> 2, wc = wid & 3, fr = lane & 15, fq = lane >> 4;
    const int K = g.K, nt = K / BK;
    unsigned voffA[2], voffB[2];
#pragma unroll
    for (int i = 0; i < 2; ++i) { int R, C; stage_rc(tid * 16 + i * 8192, R, C); const int Rb = Epi::PERM ? ((R & ~31) + perm32(R & 31)) : R;
        voffA[i] = (unsigned)(R * K + C) * 2u; voffB[i] = (unsigned)(Rb * K + C) * 2u; }
    const size_t kstep = (size_t)(BK * 2);
    const size_t hstep = (size_t)HALF * K * 2;
    const size_t tstep = 2 * hstep;
    const unsigned ldsw = (unsigned)wid * 1024u;
    const int aoff = lds_byte(wr * 64 + fr, fq * 8), boff = lds_byte(wc * 32 + fr, fq * 8);
#define PG8_SA(b, h) (((b) * 2 + (h)) * HTB)
#define PG8_SB(b, h) ((4 + (b) * 2 + (h)) * HTB)
#define PG8_STAGE(bufoff, gbase, voff) do { _Pragma("unroll") for (int _i = 0; _i < 2; ++_i) \
        __builtin_amdgcn_global_load_lds((const unsigned*)((const char*)(gbase) + (voff)[_i]), (PG8_LAS unsigned*)(lds + (bufoff) + ldsw + _i * 8192), 16, 0, 0); } while (0)
#define PG8_LDA(dst, b, h) do { _Pragma("unroll") for (int m = 0; m < 4; ++m) _Pragma("unroll") for (int k = 0; k < 2; ++k) dst[m][k] = *(const PG8_LAS bf16x8*)(lds + PG8_SA(b, h) + aoff + m * 2048 + k * 1024); } while (0)
#define PG8_LDB(dst, b, h) do { _Pragma("unroll") for (int n = 0; n < 2; ++n) _Pragma("unroll") for (int k = 0; k < 2; ++k) dst[n][k] = *(const PG8_LAS bf16x8*)(lds + PG8_SB(b, h) + boff + n * 2048 + k * 1024); } while (0)
#define PG8_MMA(ai, bj, At, Bt) do { __builtin_amdgcn_s_setprio(1); _Pragma("unroll") for (int m = 0; m < 4; ++m) _Pragma("unroll") for (int n = 0; n < 2; ++n) _Pragma("unroll") for (int k = 0; k < 2; ++k) \
        acc[ai][bj][m][n] = __builtin_amdgcn_mfma_f32_16x16x32_bf16(Bt[n][k], At[m][k], acc[ai][bj][m][n], 0, 0, 0); __builtin_amdgcn_s_setprio(0); } while (0)
#define PG8_WAIT_V(n) asm volatile("s_waitcnt vmcnt(" #n ")" ::: "memory")
#define PG8_WAIT_L(n) asm volatile("s_waitcnt lgkmcnt(" #n ")" ::: "memory")
#define PG8_BAR __builtin_amdgcn_s_barrier()
#define PG8_SCHED __builtin_amdgcn_sched_barrier(0)
    Unit cur, nxt; int ui = 0;
    if (!S.next(0, cur)) return;
    f32x4 acc[2][2][4][2];
#pragma unroll
    for (int a = 0; a < 2; ++a)
#pragma unroll
        for (int b = 0; b < 2; ++b)
#pragma unroll
            for (int m = 0; m < 4; ++m)
#pragma unroll
                for (int n = 0; n < 2; ++n) acc[a][b][m][n] = (f32x4){0.f, 0.f, 0.f, 0.f};
    bf16x8 At[4][2], B0[2][2], B1[2][2];
    const char* cA = (const char*)g.A + (size_t)cur.pm * tstep; const char* cB = (const char*)g.Bt + (size_t)cur.pn * tstep;
    S.a_ready(cur);
    if constexpr (SP2) {
        PG8_STAGE(PG8_SB(0, 0), cB, voffB); PG8_STAGE(PG8_SB(0, 1), cB + hstep, voffB); PG8_STAGE(PG8_SA(0, 0), cA, voffA); PG8_STAGE(PG8_SA(0, 1), cA + hstep, voffA);
        if (wr == 1) PG8_BAR;
        PG8_WAIT_V(2); PG8_BAR;
        PG8_STAGE(PG8_SB(1, 0), cB + kstep, voffB); PG8_STAGE(PG8_SA(1, 0), cA + kstep, voffA); PG8_STAGE(PG8_SB(1, 1), cB + hstep + kstep, voffB);
        PG8_WAIT_V(6); PG8_BAR;
    } else {
        PG8_STAGE(PG8_SB(0, 0), cB, voffB); PG8_STAGE(PG8_SA(0, 0), cA, voffA); PG8_STAGE(PG8_SB(0, 1), cB + hstep, voffB); PG8_STAGE(PG8_SA(0, 1), cA + hstep, voffA);
        if (wr == 1) PG8_BAR;
        PG8_WAIT_V(4); PG8_BAR;
        PG8_STAGE(PG8_SB(1, 0), cB + kstep, voffB); PG8_STAGE(PG8_SA(1, 0), cA + kstep, voffA); PG8_STAGE(PG8_SB(1, 1), cB + hstep + kstep, voffB);
        PG8_WAIT_V(6); PG8_BAR;
    }
    for (;;) {
        const bool has_next = S.next(ui + 1, nxt);
        const char* nA = has_next ? (const char*)g.A + (size_t)nxt.pm * tstep : cA; const char* nB = has_next ? (const char*)g.Bt + (size_t)nxt.pn * tstep : cB;
        for (int t = 0; t < nt; t += 2) {
            const bool last = (t == nt - 2);
            const char* a1 = cA + (size_t)(t + 1) * kstep;
            const char* a2 = last ? nA : cA + (size_t)(t + 2) * kstep; const char* b2 = last ? nB : cB + (size_t)(t + 2) * kstep;
            const char* a3 = a2 + kstep; const char* b3 = b2 + kstep;
            if (last && has_next) S.a_ready(nxt);
            if constexpr (SP2) {
            PG8_LDB(B0, 0, 0); PG8_LDB(B1, 0, 1); PG8_SCHED; PG8_LDA(At, 0, 0); PG8_STAGE(PG8_SA(1, 1), a1 + hstep, voffA);
            PG8_WAIT_V(8); PG8_WAIT_L(0); PG8_BAR; PG8_MMA(0, 0, At, B0); PG8_MMA(0, 1, At, B1); PG8_BAR; PG8_SCHED;
            PG8_LDA(At, 0, 1); PG8_STAGE(PG8_SB(0, 0), b2, voffB); PG8_STAGE(PG8_SB(0, 1), b2 + hstep, voffB); PG8_STAGE(PG8_SA(0, 0), a2, voffA);
            PG8_WAIT_V(8); PG8_WAIT_L(0); PG8_BAR; PG8_MMA(1, 0, At, B0); PG8_MMA(1, 1, At, B1); PG8_BAR; PG8_SCHED;
            PG8_LDB(B0, 1, 0); PG8_LDB(B1, 1, 1); PG8_SCHED; PG8_LDA(At, 1, 0); PG8_STAGE(PG8_SA(0, 1), a2 + hstep, voffA);
            PG8_WAIT_V(8); PG8_WAIT_L(0); PG8_BAR; PG8_MMA(0, 0, At, B0); PG8_MMA(0, 1, At, B1); PG8_BAR; PG8_SCHED;
            PG8_LDA(At, 1, 1); PG8_STAGE(PG8_SB(1, 0), b3, voffB); PG8_STAGE(PG8_SB(1, 1), b3 + hstep, voffB); PG8_STAGE(PG8_SA(1, 0), a3, voffA);
            PG8_WAIT_V(8); PG8_WAIT_L(0); PG8_BAR; PG8_MMA(1, 0, At, B0); PG8_MMA(1, 1, At, B1); PG8_BAR; PG8_SCHED;
            } else {
            PG8_LDB(B0, 0, 0); PG8_SCHED; PG8_LDA(At, 0, 0); PG8_STAGE(PG8_SA(1, 1), a1 + hstep, voffA);
            PG8_WAIT_L(8); PG8_BAR; PG8_WAIT_L(0); PG8_MMA(0, 0, At, B0); PG8_BAR; PG8_SCHED;
            PG8_LDB(B1, 0, 1); PG8_STAGE(PG8_SB(0, 0), b2, voffB);
            PG8_BAR; PG8_WAIT_L(0); PG8_MMA(0, 1, At, B1); PG8_BAR;
            PG8_LDA(At, 0, 1); PG8_STAGE(PG8_SA(0, 0), a2, voffA);
            PG8_BAR; PG8_WAIT_L(0); PG8_MMA(1, 0, At, B0); PG8_BAR; PG8_SCHED;
            PG8_STAGE(PG8_SB(0, 1), b2 + hstep, voffB);
            PG8_WAIT_V(6); PG8_BAR; PG8_MMA(1, 1, At, B1); PG8_BAR;
            PG8_LDB(B0, 1, 0); PG8_SCHED; PG8_LDA(At, 1, 0); PG8_STAGE(PG8_SA(0, 1), a2 + hstep, voffA);
            PG8_WAIT_L(8); PG8_BAR; PG8_WAIT_L(0); PG8_MMA(0, 0, At, B0); PG8_BAR; PG8_SCHED;
            PG8_LDB(B1, 1, 1); PG8_STAGE(PG8_SB(1, 0), b3, voffB);
            PG8_BAR; PG8_WAIT_L(0); PG8_MMA(0, 1, At, B1); PG8_BAR;
            PG8_LDA(At, 1, 1); PG8_STAGE(PG8_SA(1, 0), a3, voffA);
            PG8_BAR; PG8_WAIT_L(0); PG8_MMA(1, 0, At, B0); PG8_BAR; PG8_SCHED;
            PG8_STAGE(PG8_SB(1, 1), b3 + hstep, voffB);
            PG8_WAIT_V(6); PG8_BAR; PG8_MMA(1, 1, At, B1); PG8_BAR;
            }
        }
        if constexpr (ALIGN_EPI) { if (wr == 0) PG8_BAR; }
        if constexpr (!Epi::AFTER_DRAIN) { E(acc, cur, wr, wc, fr, fq); S.done(cur); }
        if (!has_next) break;
#pragma unroll
        for (int a = 0; a < 2; ++a)
#pragma unroll
            for (int b = 0; b < 2; ++b)
#pragma unroll
                for (int m = 0; m < 4; ++m)
#pragma unroll
                    for (int n = 0; n < 2; ++n) acc[a][b][m][n] = (f32x4){0.f, 0.f, 0.f, 0.f};
        cur = nxt; cA = nA; cB = nB; ++ui;
        if constexpr (ALIGN_EPI) { if (wr == 1) PG8_BAR; }
    }
    PG8_WAIT_V(0);
    if constexpr (!ALIGN_EPI) { if (wr == 0) PG8_BAR; }
    PG8_BAR;
    if constexpr (Epi::AFTER_DRAIN) { E.fused(acc, cur, wr, wc, fr, fq, lds, wid, lane); S.done(cur); }
#undef PG8_SA
#undef PG8_SB
#undef PG8_STAGE
#undef PG8_LDA
#undef PG8_LDB
#undef PG8_MMA
#undef PG8_WAIT_V
#undef PG8_WAIT_L
#undef PG8_BAR
#undef PG8_SCHED
}
}

#define LAS __attribute__((address_space(3)))
typedef unsigned short bf16;
typedef float f32x4 __attribute__((ext_vector_type(4)));
typedef short bf16x8 __attribute__((ext_vector_type(8)));
typedef unsigned u32x4 __attribute__((ext_vector_type(4)));
typedef unsigned u32x2 __attribute__((ext_vector_type(2)));
#define LDS_WAIT() asm volatile("s_waitcnt lgkmcnt(0)" ::: "memory")
#define VM_WAIT() asm volatile("s_waitcnt vmcnt(0)" ::: "memory")

constexpr int MPR = 16384, MSA = 128, MT = MPR + MSA, DM = 1024, NIN = 3072, FF = 4096, DPLE = 256, SRCN = 3080;
constexpr float EPS = 1e-6f, QSCALE = 0.08838834764831845f;
constexpr int LDS_BYTES = 147456;
constexpr size_t MiB = 1u << 20;
constexpr size_t WS_RS0 = 0, WS_BETA = 128 * 1024, WS_G = 448 * 1024, WS_WSB = 1 * MiB, WS_SS1 = 2 * MiB, WS_SS2 = 3 * MiB + 256 * 1024, WS_SS3 = 4 * MiB + 512 * 1024;
constexpr size_t WS_WIN = 6 * MiB, WS_WOUT = 12 * MiB, WS_WUP = 14 * MiB, WS_WDN = 22 * MiB, WS_WG = 30 * MiB, WS_WPLE = 32 * MiB;
constexpr size_t WS_PB = 33 * MiB, WS_XB = 42 * MiB, WS_MIX = 75 * MiB, WS_PROJ = 108 * MiB, WS_HID = 108 * MiB, WS_AT = 205 * MiB, WS_O = 213 * MiB, WS_DECF = 246 * MiB, WS_XBUF = 247 * MiB, WS_CTL = 255 * MiB;
constexpr size_t CTL_BYTES = 32768;
constexpr size_t O_Y = 0, O_NCP = 16908288, O_NGP = 16945152, O_NCS = 17469440, O_NGS = 18059264, O_NSV = 26447872;
constexpr size_t FR_W = 0, FR_QG = 8 * MiB, FR_KG = 16 * MiB, FR_U = 24 * MiB;

__device__ __forceinline__ unsigned f2bf(float f) { unsigned u = __builtin_bit_cast(unsigned, f); return (u + 0x7fffu + ((u >> 16) & 1u)) >> 16; }
typedef float f32x2_t_ __attribute__((ext_vector_type(2))); typedef __bf16 bf16x2_t_ __attribute__((ext_vector_type(2)));
__device__ __forceinline__ unsigned pk2(float lo, float hi) { const f32x2_t_ v = {lo, hi}; const bf16x2_t_ b = __builtin_convertvector(v, bf16x2_t_); return __builtin_bit_cast(unsigned, b); }
__device__ __forceinline__ float bflo(unsigned u) { return __builtin_bit_cast(float, u << 16); }
__device__ __forceinline__ float bfhi(unsigned u) { return __builtin_bit_cast(float, u & 0xffff0000u); }
__device__ __forceinline__ float bf2f(bf16 v) { return __builtin_bit_cast(float, (unsigned)v << 16); }
__device__ __forceinline__ float sigmoidf_(float x) { return __builtin_amdgcn_rcpf(1.f + __expf(-x)); }
__device__ __forceinline__ float siluf_(float x) { return x * __builtin_amdgcn_rcpf(1.f + __expf(-x)); }
__device__ __forceinline__ float geluf_(float x) { const float u = 1.5957691216057308f * (x + 0.044715f * x * x * x); return x * __builtin_amdgcn_rcpf(1.f + __expf(-u)); }
template <int CTRL, int ROWMASK> __device__ __forceinline__ float dpp_get(float v) { return __builtin_bit_cast(float, __builtin_amdgcn_update_dpp(0, __builtin_bit_cast(int, v), CTRL, ROWMASK, 0xF, false)); }
__device__ __forceinline__ float wave_sum(float v) {
    v += dpp_get<0xB1, 0xF>(v); v += dpp_get<0x4E, 0xF>(v); v += dpp_get<0x141, 0xF>(v); v += dpp_get<0x140, 0xF>(v);
    v += dpp_get<0x142, 0xA>(v); v += dpp_get<0x143, 0xC>(v);
    return __builtin_bit_cast(float, __builtin_amdgcn_readlane(__builtin_bit_cast(int, v), 63));
}
__device__ __forceinline__ f32x4 mfma16(bf16x8 a, bf16x8 b, f32x4 c) { return __builtin_amdgcn_mfma_f32_16x16x32_bf16(a, b, c, 0, 0, 0); }
__device__ __forceinline__ bf16x8 pack8(f32x4 a, f32x4 b) { u32x4 w; w.x = pk2(a.x, a.y); w.y = pk2(a.z, a.w); w.z = pk2(b.x, b.y); w.w = pk2(b.z, b.w); return __builtin_bit_cast(bf16x8, w); }

struct Params { const float* in[24]; float* out; unsigned char* ws; };

template <class F> struct EpiGen {
    static constexpr bool PERM = false, AFTER_DRAIN = false;
    F f;
    __device__ __forceinline__ void operator()(const pg8::f32x4 (&acc)[2][2][4][2], const pg8::Unit& u, int wr, int wc, int fr, int fq) const {
#pragma unroll
        for (int ai = 0; ai < 2; ++ai)
#pragma unroll
            for (int m = 0; m < 4; ++m) {
                const int row = u.pm * 256 + ai * 128 + wr * 64 + m * 16 + fr;
                const float ctx = f.rowctx(row); float ss = 0.f;
#pragma unroll
                for (int bj = 0; bj < 2; ++bj)
#pragma unroll
                    for (int n = 0; n < 2; ++n) ss += f(row, u.pn * 256 + bj * 128 + wc * 32 + n * 16 + 4 * fq, acc[ai][bj][m][n], ctx);
                if (F::STATS) { ss += __shfl_xor(ss, 16); ss += __shfl_xor(ss, 32); if (fq == 0) f.ss[(size_t)row * 16 + u.pn * 4 + wc] = ss; }
            }
    }
};
template <class F> struct EpiGen8 {
    static constexpr bool PERM = true, AFTER_DRAIN = false;
    F f;
    __device__ __forceinline__ void operator()(const pg8::f32x4 (&acc)[2][2][4][2], const pg8::Unit& u, int wr, int wc, int fr, int fq) const {
#pragma unroll
        for (int ai = 0; ai < 2; ++ai)
#pragma unroll
            for (int m = 0; m < 4; ++m) {
                const int row = u.pm * 256 + ai * 128 + wr * 64 + m * 16 + fr; const float ctx = f.rowctx(row); float ss = 0.f;
#pragma unroll
                for (int bj = 0; bj < 2; ++bj) ss += f.op8(row, u.pn * 256 + bj * 128 + wc * 32 + 8 * fq, acc[ai][bj][m][0], acc[ai][bj][m][1], ctx);
                if (F::STATS) { ss += __shfl_xor(ss, 16); ss += __shfl_xor(ss, 32); if (fq == 0) f.ss[(size_t)row * 16 + u.pn * 4 + wc] = ss; }
            }
    }
};
__device__ __forceinline__ float sum16(const float* p) { const f32x4 a = *(const f32x4*)p, b = *(const f32x4*)(p + 4), c = *(const f32x4*)(p + 8), d = *(const f32x4*)(p + 12);
    return ((a.x + a.y) + (a.z + a.w)) + ((b.x + b.y) + (b.z + b.w)) + ((c.x + c.y) + (c.z + c.w)) + ((d.x + d.y) + (d.z + d.w)); }
__device__ __forceinline__ void st_bf4(bf16* p, f32x4 v) { u32x2 w; w.x = pk2(v.x, v.y); w.y = pk2(v.z, v.w); *(u32x2*)p = w; }
__device__ __forceinline__ float dot4(f32x4 v) { return (v.x * v.x + v.y * v.y) + (v.z * v.z + v.w * v.w); }

struct F1 { static constexpr bool STATS = false; float* ss; const float* rs0; bf16* proj;
    __device__ __forceinline__ float rowctx(int row) const { return rs0[row]; }
    __device__ __forceinline__ float operator()(int row, int col, f32x4 a, float rs) const { f32x4 v = a * rs;
        if (col >= 2048) { v.x = geluf_(v.x); v.y = geluf_(v.y); v.z = geluf_(v.z); v.w = geluf_(v.w); }
        st_bf4(proj + (size_t)row * NIN + col, v); return 0.f; }
    __device__ __forceinline__ float op8(int row, int col, f32x4 a0, f32x4 a1, float rs) const { f32x4 v0 = a0 * rs, v1 = a1 * rs;
        if (col >= 2048) { v0.x = geluf_(v0.x); v0.y = geluf_(v0.y); v0.z = geluf_(v0.z); v0.w = geluf_(v0.w); v1.x = geluf_(v1.x); v1.y = geluf_(v1.y); v1.z = geluf_(v1.z); v1.w = geluf_(v1.w); }
        u32x4 w; w.x = pk2(v0.x, v0.y); w.y = pk2(v0.z, v0.w); w.z = pk2(v1.x, v1.y); w.w = pk2(v1.z, v1.w); *(u32x4*)(proj + (size_t)row * NIN + col) = w; return 0.f; } };
struct F2 { static constexpr bool STATS = true; float* ss; bf16* xb;
    __device__ __forceinline__ float rowctx(int) const { return 0.f; }
    __device__ __forceinline__ float operator()(int row, int col, f32x4 a, float) const { bf16* p = xb + (size_t)row * DM + col; const u32x2 r = *(const u32x2*)p;
        const f32x4 x = (f32x4){bflo(r.x) + a.x, bfhi(r.x) + a.y, bflo(r.y) + a.z, bfhi(r.y) + a.w}; st_bf4(p, x); return dot4(x); }
    __device__ __forceinline__ float op8(int row, int col, f32x4 a0, f32x4 a1, float) const { bf16* p = xb + (size_t)row * DM + col; const u32x4 r = *(const u32x4*)p;
        const f32x4 x0 = (f32x4){bflo(r.x) + a0.x, bfhi(r.x) + a0.y, bflo(r.y) + a0.z, bfhi(r.y) + a0.w}, x1 = (f32x4){bflo(r.z) + a1.x, bfhi(r.z) + a1.y, bflo(r.w) + a1.z, bfhi(r.w) + a1.w};
        u32x4 w; w.x = pk2(x0.x, x0.y); w.y = pk2(x0.z, x0.w); w.z = pk2(x1.x, x1.y); w.w = pk2(x1.z, x1.w); *(u32x4*)p = w; return dot4(x0) + dot4(x1); } };
struct F3 { static constexpr bool STATS = false; float* ss; const float* ss1; bf16* hid;
    __device__ __forceinline__ float rowctx(int row) const { return rsqrtf(sum16(ss1 + (size_t)row * 16) * (1.f / DM) + EPS); }
    __device__ __forceinline__ float operator()(int row, int col, f32x4 a, float rs) const { f32x4 v = a * rs; v.x = fmaxf(v.x, 0.f); v.y = fmaxf(v.y, 0.f); v.z = fmaxf(v.z, 0.f); v.w = fmaxf(v.w, 0.f);
        st_bf4(hid + (size_t)row * FF + col, v * v); return 0.f; }
    __device__ __forceinline__ float op8(int row, int col, f32x4 a0, f32x4 a1, float rs) const { f32x4 v0 = a0 * rs, v1 = a1 * rs;
        v0.x = fmaxf(v0.x, 0.f); v0.y = fmaxf(v0.y, 0.f); v0.z = fmaxf(v0.z, 0.f); v0.w = fmaxf(v0.w, 0.f); v1.x = fmaxf(v1.x, 0.f); v1.y = fmaxf(v1.y, 0.f); v1.z = fmaxf(v1.z, 0.f); v1.w = fmaxf(v1.w, 0.f);
        v0 = v0 * v0; v1 = v1 * v1; u32x4 w; w.x = pk2(v0.x, v0.y); w.y = pk2(v0.z, v0.w); w.z = pk2(v1.x, v1.y); w.w = pk2(v1.z, v1.w); *(u32x4*)(hid + (size_t)row * FF + col) = w; return 0.f; } };
struct F4 { static constexpr bool STATS = true; float* ss; bf16* xb;
    __device__ __forceinline__ float rowctx(int) const { return 0.f; }
    __device__ __forceinline__ float operator()(int row, int col, f32x4 a, float) const { bf16* p = xb + (size_t)row * DM + col; const u32x2 r = *(const u32x2*)p;
        const f32x4 x = (f32x4){bflo(r.x) + a.x, bfhi(r.x) + a.y, bflo(r.y) + a.z, bfhi(r.y) + a.w}; st_bf4(p, x); return dot4(x); }
    __device__ __forceinline__ float op8(int row, int col, f32x4 a0, f32x4 a1, float) const { bf16* p = xb + (size_t)row * DM + col; const u32x4 r = *(const u32x4*)p;
        const f32x4 x0 = (f32x4){bflo(r.x) + a0.x, bfhi(r.x) + a0.y, bflo(r.y) + a0.z, bfhi(r.y) + a0.w}, x1 = (f32x4){bflo(r.z) + a1.x, bfhi(r.z) + a1.y, bflo(r.w) + a1.z, bfhi(r.w) + a1.w};
        u32x4 w; w.x = pk2(x0.x, x0.y); w.y = pk2(x0.z, x0.w); w.z = pk2(x1.x, x1.y); w.w = pk2(x1.z, x1.w); *(u32x4*)p = w; return dot4(x0) + dot4(x1); } };
struct F5a { static constexpr bool STATS = false; float* ss; bf16* pp;
    __device__ __forceinline__ float rowctx(int) const { return 0.f; }
    __device__ __forceinline__ float operator()(int row, int col, f32x4 a, float) const { st_bf4(pp + (size_t)row * DM + col, a); return 0.f; }
    __device__ __forceinline__ float op8(int row, int col, f32x4 a0, f32x4 a1, float) const { u32x4 w; w.x = pk2(a0.x, a0.y); w.y = pk2(a0.z, a0.w); w.z = pk2(a1.x, a1.y); w.w = pk2(a1.z, a1.w);
        *(u32x4*)(pp + (size_t)row * DM + col) = w; return 0.f; } };
struct F5b { static constexpr bool STATS = true; float* ss; const float* ss2; const bf16* xb; const bf16* pp; bf16* x3;
    __device__ __forceinline__ float rowctx(int row) const { return rsqrtf(sum16(ss2 + (size_t)row * 16) * (1.f / DM) + EPS); }
    __device__ __forceinline__ float operator()(int row, int col, f32x4 a, float rs) const { const size_t o = (size_t)row * DM + col; const u32x2 pr = *(const u32x2*)(pp + o), xr = *(const u32x2*)(xb + o);
        f32x4 x; x.x = bflo(xr.x) + bflo(pr.x) * sigmoidf_(a.x * rs); x.y = bfhi(xr.x) + bfhi(pr.x) * sigmoidf_(a.y * rs); x.z = bflo(xr.y) + bflo(pr.y) * sigmoidf_(a.z * rs); x.w = bfhi(xr.y) + bfhi(pr.y) * sigmoidf_(a.w * rs);
        st_bf4(x3 + o, x); return dot4(x); } };

struct EpiFinal {
    static constexpr bool PERM = true, AFTER_DRAIN = true;
    const float* ss2; const bf16* xb; const bf16* pp; float* out; const float* gfin; unsigned* xbuf; unsigned* cnt;
    __device__ __forceinline__ void fused(pg8::f32x4 (&acc)[2][2][4][2], const pg8::Unit& u, int wr, int wc, int fr, int fq, LAS unsigned char* lds, int wid, int lane) const {
        LAS float* Pt = (LAS float*)lds; LAS float* St = (LAS float*)(lds + 4096);
#pragma unroll
        for (int ai = 0; ai < 2; ++ai)
#pragma unroll
            for (int m = 0; m < 4; ++m) {
                const int row_l = ai * 128 + wr * 64 + m * 16 + fr; const size_t row = (size_t)u.pm * 256 + row_l;
                const float rs = rsqrtf(sum16(ss2 + row * 16) * (1.f / DM) + EPS); float ss = 0.f;
#pragma unroll
                for (int bj = 0; bj < 2; ++bj) { const size_t o = row * DM + u.pn * 256 + bj * 128 + wc * 32 + 8 * fq; const u32x4 pr = *(const u32x4*)(pp + o), xr = *(const u32x4*)(xb + o);
                    const f32x4 a0 = acc[ai][bj][m][0], a1 = acc[ai][bj][m][1]; f32x4 x0, x1;
                    x0.x = bflo(xr.x) + bflo(pr.x) * sigmoidf_(a0.x * rs); x0.y = bfhi(xr.x) + bfhi(pr.x) * sigmoidf_(a0.y * rs); x0.z = bflo(xr.y) + bflo(pr.y) * sigmoidf_(a0.z * rs); x0.w = bfhi(xr.y) + bfhi(pr.y) * sigmoidf_(a0.w * rs);
                    x1.x = bflo(xr.z) + bflo(pr.z) * sigmoidf_(a1.x * rs); x1.y = bfhi(xr.z) + bfhi(pr.z) * sigmoidf_(a1.y * rs); x1.z = bflo(xr.w) + bflo(pr.w) * sigmoidf_(a1.z * rs); x1.w = bfhi(xr.w) + bfhi(pr.w) * sigmoidf_(a1.w * rs);
                    acc[ai][bj][m][0] = x0; acc[ai][bj][m][1] = x1; ss += dot4(x0) + dot4(x1); }
                ss += __shfl_xor(ss, 16); ss += __shfl_xor(ss, 32);
                if (fq == 0) Pt[row_l * 4 + wc] = ss;
            }
        asm volatile("s_waitcnt lgkmcnt(0)" ::: "memory"); __builtin_amdgcn_s_barrier(); asm volatile("" ::: "memory");
        const int rl = wid * 32 + (lane & 31);
        if (lane < 32) { const f32x4 p4 = *(const LAS f32x4*)(Pt + rl * 4); const float tot = (p4.x + p4.y) + (p4.z + p4.w);
            __hip_atomic_store(xbuf + ((size_t)u.pm * 256 + rl) * 4 + u.pn, __builtin_bit_cast(unsigned, tot), __ATOMIC_RELAXED, __HIP_MEMORY_SCOPE_AGENT); }
        asm volatile("s_waitcnt vmcnt(0)" ::: "memory");
        if (lane == 0) __hip_atomic_fetch_add(cnt + 64 * u.pm, 1u, __ATOMIC_RELAXED, __HIP_MEMORY_SCOPE_AGENT);
        if (wid == 0) {
            unsigned sp = 0;
            while ((unsigned)__builtin_amdgcn_readfirstlane(__hip_atomic_load(cnt + 64 * u.pm, __ATOMIC_RELAXED, __HIP_MEMORY_SCOPE_AGENT)) < 32u) { __builtin_amdgcn_s_sleep(2); if (++sp > (1u << 22)) break; }
            __builtin_amdgcn_fence(__ATOMIC_ACQUIRE, "agent");
        }
        asm volatile("s_waitcnt vmcnt(0) lgkmcnt(0)" ::: "memory"); __builtin_amdgcn_s_barrier(); asm volatile("" ::: "memory");
        if (lane < 32) { float t = 0.f;
#pragma unroll
            for (int k = 0; k < 4; ++k) t += __builtin_bit_cast(float, __hip_atomic_load(xbuf + ((size_t)u.pm * 256 + rl) * 4 + k, __ATOMIC_RELAXED, __HIP_MEMORY_SCOPE_AGENT));
            St[rl] = rsqrtf(t * (1.f / DM) + EPS); }
        asm volatile("s_waitcnt lgkmcnt(0)" ::: "memory"); __builtin_amdgcn_s_barrier(); asm volatile("" ::: "memory");
#pragma unroll
        for (int ai = 0; ai < 2; ++ai)
#pragma unroll
            for (int m = 0; m < 4; ++m) {
                const int row_l = ai * 128 + wr * 64 + m * 16 + fr; const size_t row = (size_t)u.pm * 256 + row_l; const float r = St[row_l];
#pragma unroll
                for (int bj = 0; bj < 2; ++bj)
#pragma unroll
                    for (int n = 0; n < 2; ++n) { const int col = u.pn * 256 + bj * 128 + wc * 32 + 8 * fq + 4 * n;
                        *(f32x4*)(out + row * DM + col) = acc[ai][bj][m][n] * r * *(const f32x4*)(gfin + col); }
            }
    }
};

template <int RT, int UNR, class F> __device__ __forceinline__ void small_gemm(const bf16* A, const bf16* Bt, int N, int K, const F& f, LAS unsigned char* lds, int bid, int G, int wave, int lane) {
    const int c = lane & 15, q = lane >> 4; constexpr int NMH = 8 / RT; const int ntask = NMH * (N >> 6); const int kw = K >> 3;
    LAS f32x4* red = (LAS f32x4*)lds;
    for (int t = bid; t < ntask; t += G) {
        const int mh = t % NMH, ns = t / NMH;
        const bf16* ap = A + (size_t)(mh * RT * 16 + c) * K + wave * kw + 8 * q;
        const bf16* bp = Bt + (size_t)(ns * 64 + c) * K + wave * kw + 8 * q;
        f32x4 acc[RT][4];
#pragma unroll
        for (int i = 0; i < RT; ++i)
#pragma unroll
            for (int j = 0; j < 4; ++j) acc[i][j] = (f32x4){0.f, 0.f, 0.f, 0.f};
#pragma unroll UNR
        for (int k = 0; k < kw; k += 32) {
            bf16x8 a[RT], b[4];
#pragma unroll
            for (int i = 0; i < RT; ++i) a[i] = *(const bf16x8*)(ap + (size_t)i * 16 * K + k);
#pragma unroll
            for (int j = 0; j < 4; ++j) b[j] = *(const bf16x8*)(bp + (size_t)j * 16 * K + k);
#pragma unroll
            for (int i = 0; i < RT; ++i)
#pragma unroll
                for (int j = 0; j < 4; ++j) acc[i][j] = mfma16(b[j], a[i], acc[i][j]);
        }
#pragma unroll
        for (int i = 0; i < RT; ++i)
#pragma unroll
            for (int j = 0; j < 4; ++j) red[(wave * (RT * 4) + i * 4 + j) * 64 + lane] = acc[i][j];
        __syncthreads();
        if (wave < RT) {
            const int i = wave; const int row = MPR + mh * RT * 16 + i * 16 + c; const float ctx = f.rowctx(row); float ss = 0.f;
#pragma unroll
            for (int j = 0; j < 4; ++j) { f32x4 s = red[(i * 4 + j) * 64 + lane];
#pragma unroll
                for (int w = 1; w < 8; ++w) s += red[(w * (RT * 4) + i * 4 + j) * 64 + lane];
                ss += f(row, ns * 64 + j * 16 + 4 * q, s, ctx); }
            if (F::STATS) { ss += __shfl_xor(ss, 16); ss += __shfl_xor(ss, 32); if (q == 0) f.ss[(size_t)row * 16 + ns] = ss; }
        }
        __syncthreads();
    }
}

__device__ __forceinline__ void tr_item(const float* __restrict__ W, int N, int src_c0, bf16* WT, int K, int dst_r0, const float* __restrict__ gain, LAS float* scr, int k0, int lane) {
    const float gv = gain ? gain[k0 + lane] : 1.f;
    f32x4 wv[8];
#pragma unroll
    for (int i = 0; i < 8; ++i) wv[i] = *(const f32x4*)(W + (size_t)(k0 + 8 * i + (lane >> 3)) * N + src_c0 + 4 * (lane & 7));
#pragma unroll
    for (int i = 0; i < 8; ++i) {
        float g = 0.f;
#pragma unroll
        for (int r = 0; r < 8; ++r) { const float gr = __builtin_bit_cast(float, __builtin_amdgcn_readlane(__builtin_bit_cast(int, gv), 8 * i + r)); g = ((lane >> 3) == r) ? gr : g; }
        LAS float* d = scr + (8 * i + (lane >> 3)) * 33 + 4 * (lane & 7);
        d[0] = wv[i].x * g; d[1] = wv[i].y * g; d[2] = wv[i].z * g; d[3] = wv[i].w * g;
    }
    LDS_WAIT();
    const int c = lane & 7;
#pragma unroll
    for (int j = 0; j < 4; ++j) { const int n = (lane >> 3) + 8 * j; const LAS float* s = scr + (8 * c) * 33 + n;
        u32x4 o; o.x = pk2(s[0], s[33]); o.y = pk2(s[66], s[99]); o.z = pk2(s[132], s[165]); o.w = pk2(s[198], s[231]);
        *(u32x4*)(WT + (size_t)(dst_r0 + n) * K + k0 + 8 * c) = o; }
    LDS_WAIT();
}

__device__ __forceinline__ void weight_items(const Params& P, LAS float* scr, int lane, int first, int last, int start, int stride) {
    unsigned char* ws = P.ws; const float* w_in = P.in[7]; const float* g_mix = P.in[6];
    for (int it = first + start; it < last; it += stride) {
        int r = it;
        if (r < 1536) { const int nb = r >> 4, kb = r & 15; tr_item(w_in, SRCN, nb * 32 + (nb >= 64 ? 8 : 0), (bf16*)(ws + WS_WIN), 1024, nb * 32, g_mix, scr, kb * 64, lane); continue; } r -= 1536;
        if (r < 512) { const int nb = r >> 4, kb = r & 15; tr_item(P.in[16], 1024, nb * 32, (bf16*)(ws + WS_WOUT), 1024, nb * 32, nullptr, scr, kb * 64, lane); continue; } r -= 512;
        if (r < 2048) { const int nb = r >> 4, kb = r & 15; tr_item(P.in[18], 4096, nb * 32, (bf16*)(ws + WS_WUP), 1024, nb * 32, P.in[17], scr, kb * 64, lane); continue; } r -= 2048;
        if (r < 2048) { const int nb = r >> 6, kb = r & 63; tr_item(P.in[19], 1024, nb * 32, (bf16*)(ws + WS_WDN), 4096, nb * 32, nullptr, scr, kb * 64, lane); continue; } r -= 2048;
        if (r < 512) { const int nb = r >> 4, kb = r & 15; tr_item(P.in[22], 1024, nb * 32, (bf16*)(ws + WS_WG), 1024, nb * 32, P.in[20], scr, kb * 64, lane); continue; } r -= 512;
        { const int nb = r >> 2, kb = r & 3; tr_item(P.in[21], 1024, nb * 32, (bf16*)(ws + WS_WPLE), 256, nb * 32, nullptr, scr, kb * 64, lane); }
    }
}

__device__ __forceinline__ void phase0(const Params& P, LAS unsigned char* lds, int tid, int lane, int wave, int bid, int G) {
    unsigned char* ws = P.ws; const int gw = bid * 8 + wave, NGW = G * 8, gt = bid * 512 + tid, NGT = G * 512;
    const float* w_in = P.in[7]; const float* g_mix = P.in[6];
    LAS f32x4* W8 = (LAS f32x4*)(lds + 67584);
    for (int idx = tid; idx < 2048; idx += 512) {
        const int l = idx & 63, half = (idx >> 6) & 1, je = idx >> 7; const int k = 256 * (je >> 2) + 4 * l + (je & 3);
        const float g = g_mix[k]; const float* s = w_in + (size_t)k * SRCN + 2048 + 4 * half;
        W8[idx] = (f32x4){s[0] * g, s[1] * g, s[2] * g, s[3] * g};
    }
    { const float* w_s = P.in[14]; bf16* WSB = (bf16*)(ws + WS_WSB);
      for (int i = gt; i < 65536; i += NGT) { const int t = (i >> 7) & 127, s = i & 127; WSB[i] = (bf16)f2bf(s <= t ? w_s[i] : 0.f); } }
    { bf16* PB = (bf16*)(ws + WS_PB); const float* pp = P.in[4]; const float* ps = P.in[5];
      for (int i = gt; i < MT * 32; i += NGT) { const int row = i >> 5, c8 = i & 31; const float* src = row < MPR ? pp + (size_t)row * DPLE + c8 * 8 : ps + (size_t)(row - MPR) * DPLE + c8 * 8;
          const f32x4 a = *(const f32x4*)src, b = *(const f32x4*)(src + 4); u32x4 o; o.x = pk2(a.x, a.y); o.y = pk2(a.z, a.w); o.z = pk2(b.x, b.y); o.w = pk2(b.z, b.w); *(u32x4*)(PB + (size_t)i * 8) = o; } }
    weight_items(P, (LAS float*)(lds + wave * 8448), lane, 0, 1536, gw, NGW);
    __syncthreads();
    float* RS0 = (float*)(ws + WS_RS0); float* BETA = (float*)(ws + WS_BETA); float* GG = (float*)(ws + WS_G); bf16* XB = (bf16*)(ws + WS_XB);
    const float* a_log = P.in[9]; const float* dt_bias = P.in[10];
    f32x4 vnx[4];
    { const int row = gw < MT ? gw : MT - 1; const float* xr = row < MPR ? P.in[0] + (size_t)row * DM : P.in[1] + (size_t)(row - MPR) * DM;
#pragma unroll
      for (int j = 0; j < 4; ++j) vnx[j] = *(const f32x4*)(xr + 256 * j + 4 * lane); }
    for (int row = gw; row < MT; row += NGW) {
        f32x4 v[4]; float ss = 0.f;
#pragma unroll
        for (int j = 0; j < 4; ++j) { v[j] = vnx[j]; ss += dot4(v[j]); }
        { const int rn = (row + NGW < MT) ? row + NGW : row; const float* xr = rn < MPR ? P.in[0] + (size_t)rn * DM : P.in[1] + (size_t)(rn - MPR) * DM;
#pragma unroll
          for (int j = 0; j < 4; ++j) vnx[j] = *(const f32x4*)(xr + 256 * j + 4 * lane); }
#pragma unroll
        for (int j = 0; j < 4; ++j) st_bf4(XB + (size_t)row * DM + 256 * j + 4 * lane, v[j]);
        f32x4 d0 = (f32x4){0.f, 0.f, 0.f, 0.f}, d1 = d0;
#pragma unroll
        for (int j = 0; j < 4; ++j)
#pragma unroll
            for (int e = 0; e < 4; ++e) { const float xv = v[j][e]; d0 += W8[((j * 4 + e) * 2 + 0) * 64 + lane] * xv; d1 += W8[((j * 4 + e) * 2 + 1) * 64 + lane] * xv; }
        const bool b0 = lane & 1, b1 = lane & 2, b2 = lane & 4;
        float t0 = (b0 ? d1.x : d0.x) + __shfl_xor(b0 ? d0.x : d1.x, 1), t1 = (b0 ? d1.y : d0.y) + __shfl_xor(b0 ? d0.y : d1.y, 1);
        float t2 = (b0 ? d1.z : d0.z) + __shfl_xor(b0 ? d0.z : d1.z, 1), t3 = (b0 ? d1.w : d0.w) + __shfl_xor(b0 ? d0.w : d1.w, 1);
        float u0 = (b1 ? t2 : t0) + __shfl_xor(b1 ? t0 : t2, 2), u1 = (b1 ? t3 : t1) + __shfl_xor(b1 ? t1 : t3, 2);
        float w = (b2 ? u1 : u0) + __shfl_xor(b2 ? u0 : u1, 4);
        w += __shfl_xor(w, 8); w += __shfl_xor(w, 16); w += __shfl_xor(w, 32);
        ss = wave_sum(ss); const float rs = rsqrtf(ss * (1.f / DM) + EPS);
        if (lane < 8) { const int hh = 2 * ((lane >> 1) & 1) + ((lane >> 2) & 1);
            if (!(lane & 1)) BETA[(size_t)row * 4 + hh] = sigmoidf_(w * rs);
            else { const float xa = w * rs + dt_bias[hh]; const float sp = fmaxf(xa, 0.f) + log1pf(expf(-fabsf(xa))); GG[(size_t)row * 4 + hh] = -expf(a_log[hh]) * sp; } }
        if (lane == 0) RS0[row] = rs;
    }
}

__device__ __forceinline__ void gdn_prep(const Params& P, LAS unsigned char* lds, int tid, int lane, int wave, int bid, int G) {
    unsigned char* ws = P.ws; const bf16* PROJ = (const bf16*)(ws + WS_PROJ); const float* BETA = (const float*)(ws + WS_BETA); const float* GG = (const float*)(ws + WS_G);
    bf16* FRB = (bf16*)P.out; bf16* ATf = (bf16*)(ws + WS_AT); float* DECF = (float*)(ws + WS_DECF); const float* wconv = P.in[8];
    const int tid0 = tid;
    for (int u0 = bid * 2; u0 < 1024; u0 += G * 2) {
        int tid = tid0; asm volatile("" : "+v"(tid));
        const int lane = tid & 63, wv = __builtin_amdgcn_readfirstlane(tid >> 6), hb = wv >> 2, t = tid & 255, w4 = wv & 3, c = lane & 15, q = lane >> 4;
        LAS unsigned char* base = lds + hb * 70656;
        LAS bf16* q_l = (LAS bf16*)base; LAS bf16* k_l = (LAS bf16*)(base + 17408); LAS bf16* v_l = (LAS bf16*)(base + 34816);
        LAS float* A_l = (LAS float*)(base + 52224); LAS float* gc = (LAS float*)(base + 69632); LAS float* bt = gc + 64;
        const int unit = u0 + hb, cg = unit >> 2, h = unit & 3, n = cg & 31; const int row0 = cg * 64, tokb = 16 * w4;
        float y[3][16][2];
#pragma unroll
        for (int g3 = 0; g3 < 3; ++g3) {
            const int col = g3 * 512 + h * 128 + 2 * lane;
            const float w0a = wconv[col], w0b = wconv[col + 1], w1a = wconv[1536 + col], w1b = wconv[1536 + col + 1], w2a = wconv[3072 + col], w2b = wconv[3072 + col + 1], w3a = wconv[4608 + col], w3b = wconv[4608 + col + 1];
            const bf16* src = PROJ + (size_t)(row0 + tokb) * NIN + col;
            unsigned raw[19];
            const bool nohist = (n == 0 && w4 == 0);
#pragma unroll
            for (int i = 0; i < 19; ++i) raw[i] = (i < 3 && nohist) ? 0u : *(const unsigned*)(src + (ptrdiff_t)(i - 3) * NIN);
#pragma unroll
            for (int i = 0; i < 16; ++i) {
                const float ya = w0a * bflo(raw[i]) + w1a * bflo(raw[i + 1]) + w2a * bflo(raw[i + 2]) + w3a * bflo(raw[i + 3]);
                const float yb = w0b * bfhi(raw[i]) + w1b * bfhi(raw[i + 1]) + w2b * bfhi(raw[i + 2]) + w3b * bfhi(raw[i + 3]);
                y[g3][i][0] = siluf_(ya); y[g3][i][1] = siluf_(yb);
            }
        }
#pragma unroll
        for (int g3 = 0; g3 < 2; ++g3)
#pragma unroll
            for (int i = 0; i < 16; ++i) { const float s = wave_sum(y[g3][i][0] * y[g3][i][0] + y[g3][i][1] * y[g3][i][1]); const float r = rsqrtf(s + 1e-6f); y[g3][i][0] *= r; y[g3][i][1] *= r; }
#pragma unroll
        for (int i = 0; i < 16; ++i) {
            *(LAS unsigned*)(q_l + (tokb + i) * 136 + 2 * lane) = pk2(y[0][i][0], y[0][i][1]);
            *(LAS unsigned*)(k_l + (tokb + i) * 136 + 2 * lane) = pk2(y[1][i][0], y[1][i][1]);
            *(LAS unsigned*)(v_l + (tokb + i) * 136 + 2 * lane) = pk2(y[2][i][0], y[2][i][1]);
        }
        if (w4 == 0) {
            int lane = tid; asm volatile("" : "+v"(lane)); lane &= 63;
            float g = GG[(size_t)(row0 + lane) * 4 + h];
#pragma unroll
            for (int o = 1; o < 64; o <<= 1) { const float tt = __shfl_up(g, o); if (lane >= o) g += tt; }
            gc[lane] = g; bt[lane] = BETA[(size_t)(row0 + lane) * 4 + h];
            const float dl = __expf(__shfl(g, 63));
            *(f32x4*)(DECF + (size_t)unit * 256 + lane * 4) = (f32x4){dl, dl, dl, dl};
        }
        __syncthreads();
        {
            const int it = w4; bf16x8 qf[4], kif[4];
#pragma unroll
            for (int kd = 0; kd < 4; ++kd) { qf[kd] = *(const LAS bf16x8*)(q_l + (16 * it + c) * 136 + 32 * kd + 8 * q); kif[kd] = *(const LAS bf16x8*)(k_l + (16 * it + c) * 136 + 32 * kd + 8 * q); }
            const int ii = 16 * it + c; const float gci = gc[ii];
            float atv[2][8];
#pragma unroll
            for (int jt = 0; jt < 4; ++jt) {
                if (jt <= it) {
                    f32x4 aq = (f32x4){0.f, 0.f, 0.f, 0.f}, ak = aq;
#pragma unroll
                    for (int kd = 0; kd < 4; ++kd) { const bf16x8 kjf = *(const LAS bf16x8*)(k_l + (16 * jt + c) * 136 + 32 * kd + 8 * q); aq = mfma16(kjf, qf[kd], aq); ak = mfma16(kif[kd], kjf, ak); }
                    const f32x4 gj = *(const LAS f32x4*)(gc + 16 * jt + 4 * q); f32x4 av;
                    const f32x4 gi4 = *(const LAS f32x4*)(gc + 16 * it + 4 * q), bi4 = *(const LAS f32x4*)(bt + 16 * it + 4 * q); const float gcj = gc[16 * jt + c];
#pragma unroll
                    for (int r = 0; r < 4; ++r) { const int j = 16 * jt + 4 * q + r; const float dec = (j <= ii) ? __expf(gci - gj[r]) : 0.f;
                        atv[jt >> 1][(jt & 1) * 4 + r] = aq[r] * dec * QSCALE;
                        const int i2 = 16 * it + 4 * q + r, j2 = 16 * jt + c; av[r] = (j2 < i2) ? ak[r] * bi4[r] * __expf(gi4[r] - gcj) : 0.f; }
                    *(LAS f32x4*)(A_l + (16 * jt + c) * 68 + 16 * it + 4 * q) = av;
                } else {
#pragma unroll
                    for (int r = 0; r < 4; ++r) atv[jt >> 1][(jt & 1) * 4 + r] = 0.f;
                }
            }
#pragma unroll
            for (int ks = 0; ks < 2; ++ks) { u32x4 o; o.x = pk2(atv[ks][0], atv[ks][1]); o.y = pk2(atv[ks][2], atv[ks][3]); o.z = pk2(atv[ks][4], atv[ks][5]); o.w = pk2(atv[ks][6], atv[ks][7]);
                *(u32x4*)(ATf + ((size_t)unit * 8 + it * 2 + ks) * 512 + lane * 8) = o; }
        }
        {
            const float gl = gc[63];
#pragma unroll
            for (int e = 0; e < 4; ++e) {
                const int f = w4 + 4 * e;
                { const int mt = f >> 2, ks = f & 3, tok = 16 * mt + c; const float sc = __expf(gc[tok]) * QSCALE;
                  const u32x2 lo = *(const LAS u32x2*)(q_l + tok * 136 + 32 * ks + 4 * q), hi = *(const LAS u32x2*)(q_l + tok * 136 + 32 * ks + 16 + 4 * q);
                  u32x4 o; o.x = pk2(bflo(lo.x) * sc, bfhi(lo.x) * sc); o.y = pk2(bflo(lo.y) * sc, bfhi(lo.y) * sc); o.z = pk2(bflo(hi.x) * sc, bfhi(hi.x) * sc); o.w = pk2(bflo(hi.y) * sc, bfhi(hi.y) * sc);
                  *(u32x4*)(FRB + FR_QG + (size_t)unit * 8192 + f * 512 + lane * 8) = o; }
                { const int mt = f >> 1, ks2 = f & 1; float kv[8];
#pragma unroll
                  for (int jj = 0; jj < 8; ++jj) { const int tok = 32 * ks2 + 16 * (jj >> 2) + 4 * q + (jj & 3); kv[jj] = bf2f(k_l[tok * 136 + 16 * mt + c]) * __expf(gl - gc[tok]); }
                  u32x4 o; o.x = pk2(kv[0], kv[1]); o.y = pk2(kv[2], kv[3]); o.z = pk2(kv[4], kv[5]); o.w = pk2(kv[6], kv[7]);
                  *(u32x4*)(FRB + FR_KG + (size_t)unit * 8192 + f * 512 + lane * 8) = o; }
            }
        }
        int t5 = t; asm volatile("" : "+v"(t5));
        const int col = t5 & 127, kind = __builtin_amdgcn_readfirstlane(t5 >> 7);
        typedef float f32x2s __attribute__((ext_vector_type(2)));
        f32x2s sp[32];
        {
            const LAS bf16* srcl = kind ? k_l : v_l;
#pragma unroll
            for (int i = 0; i < 64; ++i) { const float m = kind ? bt[i] * __expf(gc[i]) : bt[i]; sp[i >> 1][i & 1] = bf2f(srcl[i * 136 + col]) * m; }
        }
        __syncthreads();
        {
#pragma clang loop unroll(full)
            for (int j = 0; j < 63; ++j) {
                f32x4 avc[16];
#pragma unroll
                for (int v = (j + 1) >> 2; v < 16; ++v) avc[v] = *(const LAS f32x4*)(A_l + j * 68 + 4 * v);
                __builtin_amdgcn_sched_barrier(0);
                const float sj = sp[j >> 1][j & 1]; const f32x2s sj2 = (f32x2s){sj, sj};
#pragma unroll
                for (int v = (j + 1) >> 2; v < 16; ++v) { const f32x4 a = avc[v];
                    sp[2 * v] -= (f32x2s){a.x, a.y} * sj2; sp[2 * v + 1] -= (f32x2s){a.z, a.w} * sj2; }
                __builtin_amdgcn_sched_barrier(0);
            }
        }
        {
            LAS bf16* dstl = kind ? k_l : v_l;
#pragma unroll
            for (int i = 0; i < 64; ++i) dstl[i * 136 + col] = (bf16)f2bf(sp[i >> 1][i & 1]);
        }
        __syncthreads();
        { int l7 = tid; asm volatile("" : "+v"(l7)); const int c = l7 & 15, q = (l7 >> 4) & 3, lane = l7 & 63;
#pragma unroll
        for (int e = 0; e < 4; ++e) { const int f = w4 + 4 * e, mt = f >> 2, ks = f & 3, tok = 16 * mt + c;
            const u32x2 lo = *(const LAS u32x2*)(k_l + tok * 136 + 32 * ks + 4 * q), hi = *(const LAS u32x2*)(k_l + tok * 136 + 32 * ks + 16 + 4 * q);
            *(u32x4*)(FRB + FR_W + (size_t)unit * 8192 + f * 512 + lane * 8) = (u32x4){lo.x, lo.y, hi.x, hi.y}; }
#pragma unroll
        for (int e = 0; e < 8; ++e) { const int f = w4 + 4 * e, sl = f >> 2, mt = f & 3; const LAS bf16* s = v_l + (16 * mt + 4 * q) * 136 + 16 * sl + c;
            u32x2 o; o.x = (unsigned)s[0] | ((unsigned)s[136] << 16); o.y = (unsigned)s[272] | ((unsigned)s[408] << 16);
            *(u32x2*)(FRB + FR_U + ((size_t)unit * 32 + f) * 256 + lane * 4) = o; }
        }
        __syncthreads();
    }
}

__device__ __forceinline__ void sgu_prompt(const Params& P, LAS unsigned char* lds, int tid, int lane, int wave, int bid, int G) {
    asm volatile("" : "+v"(tid)); lane = tid & 63;
    unsigned char* ws = P.ws; const bf16* PROJ = (const bf16*)(ws + WS_PROJ); bf16* MIX = (bf16*)(ws + WS_MIX); const bf16* WSB = (const bf16*)(ws + WS_WSB);
    const float* lng = P.in[12]; const float* lnb = P.in[13]; const float* b_s = P.in[15];
    LAS bf16* vgT = (LAS bf16*)lds; const int c = lane & 15, q = lane >> 4;
    float lg[8], lb[8];
#pragma unroll
    for (int e = 0; e < 8; ++e) { lg[e] = lng[8 * lane + e]; lb[e] = lnb[8 * lane + e]; }
    for (int su = bid; su < 256; su += G) {
        const int b = su >> 5, n = (su >> 1) & 15, hp = su & 1; const int row0 = b * 2048 + n * 128;
        u32x4 rawv[16];
#pragma unroll
        for (int i = 0; i < 16; ++i) rawv[i] = *(const u32x4*)(PROJ + (size_t)(row0 + 16 * wave + i) * NIN + 2560 + 8 * lane);
        unsigned pkv[8][8];
#pragma unroll
        for (int i2 = 0; i2 < 8; ++i2) {
            float xa[8], xb2[8];
#pragma unroll
            for (int hh = 0; hh < 2; ++hh) {
                const u32x4 raw = rawv[2 * i2 + hh];
                float x[8] = {bflo(raw.x), bfhi(raw.x), bflo(raw.y), bfhi(raw.y), bflo(raw.z), bfhi(raw.z), bflo(raw.w), bfhi(raw.w)};
                float s = 0.f;
#pragma unroll
                for (int e = 0; e < 8; ++e) s += x[e];
                const float mean = wave_sum(s) * (1.f / 512.f); float s2 = 0.f;
#pragma unroll
                for (int e = 0; e < 8; ++e) { x[e] -= mean; s2 += x[e] * x[e]; }
                const float rstd = rsqrtf(wave_sum(s2) * (1.f / 512.f) + EPS);
#pragma unroll
                for (int e = 0; e < 8; ++e) { const float vn_ = x[e] * rstd * lg[e] + lb[e]; if (hh == 0) xa[e] = vn_; else xb2[e] = vn_; }
            }
#pragma unroll
            for (int e = 0; e < 8; ++e) pkv[e][i2] = pk2(xa[e], xb2[e]);
        }
        if ((q >> 1) == hp) {
#pragma unroll
            for (int e = 0; e < 8; ++e) {
                LAS bf16* rowp = vgT + (q & 1) * 17408 + (8 * c + e) * 136;
                *(LAS u32x4*)(rowp + 8 * ((2 * wave) ^ c)) = (u32x4){pkv[e][0], pkv[e][1], pkv[e][2], pkv[e][3]};
                *(LAS u32x4*)(rowp + 8 * ((2 * wave + 1) ^ c)) = (u32x4){pkv[e][4], pkv[e][5], pkv[e][6], pkv[e][7]};
            }
        }
        __syncthreads();
#pragma unroll 1
        for (int hh = 0; hh < 2; ++hh) { const int h = 2 * hp + hh; const LAS bf16* vgh = vgT + hh * 17408;
        f32x4 acc[8]; u32x2 upre[8]; const float bias_pre = b_s[h * 128 + 16 * wave + c];
#pragma unroll
        for (int nt = 0; nt < 8; ++nt) { acc[nt] = (f32x4){0.f, 0.f, 0.f, 0.f}; upre[nt] = *(const u32x2*)(PROJ + ((size_t)row0 + 16 * wave + c) * NIN + 2048 + h * 128 + 16 * nt + 4 * q); }
        for (int ks = 0; ks <= (wave >> 1); ++ks) {
            const bf16x8 bfr = *(const bf16x8*)(WSB + (size_t)(h * 128 + 16 * wave + c) * 128 + 32 * ks + 8 * q);
#pragma unroll
            for (int nt = 0; nt < 8; ++nt) { const int d = 16 * nt + c; const bf16x8 afr = *(const LAS bf16x8*)(vgh + d * 136 + 8 * ((4 * ks + q) ^ ((d >> 3) & 15))); acc[nt] = mfma16(afr, bfr, acc[nt]); }
        }
        { const int tt = 16 * wave + c; const size_t row = (size_t)row0 + tt; const float bias = bias_pre;
#pragma unroll
          for (int nt = 0; nt < 8; ++nt) { const int d0 = 16 * nt + 4 * q; const u32x2 ur = upre[nt];
              f32x4 o; o.x = bflo(ur.x) * (acc[nt].x + bias); o.y = bfhi(ur.x) * (acc[nt].y + bias); o.z = bflo(ur.y) * (acc[nt].z + bias); o.w = bfhi(ur.y) * (acc[nt].w + bias);
              st_bf4(MIX + row * DM + 512 + h * 128 + d0, o); } }
        }
        __syncthreads();
    }
}

__device__ __forceinline__ void sample_gdn(const Params& P, LAS unsigned char* lds, int tid, int lane, int wave, int bid, int G) {
    asm volatile("" : "+v"(tid)); lane = tid & 63;
    unsigned char* ws = P.ws; const bf16* PROJ = (const bf16*)(ws + WS_PROJ); bf16* MIX = (bf16*)(ws + WS_MIX); const float* BETA = (const float*)(ws + WS_BETA); const float* GG = (const float*)(ws + WS_G);
    const float* sconv = P.in[2]; const float* sgdn = P.in[3]; const float* wconv = P.in[8]; const float* gnorm = P.in[11];
    float* NCS = P.out + O_NCS; float* NGS = P.out + O_NGS;
    LAS float* sm = (LAS float*)lds; LAS float* scal = sm + 384; LAS f32x4* red = (LAS f32x4*)(sm + 512);
    const int dv4 = tid & 31, dkg = tid >> 5;
    for (int su = bid; su < 512; su += G) {
        const int bs = su >> 2, h = su & 3; const size_t srow = (size_t)MPR + bs;
        const float* S0 = sgdn + (size_t)(bs * 4 + h) * 16384 + (size_t)(8 * dkg) * 128 + 4 * dv4;
        f32x4 s0[8];
#pragma unroll
        for (int i = 0; i < 8; ++i) s0[i] = *(const f32x4*)(S0 + (size_t)i * 128);
        if (tid < 384) { const int g3 = tid >> 7, ch = tid & 127, col = g3 * 512 + h * 128 + ch;
            const float x = bf2f(PROJ[srow * NIN + col]); const float h0 = sconv[(size_t)(bs * 3 + 0) * 1536 + col], h1 = sconv[(size_t)(bs * 3 + 1) * 1536 + col], h2 = sconv[(size_t)(bs * 3 + 2) * 1536 + col];
            const float yv = siluf_(wconv[col] * h0 + wconv[1536 + col] * h1 + wconv[3072 + col] * h2 + wconv[4608 + col] * x);
            NCS[(size_t)(bs * 3 + 0) * 1536 + col] = h1; NCS[(size_t)(bs * 3 + 1) * 1536 + col] = h2; NCS[(size_t)(bs * 3 + 2) * 1536 + col] = x;
            sm[g3 * 128 + ch] = yv; }
        __syncthreads();
        if (wave < 2) { const float a = sm[wave * 128 + lane], b2 = sm[wave * 128 + 64 + lane]; const float s = wave_sum(a * a + b2 * b2); if (lane == 0) scal[wave] = rsqrtf(s + 1e-6f); }
        __syncthreads();
        const float qn = scal[0], kn = scal[1];
        const float beta = BETA[srow * 4 + h], eg = __expf(GG[srow * 4 + h]);
        float kk[8], qq[8]; f32x4 p = (f32x4){0.f, 0.f, 0.f, 0.f};
#pragma unroll
        for (int i = 0; i < 8; ++i) { kk[i] = sm[128 + 8 * dkg + i] * kn; qq[i] = sm[8 * dkg + i] * qn; p += s0[i] * kk[i]; }
        red[dkg * 32 + dv4] = p;
        __syncthreads();
        f32x4 kS = red[dv4];
#pragma unroll
        for (int g = 1; g < 16; ++g) kS += red[g * 32 + dv4];
        const f32x4 v4 = *(const LAS f32x4*)(sm + 256 + 4 * dv4); const f32x4 vnew = (v4 - kS * eg) * beta;
        __syncthreads();
        f32x4 po = (f32x4){0.f, 0.f, 0.f, 0.f}; float* S1 = NGS + (size_t)(bs * 4 + h) * 16384 + (size_t)(8 * dkg) * 128 + 4 * dv4;
#pragma unroll
        for (int i = 0; i < 8; ++i) { const f32x4 s1 = s0[i] * eg + vnew * kk[i]; *(f32x4*)(S1 + (size_t)i * 128) = s1; po += s1 * qq[i]; }
        red[dkg * 32 + dv4] = po;
        __syncthreads();
        if (tid < 32) { f32x4 o = red[dv4];
#pragma unroll
            for (int g = 1; g < 16; ++g) o += red[g * 32 + dv4];
            o = o * QSCALE; float s = dot4(o); s += __shfl_xor(s, 1); s += __shfl_xor(s, 2); s += __shfl_xor(s, 4); s += __shfl_xor(s, 8); s += __shfl_xor(s, 16);
            const float rs = rsqrtf(s * (1.f / 128.f) + EPS); const u32x2 zr = *(const u32x2*)(PROJ + srow * NIN + 1536 + h * 128 + 4 * dv4); const f32x4 gn = *(const f32x4*)(gnorm + 4 * dv4);
            f32x4 m; m.x = o.x * rs * gn.x * siluf_(bflo(zr.x)); m.y = o.y * rs * gn.y * siluf_(bfhi(zr.x)); m.z = o.z * rs * gn.z * siluf_(bflo(zr.y)); m.w = o.w * rs * gn.w * siluf_(bfhi(zr.y));
            st_bf4(MIX + srow * DM + h * 128 + 4 * dv4, m); }
        __syncthreads();
    }
}

__device__ __forceinline__ void phase2_misc(const Params& P, int tid, int lane, int wave, int bid, int G) {
    unsigned char* ws = P.ws; const bf16* PROJ = (const bf16*)(ws + WS_PROJ); bf16* MIX = (bf16*)(ws + WS_MIX);
    { float* NCP = P.out + O_NCP; for (int i = bid * 512 + tid; i < 36864; i += G * 512) { const int b = i / 4608, rem = i - b * 4608, j = rem / 1536, col = rem - j * 1536; NCP[i] = bf2f(PROJ[(size_t)(b * 2048 + 2045 + j) * NIN + col]); } }
    const int gw = bid * 8 + wave;
    if (gw < MSA) { const int bs = gw; const size_t srow = (size_t)MPR + bs; const float* lng = P.in[12]; const float* lnb = P.in[13]; float* NSV = P.out + O_NSV;
        const u32x4 raw = *(const u32x4*)(PROJ + srow * NIN + 2560 + 8 * lane); const u32x4 uraw = *(const u32x4*)(PROJ + srow * NIN + 2048 + 8 * lane);
        float x[8] = {bflo(raw.x), bfhi(raw.x), bflo(raw.y), bfhi(raw.y), bflo(raw.z), bfhi(raw.z), bflo(raw.w), bfhi(raw.w)};
        const float uu[8] = {bflo(uraw.x), bfhi(uraw.x), bflo(uraw.y), bfhi(uraw.y), bflo(uraw.z), bfhi(uraw.z), bflo(uraw.w), bfhi(uraw.w)};
        float s = 0.f;
#pragma unroll
        for (int e = 0; e < 8; ++e) s += x[e];
        const float mean = wave_sum(s) * (1.f / 512.f); float s2 = 0.f;
#pragma unroll
        for (int e = 0; e < 8; ++e) { x[e] -= mean; s2 += x[e] * x[e]; }
        const float rstd = rsqrtf(wave_sum(s2) * (1.f / 512.f) + EPS); const int h = lane >> 4; const float w00 = P.in[14][(size_t)h * 16384], b0 = P.in[15][h * 128];
        float vg[8], sg[8];
#pragma unroll
        for (int e = 0; e < 8; ++e) { vg[e] = x[e] * rstd * lng[8 * lane + e] + lnb[8 * lane + e]; sg[e] = uu[e] * (w00 * vg[e] + b0); }
        *(f32x4*)(NSV + (size_t)bs * 512 + 8 * lane) = (f32x4){vg[0], vg[1], vg[2], vg[3]}; *(f32x4*)(NSV + (size_t)bs * 512 + 8 * lane + 4) = (f32x4){vg[4], vg[5], vg[6], vg[7]};
        u32x4 o; o.x = pk2(sg[0], sg[1]); o.y = pk2(sg[2], sg[3]); o.z = pk2(sg[4], sg[5]); o.w = pk2(sg[6], sg[7]); *(u32x4*)(MIX + srow * DM + 512 + 8 * lane) = o; }
}

constexpr int ST_BYTES = 60416;
__device__ __forceinline__ void glds16(const void* g, LAS unsigned char* l) { __builtin_amdgcn_global_load_lds((const unsigned*)g, (LAS unsigned*)l, 16, 0, 0); }
__device__ __forceinline__ void scan_issue1(const bf16* FRB, const bf16* ATf, const float* DECF, int unit, int sl, LAS unsigned char* L, int lane) {
    const bf16* w = FRB + FR_W + (size_t)unit * 8192 + lane * 8; const bf16* at = ATf + (size_t)unit * 4096 + lane * 8; const bf16* uu = FRB + FR_U + ((size_t)unit * 8 + sl) * 1024 + lane * 8;
#pragma unroll
    for (int f = 0; f < 16; ++f) glds16(w + f * 512, L + f * 1024);
#pragma unroll
    for (int f = 0; f < 8; ++f) glds16(at + f * 512, L + 49152 + f * 1024);
    glds16(uu, L + 57344); glds16(uu + 512, L + 58368);
    glds16(DECF + (size_t)unit * 256 + lane * 4, L + 59392);
}
__device__ __forceinline__ void scan_issue2(const bf16* FRB, int unit, LAS unsigned char* L, int lane) {
    const bf16* qg = FRB + FR_QG + (size_t)unit * 8192 + lane * 8; const bf16* kg = FRB + FR_KG + (size_t)unit * 8192 + lane * 8;
#pragma unroll
    for (int f = 0; f < 16; ++f) glds16(qg + f * 512, L + 16384 + f * 1024);
#pragma unroll
    for (int f = 0; f < 16; ++f) glds16(kg + f * 512, L + 32768 + f * 1024);
}
__device__ __forceinline__ void gdn_scan(const Params& P, LAS unsigned char* lds, volatile LAS unsigned* flg, int lane, int wave, int bid, int G) {
    if (wave > 2) return;
    asm volatile("" : "+v"(lane));
    unsigned char* ws = P.ws; const bf16* FRB = (const bf16*)P.out; const bf16* ATf = (const bf16*)(ws + WS_AT); const float* DECF = (const float*)(ws + WS_DECF);
    bf16* O = (bf16*)(ws + WS_O); float* NGP = P.out + O_NGP; const int c = lane & 15, q = lane >> 4;
    int gs = 0;
    for (int job = bid; job < 256; job += G, gs += 32) {
        const int bh = (job & 7) + 8 * (job >> 6), sl = (job >> 3) & 7, b = bh >> 2, h = bh & 3;
        if (wave != 0) {
            for (int n = 0; n < 32; ++n) {
                const int s_ = gs + n; LAS unsigned char* L = lds + (s_ & 1) * ST_BYTES;
                while ((int)flg[0] < s_ - 1) __builtin_amdgcn_s_sleep(1);
                asm volatile("" ::: "memory");
                if (wave == 1) scan_issue1(FRB, ATf, DECF, (b * 32 + n) * 4 + h, sl, L, lane); else scan_issue2(FRB, (b * 32 + n) * 4 + h, L, lane);
                asm volatile("s_waitcnt vmcnt(0)" ::: "memory");
                if (lane == 0) flg[wave] = (unsigned)(s_ + 1);
                asm volatile("s_waitcnt lgkmcnt(0)" ::: "memory");
            }
            continue;
        }
        f32x4 S[8];
#pragma unroll
        for (int i = 0; i < 8; ++i) S[i] = (f32x4){0.f, 0.f, 0.f, 0.f};
        for (int n = 0; n < 32; ++n) {
            const int s_ = gs + n; LAS unsigned char* L = lds + (s_ & 1) * ST_BYTES;
            while ((int)flg[1] < s_ + 1 || (int)flg[2] < s_ + 1) __builtin_amdgcn_s_sleep(1);
            asm volatile("" ::: "memory");
            bf16x8 Wfr[16], QGfr[16]; u32x2 Ufr[4];
#pragma unroll
            for (int f = 0; f < 16; ++f) Wfr[f] = *(const LAS bf16x8*)(L + f * 1024 + lane * 16);
#pragma unroll
            for (int mt = 0; mt < 4; ++mt) Ufr[mt] = *(const LAS u32x2*)(L + 57344 + mt * 512 + lane * 8);
#pragma unroll
            for (int f = 0; f < 16; ++f) QGfr[f] = *(const LAS bf16x8*)(L + 16384 + f * 1024 + lane * 16);
            __builtin_amdgcn_sched_barrier(0);
            bf16x8 Sb[4];
#pragma unroll
            for (int ks = 0; ks < 4; ++ks) Sb[ks] = pack8(S[2 * ks], S[2 * ks + 1]);
            f32x4 va[4], oa[4];
#pragma unroll
            for (int mt = 0; mt < 4; ++mt) { va[mt] = (f32x4){0.f, 0.f, 0.f, 0.f}; oa[mt] = va[mt]; }
#pragma unroll
            for (int ks = 0; ks < 4; ++ks)
#pragma unroll
                for (int mt = 0; mt < 4; ++mt) va[mt] = mfma16(Wfr[mt * 4 + ks], Sb[ks], va[mt]);
            __builtin_amdgcn_sched_barrier(0);
            bf16x8 ATfr[8];
#pragma unroll
            for (int f = 0; f < 8; ++f) ATfr[f] = *(const LAS bf16x8*)(L + 49152 + f * 1024 + lane * 16);
            const float dec = *(const LAS float*)(L + 59392 + lane * 4);
            __builtin_amdgcn_sched_barrier(0);
#pragma unroll
            for (int ks = 0; ks < 4; ++ks)
#pragma unroll
                for (int mt = 0; mt < 4; ++mt) oa[mt] = mfma16(QGfr[mt * 4 + ks], Sb[ks], oa[mt]);
            __builtin_amdgcn_sched_barrier(0);
            bf16x8 KGfr[16];
#pragma unroll
            for (int f = 0; f < 16; ++f) KGfr[f] = *(const LAS bf16x8*)(L + 32768 + f * 1024 + lane * 16);
            __builtin_amdgcn_sched_barrier(0);
            f32x4 vn[4];
#pragma unroll
            for (int mt = 0; mt < 4; ++mt) vn[mt] = (f32x4){bflo(Ufr[mt].x) - va[mt].x, bfhi(Ufr[mt].x) - va[mt].y, bflo(Ufr[mt].y) - va[mt].z, bfhi(Ufr[mt].y) - va[mt].w};
            bf16x8 vb[2];
#pragma unroll
            for (int k2 = 0; k2 < 2; ++k2) vb[k2] = pack8(vn[2 * k2], vn[2 * k2 + 1]);
#pragma unroll
            for (int mt = 0; mt < 8; ++mt) S[mt] = S[mt] * dec;
#pragma unroll
            for (int k2 = 0; k2 < 2; ++k2) {
#pragma unroll
                for (int mt = 0; mt < 8; ++mt) S[mt] = mfma16(KGfr[mt * 2 + k2], vb[k2], S[mt]);
#pragma unroll
                for (int mt = 0; mt < 4; ++mt) oa[mt] = mfma16(ATfr[mt * 2 + k2], vb[k2], oa[mt]);
            }
#pragma unroll
            for (int mt = 0; mt < 4; ++mt) {
                const bool od = lane & 1; const float t0 = dpp_get<0xB1, 0xF>(od ? oa[mt].x : oa[mt].z), t1 = dpp_get<0xB1, 0xF>(od ? oa[mt].y : oa[mt].w);
                unsigned* op = (unsigned*)(O + ((size_t)(b * 2048 + n * 64 + 16 * mt + 4 * q + (od ? 2 : 0))) * 512 + h * 128 + 16 * sl + (c & ~1));
                op[0] = od ? pk2(t0, oa[mt].z) : pk2(oa[mt].x, t0); op[256] = od ? pk2(t1, oa[mt].w) : pk2(oa[mt].y, t1); }
            asm volatile("s_waitcnt lgkmcnt(0)" ::: "memory");
            if (lane == 0) flg[0] = (unsigned)(s_ + 1);
            asm volatile("" ::: "memory");
        }
#pragma unroll
        for (int mt = 0; mt < 8; ++mt) { float* sp = NGP + ((size_t)(b * 4 + h) * 128 + 16 * mt + 4 * q) * 128 + 16 * sl + c; sp[0] = S[mt].x; sp[128] = S[mt].y; sp[256] = S[mt].z; sp[384] = S[mt].w; }
        asm volatile("s_waitcnt vmcnt(0)" ::: "memory");
    }
}

__device__ __forceinline__ void gdn_gate(const Params& P, int lane, int wave, int bid, int G) {
    unsigned char* ws = P.ws; const bf16* PROJ = (const bf16*)(ws + WS_PROJ); bf16* MIX = (bf16*)(ws + WS_MIX); const bf16* O = (const bf16*)(ws + WS_O); const float* gnorm = P.in[11];
    float gn[8];
#pragma unroll
    for (int e = 0; e < 8; ++e) gn[e] = gnorm[8 * (lane & 15) + e];
    for (int row0 = bid * 8 + wave; row0 < MPR; row0 += G * 32) {
        f32x4 a[4], b[4]; u32x4 zr[4];
#pragma unroll
        for (int u = 0; u < 4; ++u) { const int row = min(row0 + u * G * 8, MPR - 1); const u32x4 orw = *(const u32x4*)(O + (size_t)row * 512 + 8 * lane);
            a[u] = (f32x4){bflo(orw.x), bfhi(orw.x), bflo(orw.y), bfhi(orw.y)}; b[u] = (f32x4){bflo(orw.z), bfhi(orw.z), bflo(orw.w), bfhi(orw.w)};
            zr[u] = *(const u32x4*)(PROJ + (size_t)row * NIN + 1536 + 8 * lane); }
#pragma unroll
        for (int u = 0; u < 4; ++u) { const int row = row0 + u * G * 8;
            float s = dot4(a[u]) + dot4(b[u]); s += dpp_get<0xB1, 0xF>(s); s += dpp_get<0x4E, 0xF>(s); s += dpp_get<0x141, 0xF>(s); s += dpp_get<0x140, 0xF>(s);
            const float rs = rsqrtf(s * (1.f / 128.f) + EPS);
            u32x4 o; o.x = pk2(a[u].x * rs * gn[0] * siluf_(bflo(zr[u].x)), a[u].y * rs * gn[1] * siluf_(bfhi(zr[u].x))); o.y = pk2(a[u].z * rs * gn[2] * siluf_(bflo(zr[u].y)), a[u].w * rs * gn[3] * siluf_(bfhi(zr[u].y)));
            o.z = pk2(b[u].x * rs * gn[4] * siluf_(bflo(zr[u].z)), b[u].y * rs * gn[5] * siluf_(bfhi(zr[u].z))); o.w = pk2(b[u].z * rs * gn[6] * siluf_(bflo(zr[u].w)), b[u].w * rs * gn[7] * siluf_(bfhi(zr[u].w)));
            if (row < MPR) *(u32x4*)(MIX + (size_t)row * DM + 8 * lane) = o; }
    }
}
__device__ __forceinline__ void final_norm(const Params& P, int lane, int wave, int bid, int G) {
    const float* SS3 = (const float*)(P.ws + WS_SS3); const float* gf = P.in[23]; float* out = P.out; const bf16* X3 = (const bf16*)(P.ws + WS_HID);
    f32x4 g4[4];
#pragma unroll
    for (int j = 0; j < 2; ++j) { g4[2 * j] = *(const f32x4*)(gf + 512 * j + 8 * lane); g4[2 * j + 1] = *(const f32x4*)(gf + 512 * j + 8 * lane + 4); }
    for (int row0 = MPR + bid * 8 + wave; row0 < MT; row0 += G * 32) {
        u32x4 v[4][2]; float rs[4];
#pragma unroll
        for (int u = 0; u < 4; ++u) { const int row = min(row0 + u * G * 8, MT - 1); rs[u] = sum16(SS3 + (size_t)row * 16);
#pragma unroll
            for (int j = 0; j < 2; ++j) v[u][j] = *(const u32x4*)(X3 + (size_t)row * DM + 512 * j + 8 * lane); }
#pragma unroll
        for (int u = 0; u < 4; ++u) { const int row = row0 + u * G * 8; const float r = rsqrtf(rs[u] * (1.f / DM) + EPS);
            if (row < MT) {
#pragma unroll
                for (int j = 0; j < 2; ++j) { const u32x4 w = v[u][j]; float* o = out + (size_t)row * DM + 512 * j + 8 * lane;
                    *(f32x4*)o = (f32x4){bflo(w.x), bfhi(w.x), bflo(w.y), bfhi(w.y)} * r * g4[2 * j];
                    *(f32x4*)(o + 4) = (f32x4){bflo(w.z), bfhi(w.z), bflo(w.w), bfhi(w.w)} * r * g4[2 * j + 1]; } } }
    }
}
#define XB_TMO      128
#define XB_XCNT(j)  (256  + 64 * (j))
#define XB_XSUB(j)  (1280 + 64 * (j))
#define XB_XGEN(j)  (2304 + 64 * (j))
#define XB_TOP      3328
#define XB_TOPGEN   3392
#define XCD_BAR_WORDS 3456
#define XB_SPIN_CAP (1u << 18)

__device__ __forceinline__ unsigned xb_ld(unsigned* p)              { return __hip_atomic_load(p, __ATOMIC_RELAXED, __HIP_MEMORY_SCOPE_AGENT); }
__device__ __forceinline__ unsigned xb_add(unsigned* p, unsigned v) { return __hip_atomic_fetch_add(p, v, __ATOMIC_RELAXED, __HIP_MEMORY_SCOPE_AGENT); }
__device__ __forceinline__ unsigned xb_xcc_id() { return (unsigned)__builtin_amdgcn_s_getreg((3 << 11) | 20) & 0xFu; }
#define XB_SPIN(cond, bar) do { unsigned _sp = 0; while (cond) { __builtin_amdgcn_s_sleep(1); \
    if ((++_sp & 255u) == 0u) { if (xb_ld(&(bar)[XB_TMO])) break; if (_sp > XB_SPIN_CAP) { atomicAdd(&(bar)[XB_TMO], 1u); break; } } } } while (0)

struct XcdBarrier {
    unsigned* bar; unsigned x;
    volatile LAS unsigned* st;
};

__device__ __forceinline__ XcdBarrier xcd_barrier_post(unsigned* bar, volatile LAS unsigned* st) {
    XcdBarrier b; b.bar = bar; b.x = xb_xcc_id(); b.st = st;
    if (threadIdx.x == 0) (void)xb_add(&bar[XB_XCNT(b.x)], 1u);
    return b;
}
__device__ __forceinline__ void xcd_barrier_complete(unsigned* bar, unsigned x, unsigned& nloc, unsigned& nx) {
    const unsigned G = gridDim.x * gridDim.y * gridDim.z;
    unsigned sum, cnt, mine, sp = 0u;
    for (;;) {
        sum = 0u; cnt = 0u; mine = 0u;
#pragma unroll
        for (unsigned j = 0; j < 16; ++j) { const unsigned c = xb_ld(&bar[XB_XCNT(j)]); sum += c; cnt += (c > 0u) ? 1u : 0u; mine = (j == x) ? c : mine; }
        if (sum == G) break;
        __builtin_amdgcn_s_sleep(1);
        if ((++sp & 255u) == 0u) { if (xb_ld(&bar[XB_TMO])) break; if (sp > XB_SPIN_CAP) { atomicAdd(&bar[XB_TMO], 1u); break; } }
    }
    nloc = mine > 0u ? mine : 1u; nx = cnt > 0u ? cnt : 1u;
}

__device__ __forceinline__ void xcd_barrier(const XcdBarrier& b) {
    asm volatile("s_waitcnt vmcnt(0)" ::: "memory");
    __syncthreads();
    if (threadIdx.x == 0) {
        unsigned* bar = b.bar;
        __builtin_amdgcn_s_waitcnt(0);
        unsigned nloc = b.st[0], nx = b.st[1];
        if (nloc == 0u) { xcd_barrier_complete(bar, b.x, nloc, nx); b.st[0] = nloc; b.st[1] = nx; }
        const unsigned old = xb_add(&bar[XB_XSUB(b.x)], 1u);
        const unsigned gen = old / nloc;
        if (old + 1u == (gen + 1u) * nloc) {
            __builtin_amdgcn_fence(__ATOMIC_RELEASE, "agent");
            asm volatile("s_waitcnt vmcnt(0)" ::: "memory");
            const unsigned og = xb_add(&bar[XB_TOP], 1u);
            const unsigned tg = og / nx;
            if (og + 1u == (tg + 1u) * nx) xb_add(&bar[XB_TOPGEN], 1u);
            else XB_SPIN(xb_ld(&bar[XB_TOPGEN]) == tg, bar);
            __builtin_amdgcn_fence(__ATOMIC_ACQUIRE, "agent");
            xb_add(&bar[XB_XGEN(b.x)], 1u);
            asm volatile("s_waitcnt vmcnt(0)" ::: "memory");
        } else {
            XB_SPIN(xb_ld(&bar[XB_XGEN(b.x)]) == gen, bar);
            __builtin_amdgcn_fence(__ATOMIC_ACQUIRE, "agent");
            asm volatile("s_waitcnt vmcnt(0)" ::: "memory");
        }
    }
    __syncthreads();
}

__global__ void __launch_bounds__(512, 2) mega_fwd(Params P) {
    extern __shared__ __attribute__((aligned(16))) unsigned char lds_raw[];
    LAS unsigned char* lds = (LAS unsigned char*)lds_raw;
    const int bid = blockIdx.x, G = gridDim.x;
#define FRESH() int tid = threadIdx.x; asm volatile("" : "+v"(tid)); const int lane = tid & 63, wave = __builtin_amdgcn_readfirstlane(tid >> 6), gw = bid * 8 + wave, NGW = G * 8; (void)gw; (void)NGW; (void)lane

    volatile LAS unsigned* st = (volatile LAS unsigned*)(lds + LDS_BYTES - 64);
    if (threadIdx.x < 16) st[threadIdx.x] = 0u;
    __syncthreads();
    unsigned char* ws = P.ws;
    XcdBarrier bar = xcd_barrier_post((unsigned*)(ws + WS_CTL), st);
#define GRID_BAR() xcd_barrier(bar)
    bf16* XB = (bf16*)(ws + WS_XB); bf16* MIX = (bf16*)(ws + WS_MIX); bf16* PROJ = (bf16*)(ws + WS_PROJ); bf16* HID = (bf16*)(ws + WS_HID); bf16* PB = (bf16*)(ws + WS_PB);
    float* SS1 = (float*)(ws + WS_SS1); float* SS2 = (float*)(ws + WS_SS2); float* SS3 = (float*)(ws + WS_SS3);

    { FRESH(); phase0(P, lds, tid, lane, wave, bid, G); }
    GRID_BAR();
    {   FRESH();
        pg8::Gemm g{XB, (const bf16*)(ws + WS_WIN), MPR, NIN, DM}; pg8::StaticOrder S; S.init(MPR, NIN, G, bid);
        EpiGen<F1> E{F1{nullptr, (const float*)(ws + WS_RS0), PROJ}}; EpiGen8<F1> E8{E.f};
        pg8::gemm_phase<EpiGen8<F1>, pg8::StaticOrder, true, true>(lds, g, S, E8);
        small_gemm<2, 4>(XB + (size_t)MPR * DM, (const bf16*)(ws + WS_WIN), NIN, DM, E.f, lds, bid, G, wave, lane);
    }
    GRID_BAR();
    if ((bid & 3) == 1) { FRESH(); sample_gdn(P, lds, tid, lane, wave, bid, G); }
    if ((bid & 3) == 2) { FRESH(); sgu_prompt(P, lds, tid, lane, wave, bid, G); }
    { FRESH(); gdn_prep(P, lds, tid, lane, wave, bid, G); }
    if ((bid & 3) != 2) { FRESH(); sgu_prompt(P, lds, tid, lane, wave, bid, G); }
    if ((bid & 3) != 1) { FRESH(); sample_gdn(P, lds, tid, lane, wave, bid, G); }
    { FRESH(); phase2_misc(P, tid, lane, wave, bid, G); }
    GRID_BAR();
    { FRESH(); gdn_scan(P, lds, st + 4, lane, wave, bid, G);
      if (wave >= 3 && wave <= 5) weight_items(P, (LAS float*)(lds + 2 * ST_BYTES + (wave - 3) * 8448), lane, 1536, 6784, bid * 3 + (wave - 3), G * 3); }
    GRID_BAR();
    { FRESH(); gdn_gate(P, lane, wave, bid, G); }
    GRID_BAR();
    {   FRESH();
        pg8::Gemm g{MIX, (const bf16*)(ws + WS_WOUT), MPR, DM, DM}; pg8::StaticOrder S; S.init(MPR, DM, G, bid);
        EpiGen<F2> E{F2{SS1, XB}}; EpiGen8<F2> E8{E.f};
        pg8::gemm_phase<EpiGen8<F2>, pg8::StaticOrder, false, true>(lds, g, S, E8);
        small_gemm<2, 4>(MIX + (size_t)MPR * DM, (const bf16*)(ws + WS_WOUT), DM, DM, E.f, lds, bid, G, wave, lane);
    }
    GRID_BAR();
    {   FRESH();
        pg8::Gemm g{XB, (const bf16*)(ws + WS_WUP), MPR, FF, DM}; pg8::StaticOrder S; S.init(MPR, FF, G, bid);
        EpiGen<F3> E{F3{nullptr, SS1, HID}}; EpiGen8<F3> E8{E.f};
        pg8::gemm_phase<EpiGen8<F3>, pg8::StaticOrder, true, true>(lds, g, S, E8);
        small_gemm<2, 4>(XB + (size_t)MPR * DM, (const bf16*)(ws + WS_WUP), FF, DM, E.f, lds, bid, G, wave, lane);
    }
    GRID_BAR();
    {   FRESH();
        pg8::Gemm g{HID, (const bf16*)(ws + WS_WDN), MPR, DM, FF}; pg8::StaticOrder S; S.init(MPR, DM, G, bid);
        EpiGen<F4> E{F4{SS2, XB}}; EpiGen8<F4> E8{E.f};
        pg8::gemm_phase<EpiGen8<F4>, pg8::StaticOrder, false, true>(lds, g, S, E8);
        small_gemm<2, 4>(HID + (size_t)MPR * FF, (const bf16*)(ws + WS_WDN), DM, FF, E.f, lds, bid, G, wave, lane);
    }
    GRID_BAR();
    {   FRESH();
        bf16* PP = MIX;
        { pg8::Gemm g{PB, (const bf16*)(ws + WS_WPLE), MPR, DM, DPLE}; pg8::StaticOrder S; S.init(MPR, DM, G, bid);
          EpiGen<F5a> E{F5a{nullptr, PP}}; EpiGen8<F5a> E8{E.f};
          pg8::gemm_phase<EpiGen8<F5a>, pg8::StaticOrder, false, true>(lds, g, S, E8);
          small_gemm<2, 4>(PB + (size_t)MPR * DPLE, (const bf16*)(ws + WS_WPLE), DM, DPLE, E.f, lds, bid, G, wave, lane); }
        { pg8::Gemm g{XB, (const bf16*)(ws + WS_WG), MPR, DM, DM}; pg8::StaticOrder S; S.init(MPR, DM, G, bid);
          EpiGen<F5b> E{F5b{SS3, SS2, XB, PP, HID}};
          EpiFinal EF{SS2, XB, PP, P.out, P.in[23], (unsigned*)(ws + WS_XBUF), (unsigned*)(ws + WS_CTL + 16384)};
          pg8::gemm_phase<EpiFinal, pg8::StaticOrder, false, true>(lds, g, S, EF);
          small_gemm<2, 4>(XB + (size_t)MPR * DM, (const bf16*)(ws + WS_WG), DM, DM, E.f, lds, bid, G, wave, lane); }
    }
    GRID_BAR();
    { FRESH(); final_norm(P, lane, wave, bid, G); }
}

extern "C" void kernel_launch(void* const* d_in, const int* in_sizes, int n_in, void* d_out, int out_size, void* d_ws, size_t ws_size, hipStream_t stream) {
    static int grid = 0;
    if (grid == 0) {
        int dev = 0, cus = 0;
        if (hipGetDevice(&dev) != hipSuccess || hipDeviceGetAttribute(&cus, hipDeviceAttributeMultiprocessorCount, dev) != hipSuccess) { fprintf(stderr, "kernel_launch: device query failed\n"); grid = -1; return; }
        if (hipFuncSetAttribute((const void*)mega_fwd, hipFuncAttributeMaxDynamicSharedMemorySize, LDS_BYTES) != hipSuccess) { fprintf(stderr, "kernel_launch: hipFuncSetAttribute failed\n"); grid = -1; return; }
        int per_cu = 0;
        if (hipOccupancyMaxActiveBlocksPerMultiprocessor(&per_cu, (const void*)mega_fwd, 512, LDS_BYTES) != hipSuccess || per_cu < 1) fprintf(stderr, "kernel_launch: occupancy query reports %d\n", per_cu);
        (void)hipGetLastError();
        grid = cus < 256 ? cus : 256;
        if (n_in != 24 || ws_size < 256 * MiB) fprintf(stderr, "kernel_launch: unexpected n_in %d / ws %zu\n", n_in, ws_size);
    }
    if (grid < 0) return;
    (void)hipMemsetAsync((char*)d_ws + WS_CTL, 0, CTL_BYTES, stream);
    Params p{};
    for (int i = 0; i < 24; ++i) p.in[i] = (const float*)d_in[i];
    p.out = (float*)d_out; p.ws = (unsigned char*)d_ws;
    hipLaunchKernelGGL(mega_fwd, dim3(grid), dim3(512), LDS_BYTES, stream, p);
}
```

```cpp
#include <hip/hip_runtime.h>
#include <cstdio>
#include <cstdint>
namespace pg8 {
#define PG8_LAS __attribute__((address_space(3)))
typedef unsigned short bf16_t;
typedef short bf16x8 __attribute__((ext_vector_type(8)));
typedef float f32x4 __attribute__((ext_vector_type(4)));
typedef unsigned u32x4 __attribute__((ext_vector_type(4)));
constexpr int BM = 256, BK = 64, HALF = 128, HTB = HALF * BK * 2  , STAGE_BYTES = 8 * HTB, NXCD = 8, WGM = 8;

__host__ __device__ __forceinline__ int lds_byte(int r, int c) { const int st = (r >> 4) * 2 + (c >> 5), rr = r & 15, cc = c & 31, ob = rr * 64 + cc * 2; return st * 1024 + (ob ^ (((ob >> 9) & 1) << 5)); }
__host__ __device__ __forceinline__ void stage_rc(int b, int& R, int& C) { const int st = b / 1024, sb = b % 1024, swz = sb ^ (((sb >> 9) & 1) << 5); R = (st >> 1) * 16 + swz / 64; C = (st & 1) * 32 + (swz % 64) / 2; }
__host__ __device__ __forceinline__ int perm32(int rho) { const int n = rho >> 4, i = rho & 15; return 8 * (i >> 2) + 4 * n + (i & 3); }

struct Unit { int pm, pn; };
struct Gemm { const bf16_t* A; const bf16_t* Bt; int M, N, K; };

struct StaticOrder {
    int nM, nN, nwg, G, c;
    __host__ __device__ void init(int M, int N, int G_, int c_) { nM = M / BM; nN = N / BM; nwg = nM * nN; G = G_; c = c_; }
    __host__ __device__ bool next(int i, Unit& u) const {
        const long L = (long)i * G + c; if (L >= nwg) return false;
        int wgid = (int)L; { const int q = nwg / NXCD, r = nwg % NXCD, xcd = wgid % NXCD, off = wgid / NXCD; wgid = (xcd < r ? xcd * (q + 1) : r * (q + 1) + (xcd - r) * q) + off; }
        const int nig = WGM * nN, gid = wgid / nig, fm = gid * WGM, gsz = (nM - fm) < WGM ? (nM - fm) : WGM;
        u.pm = fm + ((wgid % nig) % gsz); u.pn = (wgid % nig) / gsz; return true;
    }
    __device__ __forceinline__ void a_ready(const Unit&) const {}
    __device__ __forceinline__ void done(const Unit&) const {}
};

__device__ __forceinline__ unsigned cvt_pk_bf16(float lo, float hi) { unsigned r; asm volatile("v_cvt_pk_bf16_f32 %0, %1, %2" : "=v"(r) : "v"(lo), "v"(hi)); return r; }
template <class Epi, class Sched, bool ALIGN_EPI = false, bool SP2 = false>
__device__ __forceinline__ void gemm_phase(PG8_LAS unsigned char* lds, const Gemm g, const Sched& S, const Epi& E) {
    int tid_ = threadIdx.x; asm volatile("" : "+v"(tid_));
    const int tid = tid_, wid = __builtin_amdgcn_readfirstlane(tid >> 6), lane = tid & 63, wr = wid >> 2, wc = wid & 3, fr = lane & 15, fq = lane >> 4;
    const int K = g.K, nt = K / BK;
    unsigned voffA[2], voffB[2];
#pragma unroll
    for (int i = 0; i < 2; ++i) { int R, C; stage_rc(tid * 16 + i * 8192, R, C); const int Rb = Epi::PERM ? ((R & ~31) + perm32(R & 31)) : R;
        voffA[i] = (unsigned)(R * K + C) * 2u; voffB[i] = (unsigned)(Rb * K + C) * 2u; }
    const size_t kstep = (size_t)(BK * 2);
    const size_t hstep = (size_t)HALF * K * 2;
    const size_t tstep = 2 * hstep;
    const unsigned ldsw = (unsigned)wid * 1024u;
    const int aoff = lds_byte(wr * 64 + fr, fq * 8), boff = lds_byte(wc * 32 + fr, fq * 8);
#define PG8_SA(b, h) (((b) * 2 + (h)) * HTB)
#define PG8_SB(b, h) ((4 + (b) * 2 + (h)) * HTB)
#define PG8_STAGE(bufoff, gbase, voff) do { _Pragma("unroll") for (int _i = 0; _i < 2; ++_i) \
        __builtin_amdgcn_global_load_lds((const unsigned*)((const char*)(gbase) + (voff)[_i]), (PG8_LAS unsigned*)(lds + (bufoff) + ldsw + _i * 8192), 16, 0, 0); } while (0)
#define PG8_LDA(dst, b, h) do { _Pragma("unroll") for (int m = 0; m < 4; ++m) _Pragma("unroll") for (int k = 0; k < 2; ++k) dst[m][k] = *(const PG8_LAS bf16x8*)(lds + PG8_SA(b, h) + aoff + m * 2048 + k * 1024); } while (0)
#define PG8_LDB(dst, b, h) do { _Pragma("unroll") for (int n = 0; n < 2; ++n) _Pragma("unroll") for (int k = 0; k < 2; ++k) dst[n][k] = *(const PG8_LAS bf16x8*)(lds + PG8_SB(b, h) + boff + n * 2048 + k * 1024); } while (0)
#define PG8_MMA(ai, bj, At, Bt) do { __builtin_amdgcn_s_setprio(1); _Pragma("unroll") for (int m = 0; m < 4; ++m) _Pragma("unroll") for (int n = 0; n < 2; ++n) _Pragma("unroll") for (int k = 0; k < 2; ++k) \
        acc[ai][bj][m][n] = __builtin_amdgcn_mfma_f32_16x16x32_bf16(Bt[n][k], At[m][k], acc[ai][bj][m][n], 0, 0, 0); __builtin_amdgcn_s_setprio(0); } while (0)
#define PG8_WAIT_V(n) asm volatile("s_waitcnt vmcnt(" #n ")" ::: "memory")
#define PG8_WAIT_L(n) asm volatile("s_waitcnt lgkmcnt(" #n ")" ::: "memory")
#define PG8_BAR __builtin_amdgcn_s_barrier()
#define PG8_SCHED __builtin_amdgcn_sched_barrier(0)
    Unit cur, nxt; int ui = 0;
    if (!S.next(0, cur)) return;
    f32x4 acc[2][2][4][2];
#pragma unroll
    for (int a = 0; a < 2; ++a)
#pragma unroll
        for (int b = 0; b < 2; ++b)
#pragma unroll
            for (int m = 0; m < 4; ++m)
#pragma unroll
                for (int n = 0; n < 2; ++n) acc[a][b][m][n] = (f32x4){0.f, 0.f, 0.f, 0.f};
    bf16x8 At[4][2], B0[2][2], B1[2][2];
    const char* cA = (const char*)g.A + (size_t)cur.pm * tstep; const char* cB = (const char*)g.Bt + (size_t)cur.pn * tstep;
    S.a_ready(cur);
    if constexpr (SP2) {
        PG8_STAGE(PG8_SB(0, 0), cB, voffB); PG8_STAGE(PG8_SB(0, 1), cB + hstep, voffB); PG8_STAGE(PG8_SA(0, 0), cA, voffA); PG8_STAGE(PG8_SA(0, 1), cA + hstep, voffA);
        if (wr == 1) PG8_BAR;
        PG8_WAIT_V(2); PG8_BAR;
        PG8_STAGE(PG8_SB(1, 0), cB + kstep, voffB); PG8_STAGE(PG8_SA(1, 0), cA + kstep, voffA); PG8_STAGE(PG8_SB(1, 1), cB + hstep + kstep, voffB);
        PG8_WAIT_V(6); PG8_BAR;
    } else {
        PG8_STAGE(PG8_SB(0, 0), cB, voffB); PG8_STAGE(PG8_SA(0, 0), cA, voffA); PG8_STAGE(PG8_SB(0, 1), cB + hstep, voffB); PG8_STAGE(PG8_SA(0, 1), cA + hstep, voffA);
        if (wr == 1) PG8_BAR;
        PG8_WAIT_V(4); PG8_BAR;
        PG8_STAGE(PG8_SB(1, 0), cB + kstep, voffB); PG8_STAGE(PG8_SA(1, 0), cA + kstep, voffA); PG8_STAGE(PG8_SB(1, 1), cB + hstep + kstep, voffB);
        PG8_WAIT_V(6); PG8_BAR;
    }
    for (;;) {
        const bool has_next = S.next(ui + 1, nxt);
        const char* nA = has_next ? (const char*)g.A + (size_t)nxt.pm * tstep : cA; const char* nB = has_next ? (const char*)g.Bt + (size_t)nxt.pn * tstep : cB;
        for (int t = 0; t < nt; t += 2) {
            const bool last = (t == nt - 2);
            const char* a1 = cA + (size_t)(t + 1) * kstep;
            const char* a2 = last ? nA : cA + (size_t)(t + 2) * kstep; const char* b2 = last ? nB : cB + (size_t)(t + 2) * kstep;
            const char* a3 = a2 + kstep; const char* b3 = b2 + kstep;
            if (last && has_next) S.a_ready(nxt);
            if constexpr (SP2) {
            PG8_LDB(B0, 0, 0); PG8_LDB(B1, 0, 1); PG8_SCHED; PG8_LDA(At, 0, 0); PG8_STAGE(PG8_SA(1, 1), a1 + hstep, voffA);
            PG8_WAIT_V(8); PG8_WAIT_L(0); PG8_BAR; PG8_MMA(0, 0, At, B0); PG8_MMA(0, 1, At, B1); PG8_BAR; PG8_SCHED;
            PG8_LDA(At, 0, 1); PG8_STAGE(PG8_SB(0, 0), b2, voffB); PG8_STAGE(PG8_SB(0, 1), b2 + hstep, voffB); PG8_STAGE(PG8_SA(0, 0), a2, voffA);
            PG8_WAIT_V(8); PG8_WAIT_L(0); PG8_BAR; PG8_MMA(1, 0, At, B0); PG8_MMA(1, 1, At, B1); PG8_BAR; PG8_SCHED;
            PG8_LDB(B0, 1, 0); PG8_LDB(B1, 1, 1); PG8_SCHED; PG8_LDA(At, 1, 0); PG8_STAGE(PG8_SA(0, 1), a2 + hstep, voffA);
            PG8_WAIT_V(8); PG8_WAIT_L(0); PG8_BAR; PG8_MMA(0, 0, At, B0); PG8_MMA(0, 1, At, B1); PG8_BAR; PG8_SCHED;
            PG8_LDA(At, 1, 1); PG8_STAGE(PG8_SB(1, 0), b3, voffB); PG8_STAGE(PG8_SB(1, 1), b3 + hstep, voffB); PG8_STAGE(PG8_SA(1, 0), a3, voffA);
            PG8_WAIT_V(8); PG8_WAIT_L(0); PG8_BAR; PG8_MMA(1, 0, At, B0); PG8_MMA(1, 1, At, B1); PG8_BAR; PG8_SCHED;
            } else {
            PG8_LDB(B0, 0, 0); PG8_SCHED; PG8_LDA(At, 0, 0); PG8_STAGE(PG8_SA(1, 1), a1 + hstep, voffA);
            PG8_WAIT_L(8); PG8_BAR; PG8_WAIT_L(0); PG8_MMA(0, 0, At, B0); PG8_BAR; PG8_SCHED;
            PG8_LDB(B1, 0, 1); PG8_STAGE(PG8_SB(0, 0), b2, voffB);
            PG8_BAR; PG8_WAIT_L(0); PG8_MMA(0, 1, At, B1); PG8_BAR;
            PG8_LDA(At, 0, 1); PG8_STAGE(PG8_SA(0, 0), a2, voffA);
            PG8_BAR; PG8_WAIT_L(0); PG8_MMA(1, 0, At, B0); PG8_BAR; PG8_SCHED;
            PG8_STAGE(PG8_SB(0, 1), b2 + hstep, voffB);
            PG8_WAIT_V(6); PG8_BAR; PG8_MMA(1, 1, At, B1); PG8_BAR;
            PG8_LDB(B0, 1, 0); PG8_SCHED; PG8_LDA(At, 1, 0); PG8_STAGE(PG8_SA(0, 1), a2 + hstep, voffA);
            PG8_WAIT_L(8); PG8_BAR; PG8_WAIT_L(0); PG8_MMA(0, 0, At, B0); PG8_BAR; PG8_SCHED;
            PG8_LDB(B1, 1, 1); PG8_STAGE(PG8_SB(1, 0), b3, voffB);
            PG8_BAR; PG8_WAIT_L(0); PG8_MMA(0, 1, At, B1); PG8_BAR;
            PG8_LDA(At, 1, 1); PG8_STAGE(PG8_SA(1, 0), a3, voffA);
            PG8_BAR; PG8_WAIT_L(0); PG8_MMA(1, 0, At, B0); PG8_BAR; PG8_SCHED;
            PG8_STAGE(PG8_SB(1, 1), b3 + hstep, voffB);
            PG8_WAIT_V(6); PG8_BAR; PG8_MMA(1, 1, At, B1); PG8_BAR;
            }
        }
        if constexpr (ALIGN_EPI) { if (wr == 0) PG8_BAR; }
        if constexpr (!Epi::AFTER_DRAIN) { E(acc, cur, wr, wc, fr, fq); S.done(cur); }
        if (!has_next) break;
#pragma unroll
        for (int a = 0; a < 2; ++a)
#pragma unroll
            for (int b = 0; b < 2; ++b)
#pragma unroll
                for (int m = 0; m < 4; ++m)
#pragma unroll
                    for (int n = 0; n < 2; ++n) acc[a][b][m][n] = (f32x4){0.f, 0.f, 0.f, 0.f};
        cur = nxt; cA = nA; cB = nB; ++ui;
        if constexpr (ALIGN_EPI) { if (wr == 1) PG8_BAR; }
    }
    PG8_WAIT_V(0);
    if constexpr (!ALIGN_EPI) { if (wr == 0) PG8_BAR; }
    PG8_BAR;
    if constexpr (Epi::AFTER_DRAIN) { E.fused(acc, cur, wr, wc, fr, fq, lds, wid, lane); S.done(cur); }
#undef PG8_SA
#undef PG8_SB
#undef PG8_STAGE
#undef PG8_LDA
#undef PG8_LDB
#undef PG8_MMA
#undef PG8_WAIT_V
#undef PG8_WAIT_L
#undef PG8_BAR
#undef PG8_SCHED
}
}

#define LAS __attribute__((address_space(3)))
typedef unsigned short bf16;
typedef float f32x4 __attribute__((ext_vector_type(4)));
typedef short bf16x8 __attribute__((ext_vector_type(8)));
typedef unsigned u32x4 __attribute__((ext_vector_type(4)));
typedef unsigned u32x2 __attribute__((ext_vector_type(2)));
#define LDS_WAIT() asm volatile("s_waitcnt lgkmcnt(0)" ::: "memory")
#define VM_WAIT() asm volatile("s_waitcnt vmcnt(0)" ::: "memory")

constexpr int MPR = 16384, MSA = 128, MT = MPR + MSA, DM = 1024, NIN = 3072, FF = 4096, DPLE = 256, SRCN = 3080;
constexpr float EPS = 1e-6f, QSCALE = 0.08838834764831845f;
constexpr int LDS_BYTES = 147456;
constexpr size_t MiB = 1u << 20;
constexpr size_t WS_RS0 = 0, WS_BETA = 128 * 1024, WS_G = 448 * 1024, WS_WSB = 1 * MiB, WS_SS1 = 2 * MiB, WS_SS2 = 3 * MiB + 256 * 1024, WS_SS3 = 4 * MiB + 512 * 1024;
constexpr size_t WS_WIN = 6 * MiB, WS_WOUT = 12 * MiB, WS_WUP = 14 * MiB, WS_WDN = 22 * MiB, WS_WG = 30 * MiB, WS_WPLE = 32 * MiB;
constexpr size_t WS_PB = 33 * MiB, WS_XB = 42 * MiB, WS_MIX = 75 * MiB, WS_PROJ = 108 * MiB, WS_HID = 108 * MiB, WS_AT = 205 * MiB, WS_O = 213 * MiB, WS_DECF = 246 * MiB, WS_XBUF = 247 * MiB, WS_CTL = 255 * MiB;
constexpr size_t CTL_BYTES = 32768;
constexpr size_t O_Y = 0, O_NCP = 16908288, O_NGP = 16945152, O_NCS = 17469440, O_NGS = 18059264, O_NSV = 26447872;
constexpr size_t FR_W = 0, FR_QG = 8 * MiB, FR_KG = 16 * MiB, FR_U = 24 * MiB;

__device__ __forceinline__ unsigned f2bf(float f) { unsigned u = __builtin_bit_cast(unsigned, f); return (u + 0x7fffu + ((u >> 16) & 1u)) >> 16; }
typedef float f32x2_t_ __attribute__((ext_vector_type(2))); typedef __bf16 bf16x2_t_ __attribute__((ext_vector_type(2)));
__device__ __forceinline__ unsigned pk2(float lo, float hi) { const f32x2_t_ v = {lo, hi}; const bf16x2_t_ b = __builtin_convertvector(v, bf16x2_t_); return __builtin_bit_cast(unsigned, b); }
__device__ __forceinline__ float bflo(unsigned u) { return __builtin_bit_cast(float, u << 16); }
__device__ __forceinline__ float bfhi(unsigned u) { return __builtin_bit_cast(float, u & 0xffff0000u); }
__device__ __forceinline__ float bf2f(bf16 v) { return __builtin_bit_cast(float, (unsigned)v << 16); }
__device__ __forceinline__ float sigmoidf_(float x) { return __builtin_amdgcn_rcpf(1.f + __expf(-x)); }
__device__ __forceinline__ float siluf_(float x) { return x * __builtin_amdgcn_rcpf(1.f + __expf(-x)); }
__device__ __forceinline__ float geluf_(float x) { const float u = 1.5957691216057308f * (x + 0.044715f * x * x * x); return x * __builtin_amdgcn_rcpf(1.f + __expf(-u)); }
template <int CTRL, int ROWMASK> __device__ __forceinline__ float dpp_get(float v) { return __builtin_bit_cast(float, __builtin_amdgcn_update_dpp(0, __builtin_bit_cast(int, v), CTRL, ROWMASK, 0xF, false)); }
__device__ __forceinline__ float wave_sum(float v) {
    v += dpp_get<0xB1, 0xF>(v); v += dpp_get<0x4E, 0xF>(v); v += dpp_get<0x141, 0xF>(v); v += dpp_get<0x140, 0xF>(v);
    v += dpp_get<0x142, 0xA>(v); v += dpp_get<0x143, 0xC>(v);
    return __builtin_bit_cast(float, __builtin_amdgcn_readlane(__builtin_bit_cast(int, v), 63));
}
__device__ __forceinline__ f32x4 mfma16(bf16x8 a, bf16x8 b, f32x4 c) { return __builtin_amdgcn_mfma_f32_16x16x32_bf16(a, b, c, 0, 0, 0); }
__device__ __forceinline__ bf16x8 pack8(f32x4 a, f32x4 b) { u32x4 w; w.x = pk2(a.x, a.y); w.y = pk2(a.z, a.w); w.z = pk2(b.x, b.y); w.w = pk2(b.z, b.w); return __builtin_bit_cast(bf16x8, w); }

struct Params { const float* in[24]; float* out; unsigned char* ws; };

template <class F> struct EpiGen {
    static constexpr bool PERM = false, AFTER_DRAIN = false;
    F f;
    __device__ __forceinline__ void operator()(const pg8::f32x4 (&acc)[2][2][4][2], const pg8::Unit& u, int wr, int wc, int fr, int fq) const {
#pragma unroll
        for (int ai = 0; ai < 2; ++ai)
#pragma unroll
            for (int m = 0; m < 4; ++m) {
                const int row = u.pm * 256 + ai * 128 + wr * 64 + m * 16 + fr;
                const float ctx = f.rowctx(row); float ss = 0.f;
#pragma unroll
                for (int bj = 0; bj < 2; ++bj)
#pragma unroll
                    for (int n = 0; n < 2; ++n) ss += f(row, u.pn * 256 + bj * 128 + wc * 32 + n * 16 + 4 * fq, acc[ai][bj][m][n], ctx);
                if (F::STATS) { ss += __shfl_xor(ss, 16); ss += __shfl_xor(ss, 32); if (fq == 0) f.ss[(size_t)row * 16 + u.pn * 4 + wc] = ss; }
            }
    }
};
template <class F> struct EpiGen8 {
    static constexpr bool PERM = true, AFTER_DRAIN = false;
    F f;
    __device__ __forceinline__ void operator()(const pg8::f32x4 (&acc)[2][2][4][2], const pg8::Unit& u, int wr, int wc, int fr, int fq) const {
#pragma unroll
        for (int ai = 0; ai < 2; ++ai)
#pragma unroll
            for (int m = 0; m < 4; ++m) {
                const int row = u.pm * 256 + ai * 128 + wr * 64 + m * 16 + fr; const float ctx = f.rowctx(row); float ss = 0.f;
#pragma unroll
                for (int bj = 0; bj < 2; ++bj) ss += f.op8(row, u.pn * 256 + bj * 128 + wc * 32 + 8 * fq, acc[ai][bj][m][0], acc[ai][bj][m][1], ctx);
                if (F::STATS) { ss += __shfl_xor(ss, 16); ss += __shfl_xor(ss, 32); if (fq == 0) f.ss[(size_t)row * 16 + u.pn * 4 + wc] = ss; }
            }
    }
};
__device__ __forceinline__ float sum16(const float* p) { const f32x4 a = *(const f32x4*)p, b = *(const f32x4*)(p + 4), c = *(const f32x4*)(p + 8), d = *(const f32x4*)(p + 12);
    return ((a.x + a.y) + (a.z + a.w)) + ((b.x + b.y) + (b.z + b.w)) + ((c.x + c.y) + (c.z + c.w)) + ((d.x + d.y) + (d.z + d.w)); }
__device__ __forceinline__ void st_bf4(bf16* p, f32x4 v) { u32x2 w; w.x = pk2(v.x, v.y); w.y = pk2(v.z, v.w); *(u32x2*)p = w; }
__device__ __forceinline__ float dot4(f32x4 v) { return (v.x * v.x + v.y * v.y) + (v.z * v.z + v.w * v.w); }

struct F1 { static constexpr bool STATS = false; float* ss; const float* rs0; bf16* proj;
    __device__ __forceinline__ float rowctx(int row) const { return rs0[row]; }
    __device__ __forceinline__ float operator()(int row, int col, f32x4 a, float rs) const { f32x4 v = a * rs;
        if (col >= 2048) { v.x = geluf_(v.x); v.y = geluf_(v.y); v.z = geluf_(v.z); v.w = geluf_(v.w); }
        st_bf4(proj + (size_t)row * NIN + col, v); return 0.f; }
    __device__ __forceinline__ float op8(int row, int col, f32x4 a0, f32x4 a1, float rs) const { f32x4 v0 = a0 * rs, v1 = a1 * rs;
        if (col >= 2048) { v0.x = geluf_(v0.x); v0.y = geluf_(v0.y); v0.z = geluf_(v0.z); v0.w = geluf_(v0.w); v1.x = geluf_(v1.x); v1.y = geluf_(v1.y); v1.z = geluf_(v1.z); v1.w = geluf_(v1.w); }
        u32x4 w; w.x = pk2(v0.x, v0.y); w.y = pk2(v0.z, v0.w); w.z = pk2(v1.x, v1.y); w.w = pk2(v1.z, v1.w); *(u32x4*)(proj + (size_t)row * NIN + col) = w; return 0.f; } };
struct F2 { static constexpr bool STATS = true; float* ss; bf16* xb;
    __device__ __forceinline__ float rowctx(int) const { return 0.f; }
    __device__ __forceinline__ float operator()(int row, int col, f32x4 a, float) const { bf16* p = xb + (size_t)row * DM + col; const u32x2 r = *(const u32x2*)p;
        const f32x4 x = (f32x4){bflo(r.x) + a.x, bfhi(r.x) + a.y, bflo(r.y) + a.z, bfhi(r.y) + a.w}; st_bf4(p, x); return dot4(x); }
    __device__ __forceinline__ float op8(int row, int col, f32x4 a0, f32x4 a1, float) const { bf16* p = xb + (size_t)row * DM + col; const u32x4 r = *(const u32x4*)p;
        const f32x4 x0 = (f32x4){bflo(r.x) + a0.x, bfhi(r.x) + a0.y, bflo(r.y) + a0.z, bfhi(r.y) + a0.w}, x1 = (f32x4){bflo(r.z) + a1.x, bfhi(r.z) + a1.y, bflo(r.w) + a1.z, bfhi(r.w) + a1.w};
        u32x4 w; w.x = pk2(x0.x, x0.y); w.y = pk2(x0.z, x0.w); w.z = pk2(x1.x, x1.y); w.w = pk2(x1.z, x1.w); *(u32x4*)p = w; return dot4(x0) + dot4(x1); } };
struct F3 { static constexpr bool STATS = false; float* ss; const float* ss1; bf16* hid;
    __device__ __forceinline__ float rowctx(int row) const { return rsqrtf(sum16(ss1 + (size_t)row * 16) * (1.f / DM) + EPS); }
    __device__ __forceinline__ float operator()(int row, int col, f32x4 a, float rs) const { f32x4 v = a * rs; v.x = fmaxf(v.x, 0.f); v.y = fmaxf(v.y, 0.f); v.z = fmaxf(v.z, 0.f); v.w = fmaxf(v.w, 0.f);
        st_bf4(hid + (size_t)row * FF + col, v * v); return 0.f; }
    __device__ __forceinline__ float op8(int row, int col, f32x4 a0, f32x4 a1, float rs) const { f32x4 v0 = a0 * rs, v1 = a1 * rs;
        v0.x = fmaxf(v0.x, 0.f); v0.y = fmaxf(v0.y, 0.f); v0.z = fmaxf(v0.z, 0.f); v0.w = fmaxf(v0.w, 0.f); v1.x = fmaxf(v1.x, 0.f); v1.y = fmaxf(v1.y, 0.f); v1.z = fmaxf(v1.z, 0.f); v1.w = fmaxf(v1.w, 0.f);
        v0 = v0 * v0; v1 = v1 * v1; u32x4 w; w.x = pk2(v0.x, v0.y); w.y = pk2(v0.z, v0.w); w.z = pk2(v1.x, v1.y); w.w = pk2(v1.z, v1.w); *(u32x4*)(hid + (size_t)row * FF + col) = w; return 0.f; } };
struct F4 { static constexpr bool STATS = true; float* ss; bf16* xb;
    __device__ __forceinline__ float rowctx(int) const { return 0.f; }
    __device__ __forceinline__ float operator()(int row, int col, f32x4 a, float) const { bf16* p = xb + (size_t)row * DM + col; const u32x2 r = *(const u32x2*)p;
        const f32x4 x = (f32x4){bflo(r.x) + a.x, bfhi(r.x) + a.y, bflo(r.y) + a.z, bfhi(r.y) + a.w}; st_bf4(p, x); return dot4(x); }
    __device__ __forceinline__ float op8(int row, int col, f32x4 a0, f32x4 a1, float) const { bf16* p = xb + (size_t)row * DM + col; const u32x4 r = *(const u32x4*)p;
        const f32x4 x0 = (f32x4){bflo(r.x) + a0.x, bfhi(r.x) + a0.y, bflo(r.y) + a0.z, bfhi(r.y) + a0.w}, x1 = (f32x4){bflo(r.z) + a1.x, bfhi(r.z) + a1.y, bflo(r.w) + a1.z, bfhi(r.w) + a1.w};
        u32x4 w; w.x = pk2(x0.x, x0.y); w.y = pk2(x0.z, x0.w); w.z = pk2(x1.x, x1.y); w.w = pk2(x1.z, x1.w); *(u32x4*)p = w; return dot4(x0) + dot4(x1); } };
struct F5a { static constexpr bool STATS = false; float* ss; bf16* pp;
    __device__ __forceinline__ float rowctx(int) const { return 0.f; }
    __device__ __forceinline__ float operator()(int row, int col, f32x4 a, float) const { st_bf4(pp + (size_t)row * DM + col, a); return 0.f; }
    __device__ __forceinline__ float op8(int row, int col, f32x4 a0, f32x4 a1, float) const { u32x4 w; w.x = pk2(a0.x, a0.y); w.y = pk2(a0.z, a0.w); w.z = pk2(a1.x, a1.y); w.w = pk2(a1.z, a1.w);
        *(u32x4*)(pp + (size_t)row * DM + col) = w; return 0.f; } };
struct F5b { static constexpr bool STATS = true; float* ss; const float* ss2; const bf16* xb; const bf16* pp; bf16* x3;
    __device__ __forceinline__ float rowctx(int row) const { return rsqrtf(sum16(ss2 + (size_t)row * 16) * (1.f / DM) + EPS); }
    __device__ __forceinline__ float operator()(int row, int col, f32x4 a, float rs) const { const size_t o = (size_t)row * DM + col; const u32x2 pr = *(const u32x2*)(pp + o), xr = *(const u32x2*)(xb + o);
        f32x4 x; x.x = bflo(xr.x) + bflo(pr.x) * sigmoidf_(a.x * rs); x.y = bfhi(xr.x) + bfhi(pr.x) * sigmoidf_(a.y * rs); x.z = bflo(xr.y) + bflo(pr.y) * sigmoidf_(a.z * rs); x.w = bfhi(xr.y) + bfhi(pr.y) * sigmoidf_(a.w * rs);
        st_bf4(x3 + o, x); return dot4(x); } };

struct EpiFinal {
    static constexpr bool PERM = true, AFTER_DRAIN = true;
    const float* ss2; const bf16* xb; const bf16* pp; float* out; const float* gfin; unsigned* xbuf; unsigned* cnt;
    __device__ __forceinline__ void fused(pg8::f32x4 (&acc)[2][2][4][2], const pg8::Unit& u, int wr, int wc, int fr, int fq, LAS unsigned char* lds, int wid, int lane) const {
        LAS float* Pt = (LAS float*)lds; LAS float* St = (LAS float*)(lds + 4096);
#pragma unroll
        for (int ai = 0; ai < 2; ++ai)
#pragma unroll
            for (int m = 0; m < 4; ++m) {
                const int row_l = ai * 128 + wr * 64 + m * 16 + fr; const size_t row = (size_t)u.pm * 256 + row_l;
                const float rs = rsqrtf(sum16(ss2 + row * 16) * (1.f / DM) + EPS); float ss = 0.f;
#pragma unroll
                for (int bj = 0; bj < 2; ++bj) { const size_t o = row * DM + u.pn * 256 + bj * 128 + wc * 32 + 8 * fq; const u32x4 pr = *(const u32x4*)(pp + o), xr = *(const u32x4*)(xb + o);
                    const f32x4 a0 = acc[ai][bj][m][0], a1 = acc[ai][bj][m][1]; f32x4 x0, x1;
                    x0.x = bflo(xr.x) + bflo(pr.x) * sigmoidf_(a0.x * rs); x0.y = bfhi(xr.x) + bfhi(pr.x) * sigmoidf_(a0.y * rs); x0.z = bflo(xr.y) + bflo(pr.y) * sigmoidf_(a0.z * rs); x0.w = bfhi(xr.y) + bfhi(pr.y) * sigmoidf_(a0.w * rs);
                    x1.x = bflo(xr.z) + bflo(pr.z) * sigmoidf_(a1.x * rs); x1.y = bfhi(xr.z) + bfhi(pr.z) * sigmoidf_(a1.y * rs); x1.z = bflo(xr.w) + bflo(pr.w) * sigmoidf_(a1.z * rs); x1.w = bfhi(xr.w) + bfhi(pr.w) * sigmoidf_(a1.w * rs);
                    acc[ai][bj][m][0] = x0; acc[ai][bj][m][1] = x1; ss += dot4(x0) + dot4(x1); }
                ss += __shfl_xor(ss, 16); ss += __shfl_xor(ss, 32);
                if (fq == 0) Pt[row_l * 4 + wc] = ss;
            }
        asm volatile("s_waitcnt lgkmcnt(0)" ::: "memory"); __builtin_amdgcn_s_barrier(); asm volatile("" ::: "memory");
        const int rl = wid * 32 + (lane & 31);
        if (lane < 32) { const f32x4 p4 = *(const LAS f32x4*)(Pt + rl * 4); const float tot = (p4.x + p4.y) + (p4.z + p4.w);
            __hip_atomic_store(xbuf + ((size_t)u.pm * 256 + rl) * 4 + u.pn, __builtin_bit_cast(unsigned, tot), __ATOMIC_RELAXED, __HIP_MEMORY_SCOPE_AGENT); }
        asm volatile("s_waitcnt vmcnt(0)" ::: "memory");
        if (lane == 0) __hip_atomic_fetch_add(cnt + 64 * u.pm, 1u, __ATOMIC_RELAXED, __HIP_MEMORY_SCOPE_AGENT);
        if (wid == 0) {
            unsigned sp = 0;
            while ((unsigned)__builtin_amdgcn_readfirstlane(__hip_atomic_load(cnt + 64 * u.pm, __ATOMIC_RELAXED, __HIP_MEMORY_SCOPE_AGENT)) < 32u) { __builtin_amdgcn_s_sleep(2); if (++sp > (1u << 22)) break; }
            __builtin_amdgcn_fence(__ATOMIC_ACQUIRE, "agent");
        }
        asm volatile("s_waitcnt vmcnt(0) lgkmcnt(0)" ::: "memory"); __builtin_amdgcn_s_barrier(); asm volatile("" ::: "memory");
        if (lane < 32) { float t = 0.f;
#pragma unroll
            for (int k = 0; k < 4; ++k) t += __builtin_bit_cast(float, __hip_atomic_load(xbuf + ((size_t)u.pm * 256 + rl) * 4 + k, __ATOMIC_RELAXED, __HIP_MEMORY_SCOPE_AGENT));
            St[rl] = rsqrtf(t * (1.f / DM) + EPS); }
        asm volatile("s_waitcnt lgkmcnt(0)" ::: "memory"); __builtin_amdgcn_s_barrier(); asm volatile("" ::: "memory");
#pragma unroll
        for (int ai = 0; ai < 2; ++ai)
#pragma unroll
            for (int m = 0; m < 4; ++m) {
                const int row_l = ai * 128 + wr * 64 + m * 16 + fr; const size_t row = (size_t)u.pm * 256 + row_l; const float r = St[row_l];
#pragma unroll
                for (int bj = 0; bj < 2; ++bj)
#pragma unroll
                    for (int n = 0; n < 2; ++n) { const int col = u.pn * 256 + bj * 128 + wc * 32 + 8 * fq + 4 * n;
                        *(f32x4*)(out + row * DM + col) = acc[ai][bj][m][n] * r * *(const f32x4*)(gfin + col); }
            }
    }
};

template <int RT, int UNR, class F> __device__ __forceinline__ void small_gemm(const bf16* A, const bf16* Bt, int N, int K, const F& f, LAS unsigned char* lds, int bid, int G, int wave, int lane) {
    const int c = lane & 15, q = lane >> 4; constexpr int NMH = 8 / RT; const int ntask = NMH * (N >> 6); const int kw = K >> 3;
    LAS f32x4* red = (LAS f32x4*)lds;
    for (int t = bid; t < ntask; t += G) {
        const int mh = t % NMH, ns = t / NMH;
        const bf16* ap = A + (size_t)(mh * RT * 16 + c) * K + wave * kw + 8 * q;
        const bf16* bp = Bt + (size_t)(ns * 64 + c) * K + wave * kw + 8 * q;
        f32x4 acc[RT][4];
#pragma unroll
        for (int i = 0; i < RT; ++i)
#pragma unroll
            for (int j = 0; j < 4; ++j) acc[i][j] = (f32x4){0.f, 0.f, 0.f, 0.f};
#pragma unroll UNR
        for (int k = 0; k < kw; k += 32) {
            bf16x8 a[RT], b[4];
#pragma unroll
            for (int i = 0; i < RT; ++i) a[i] = *(const bf16x8*)(ap + (size_t)i * 16 * K + k);
#pragma unroll
            for (int j = 0; j < 4; ++j) b[j] = *(const bf16x8*)(bp + (size_t)j * 16 * K + k);
#pragma unroll
            for (int i = 0; i < RT; ++i)
#pragma unroll
                for (int j = 0; j < 4; ++j) acc[i][j] = mfma16(b[j], a[i], acc[i][j]);
        }
#pragma unroll
        for (int i = 0; i < RT; ++i)
#pragma unroll
            for (int j = 0; j < 4; ++j) red[(wave * (RT * 4) + i * 4 + j) * 64 + lane] = acc[i][j];
        __syncthreads();
        if (wave < RT) {
            const int i = wave; const int row = MPR + mh * RT * 16 + i * 16 + c; const float ctx = f.rowctx(row); float ss = 0.f;
#pragma unroll
            for (int j = 0; j < 4; ++j) { f32x4 s = red[(i * 4 + j) * 64 + lane];
#pragma unroll
                for (int w = 1; w < 8; ++w) s += red[(w * (RT * 4) + i * 4 + j) * 64 + lane];
                ss += f(row, ns * 64 + j * 16 + 4 * q, s, ctx); }
            if (F::STATS) { ss += __shfl_xor(ss, 16); ss += __shfl_xor(ss, 32); if (q == 0) f.ss[(size_t)row * 16 + ns] = ss; }
        }
        __syncthreads();
    }
}

__device__ __forceinline__ void tr_item(const float* __restrict__ W, int N, int src_c0, bf16* WT, int K, int dst_r0, const float* __restrict__ gain, LAS float* scr, int k0, int lane) {
    const float gv = gain ? gain[k0 + lane] : 1.f;
    f32x4 wv[8];
#pragma unroll
    for (int i = 0; i < 8; ++i) wv[i] = *(const f32x4*)(W + (size_t)(k0 + 8 * i + (lane >> 3)) * N + src_c0 + 4 * (lane & 7));
#pragma unroll
    for (int i = 0; i < 8; ++i) {
        float g = 0.f;
#pragma unroll
        for (int r = 0; r < 8; ++r) { const float gr = __builtin_bit_cast(float, __builtin_amdgcn_readlane(__builtin_bit_cast(int, gv), 8 * i + r)); g = ((lane >> 3) == r) ? gr : g; }
        LAS float* d = scr + (8 * i + (lane >> 3)) * 33 + 4 * (lane & 7);
        d[0] = wv[i].x * g; d[1] = wv[i].y * g; d[2] = wv[i].z * g; d[3] = wv[i].w * g;
    }
    LDS_WAIT();
    const int c = lane & 7;
#pragma unroll
    for (int j = 0; j < 4; ++j) { const int n = (lane >> 3) + 8 * j; const LAS float* s = scr + (8 * c) * 33 + n;
        u32x4 o; o.x = pk2(s[0], s[33]); o.y = pk2(s[66], s[99]); o.z = pk2(s[132], s[165]); o.w = pk2(s[198], s[231]);
        *(u32x4*)(WT + (size_t)(dst_r0 + n) * K + k0 + 8 * c) = o; }
    LDS_WAIT();
}

__device__ __forceinline__ void weight_items(const Params& P, LAS float* scr, int lane, int first, int last, int start, int stride) {
    unsigned char* ws = P.ws; const float* w_in = P.in[7]; const float* g_mix = P.in[6];
    for (int it = first + start; it < last; it += stride) {
        int r = it;
        if (r < 1536) { const int nb = r >> 4, kb = r & 15; tr_item(w_in, SRCN, nb * 32 + (nb >= 64 ? 8 : 0), (bf16*)(ws + WS_WIN), 1024, nb * 32, g_mix, scr, kb * 64, lane); continue; } r -= 1536;
        if (r < 512) { const int nb = r >> 4, kb = r & 15; tr_item(P.in[16], 1024, nb * 32, (bf16*)(ws + WS_WOUT), 1024, nb * 32, nullptr, scr, kb * 64, lane); continue; } r -= 512;
        if (r < 2048) { const int nb = r >> 4, kb = r & 15; tr_item(P.in[18], 4096, nb * 32, (bf16*)(ws + WS_WUP), 1024, nb * 32, P.in[17], scr, kb * 64, lane); continue; } r -= 2048;
        if (r < 2048) { const int nb = r >> 6, kb = r & 63; tr_item(P.in[19], 1024, nb * 32, (bf16*)(ws + WS_WDN), 4096, nb * 32, nullptr, scr, kb * 64, lane); continue; } r -= 2048;
        if (r < 512) { const int nb = r >> 4, kb = r & 15; tr_item(P.in[22], 1024, nb * 32, (bf16*)(ws + WS_WG), 1024, nb * 32, P.in[20], scr, kb * 64, lane); continue; } r -= 512;
        { const int nb = r >> 2, kb = r & 3; tr_item(P.in[21], 1024, nb * 32, (bf16*)(ws + WS_WPLE), 256, nb * 32, nullptr, scr, kb * 64, lane); }
    }
}

__device__ __forceinline__ void phase0(const Params& P, LAS unsigned char* lds, int tid, int lane, int wave, int bid, int G) {
    unsigned char* ws = P.ws; const int gw = bid * 8 + wave, NGW = G * 8, gt = bid * 512 + tid, NGT = G * 512;
    const float* w_in = P.in[7]; const float* g_mix = P.in[6];
    LAS f32x4* W8 = (LAS f32x4*)(lds + 67584);
    for (int idx = tid; idx < 2048; idx += 512) {
        const int l = idx & 63, half = (idx >> 6) & 1, je = idx >> 7; const int k = 256 * (je >> 2) + 4 * l + (je & 3);
        const float g = g_mix[k]; const float* s = w_in + (size_t)k * SRCN + 2048 + 4 * half;
        W8[idx] = (f32x4){s[0] * g, s[1] * g, s[2] * g, s[3] * g};
    }
    { const float* w_s = P.in[14]; bf16* WSB = (bf16*)(ws + WS_WSB);
      for (int i = gt; i < 65536; i += NGT) { const int t = (i >> 7) & 127, s = i & 127; WSB[i] = (bf16)f2bf(s <= t ? w_s[i] : 0.f); } }
    { bf16* PB = (bf16*)(ws + WS_PB); const float* pp = P.in[4]; const float* ps = P.in[5];
      for (int i = gt; i < MT * 32; i += NGT) { const int row = i >> 5, c8 = i & 31; const float* src = row < MPR ? pp + (size_t)row * DPLE + c8 * 8 : ps + (size_t)(row - MPR) * DPLE + c8 * 8;
          const f32x4 a = *(const f32x4*)src, b = *(const f32x4*)(src + 4); u32x4 o; o.x = pk2(a.x, a.y); o.y = pk2(a.z, a.w); o.z = pk2(b.x, b.y); o.w = pk2(b.z, b.w); *(u32x4*)(PB + (size_t)i * 8) = o; } }
    weight_items(P, (LAS float*)(lds + wave * 8448), lane, 0, 1536, gw, NGW);
    __syncthreads();
    float* RS0 = (float*)(ws + WS_RS0); float* BETA = (float*)(ws + WS_BETA); float* GG = (float*)(ws + WS_G); bf16* XB = (bf16*)(ws + WS_XB);
    const float* a_log = P.in[9]; const float* dt_bias = P.in[10];
    f32x4 vnx[4];
    { const int row = gw < MT ? gw : MT - 1; const float* xr = row < MPR ? P.in[0] + (size_t)row * DM : P.in[1] + (size_t)(row - MPR) * DM;
#pragma unroll
      for (int j = 0; j < 4; ++j) vnx[j] = *(const f32x4*)(xr + 256 * j + 4 * lane); }
    for (int row = gw; row < MT; row += NGW) {
        f32x4 v[4]; float ss = 0.f;
#pragma unroll
        for (int j = 0; j < 4; ++j) { v[j] = vnx[j]; ss += dot4(v[j]); }
        { const int rn = (row + NGW < MT) ? row + NGW : row; const float* xr = rn < MPR ? P.in[0] + (size_t)rn * DM : P.in[1] + (size_t)(rn - MPR) * DM;
#pragma unroll
          for (int j = 0; j < 4; ++j) vnx[j] = *(const f32x4*)(xr + 256 * j + 4 * lane); }
#pragma unroll
        for (int j = 0; j < 4; ++j) st_bf4(XB + (size_t)row * DM + 256 * j + 4 * lane, v[j]);
        f32x4 d0 = (f32x4){0.f, 0.f, 0.f, 0.f}, d1 = d0;
#pragma unroll
        for (int j = 0; j < 4; ++j)
#pragma unroll
            for (int e = 0; e < 4; ++e) { const float xv = v[j][e]; d0 += W8[((j * 4 + e) * 2 + 0) * 64 + lane] * xv; d1 += W8[((j * 4 + e) * 2 + 1) * 64 + lane] * xv; }
        const bool b0 = lane & 1, b1 = lane & 2, b2 = lane & 4;
        float t0 = (b0 ? d1.x : d0.x) + __shfl_xor(b0 ? d0.x : d1.x, 1), t1 = (b0 ? d1.y : d0.y) + __shfl_xor(b0 ? d0.y : d1.y, 1);
        float t2 = (b0 ? d1.z : d0.z) + __shfl_xor(b0 ? d0.z : d1.z, 1), t3 = (b0 ? d1.w : d0.w) + __shfl_xor(b0 ? d0.w : d1.w, 1);
        float u0 = (b1 ? t2 : t0) + __shfl_xor(b1 ? t0 : t2, 2), u1 = (b1 ? t3 : t1) + __shfl_xor(b1 ? t1 : t3, 2);
        float w = (b2 ? u1 : u0) + __shfl_xor(b2 ? u0 : u1, 4);
        w += __shfl_xor(w, 8); w += __shfl_xor(w, 16); w += __shfl_xor(w, 32);
        ss = wave_sum(ss); const float rs = rsqrtf(ss * (1.f / DM) + EPS);
        if (lane < 8) { const int hh = 2 * ((lane >> 1) & 1) + ((lane >> 2) & 1);
            if (!(lane & 1)) BETA[(size_t)row * 4 + hh] = sigmoidf_(w * rs);
            else { const float xa = w * rs + dt_bias[hh]; const float sp = fmaxf(xa, 0.f) + log1pf(expf(-fabsf(xa))); GG[(size_t)row * 4 + hh] = -expf(a_log[hh]) * sp; } }
        if (lane == 0) RS0[row] = rs;
    }
}

__device__ __forceinline__ void gdn_prep(const Params& P, LAS unsigned char* lds, int tid, int lane, int wave, int bid, int G) {
    unsigned char* ws = P.ws; const bf16* PROJ = (const bf16*)(ws + WS_PROJ); const float* BETA = (const float*)(ws + WS_BETA); const float* GG = (const float*)(ws + WS_G);
    bf16* FRB = (bf16*)P.out; bf16* ATf = (bf16*)(ws + WS_AT); float* DECF = (float*)(ws + WS_DECF); const float* wconv = P.in[8];
    const int tid0 = tid;
    for (int u0 = bid * 2; u0 < 1024; u0 += G * 2) {
        int tid = tid0; asm volatile("" : "+v"(tid));
        const int lane = tid & 63, wv = __builtin_amdgcn_readfirstlane(tid >> 6), hb = wv >> 2, t = tid & 255, w4 = wv & 3, c = lane & 15, q = lane >> 4;
        LAS unsigned char* base = lds + hb * 70656;
        LAS bf16* q_l = (LAS bf16*)base; LAS bf16* k_l = (LAS bf16*)(base + 17408); LAS bf16* v_l = (LAS bf16*)(base + 34816);
        LAS float* A_l = (LAS float*)(base + 52224); LAS float* gc = (LAS float*)(base + 69632); LAS float* bt = gc + 64;
        const int unit = u0 + hb, cg = unit >> 2, h = unit & 3, n = cg & 31; const int row0 = cg * 64, tokb = 16 * w4;
        float y[3][16][2];
#pragma unroll
        for (int g3 = 0; g3 < 3; ++g3) {
            const int col = g3 * 512 + h * 128 + 2 * lane;
            const float w0a = wconv[col], w0b = wconv[col + 1], w1a = wconv[1536 + col], w1b = wconv[1536 + col + 1], w2a = wconv[3072 + col], w2b = wconv[3072 + col + 1], w3a = wconv[4608 + col], w3b = wconv[4608 + col + 1];
            const bf16* src = PROJ + (size_t)(row0 + tokb) * NIN + col;
            unsigned raw[19];
            const bool nohist = (n == 0 && w4 == 0);
#pragma unroll
            for (int i = 0; i < 19; ++i) raw[i] = (i < 3 && nohist) ? 0u : *(const unsigned*)(src + (ptrdiff_t)(i - 3) * NIN);
#pragma unroll
            for (int i = 0; i < 16; ++i) {
                const float ya = w0a * bflo(raw[i]) + w1a * bflo(raw[i + 1]) + w2a * bflo(raw[i + 2]) + w3a * bflo(raw[i + 3]);
                const float yb = w0b * bfhi(raw[i]) + w1b * bfhi(raw[i + 1]) + w2b * bfhi(raw[i + 2]) + w3b * bfhi(raw[i + 3]);
                y[g3][i][0] = siluf_(ya); y[g3][i][1] = siluf_(yb);
            }
        }
#pragma unroll
        for (int g3 = 0; g3 < 2; ++g3)
#pragma unroll
            for (int i = 0; i < 16; ++i) { const float s = wave_sum(y[g3][i][0] * y[g3][i][0] + y[g3][i][1] * y[g3][i][1]); const float r = rsqrtf(s + 1e-6f); y[g3][i][0] *= r; y[g3][i][1] *= r; }
#pragma unroll
        for (int i = 0; i < 16; ++i) {
            *(LAS unsigned*)(q_l + (tokb + i) * 136 + 2 * lane) = pk2(y[0][i][0], y[0][i][1]);
            *(LAS unsigned*)(k_l + (tokb + i) * 136 + 2 * lane) = pk2(y[1][i][0], y[1][i][1]);
            *(LAS unsigned*)(v_l + (tokb + i) * 136 + 2 * lane) = pk2(y[2][i][0], y[2][i][1]);
        }
        if (w4 == 0) {
            int lane = tid; asm volatile("" : "+v"(lane)); lane &= 63;
            float g = GG[(size_t)(row0 + lane) * 4 + h];
#pragma unroll
            for (int o = 1; o < 64; o <<= 1) { const float tt = __shfl_up(g, o); if (lane >= o) g += tt; }
            const float btv = BETA[(size_t)(row0 + lane) * 4 + h]; gc[lane] = g; bt[lane] = btv; gc[128 + lane] = btv * __expf(g);
            const float dl = __expf(__shfl(g, 63));
            *(f32x4*)(DECF + (size_t)unit * 256 + lane * 4) = (f32x4){dl, dl, dl, dl};
        }
        __syncthreads();
        {
            const int it = w4; bf16x8 qf[4], kif[4];
#pragma unroll
            for (int kd = 0; kd < 4; ++kd) { qf[kd] = *(const LAS bf16x8*)(q_l + (16 * it + c) * 136 + 32 * kd + 8 * q); kif[kd] = *(const LAS bf16x8*)(k_l + (16 * it + c) * 136 + 32 * kd + 8 * q); }
            const int ii = 16 * it + c; const float gci = gc[ii];
            float atv[2][8];
#pragma unroll
            for (int jt = 0; jt < 4; ++jt) {
                if (jt <= it) {
                    f32x4 aq = (f32x4){0.f, 0.f, 0.f, 0.f}, ak = aq;
#pragma unroll
                    for (int kd = 0; kd < 4; ++kd) { const bf16x8 kjf = *(const LAS bf16x8*)(k_l + (16 * jt + c) * 136 + 32 * kd + 8 * q); aq = mfma16(kjf, qf[kd], aq); ak = mfma16(kif[kd], kjf, ak); }
                    const f32x4 gj = *(const LAS f32x4*)(gc + 16 * jt + 4 * q); f32x4 av;
                    const f32x4 gi4 = *(const LAS f32x4*)(gc + 16 * it + 4 * q), bi4 = *(const LAS f32x4*)(bt + 16 * it + 4 * q); const float gcj = gc[16 * jt + c];
#pragma unroll
                    for (int r = 0; r < 4; ++r) { const int j = 16 * jt + 4 * q + r; const float dec = (j <= ii) ? __expf(gci - gj[r]) : 0.f;
                        atv[jt >> 1][(jt & 1) * 4 + r] = aq[r] * dec * QSCALE;
                        const int i2 = 16 * it + 4 * q + r, j2 = 16 * jt + c; av[r] = (j2 < i2) ? ak[r] * bi4[r] * __expf(gi4[r] - gcj) : 0.f; }
                    *(LAS f32x4*)(A_l + (16 * jt + c) * 68 + 16 * it + 4 * q) = av;
                } else {
#pragma unroll
                    for (int r = 0; r < 4; ++r) atv[jt >> 1][(jt & 1) * 4 + r] = 0.f;
                }
            }
#pragma unroll
            for (int ks = 0; ks < 2; ++ks) { u32x4 o; o.x = pk2(atv[ks][0], atv[ks][1]); o.y = pk2(atv[ks][2], atv[ks][3]); o.z = pk2(atv[ks][4], atv[ks][5]); o.w = pk2(atv[ks][6], atv[ks][7]);
                *(u32x4*)(ATf + ((size_t)unit * 8 + it * 2 + ks) * 512 + lane * 8) = o; }
        }
        {
            const float gl = gc[63];
#pragma unroll
            for (int e = 0; e < 4; ++e) {
                const int f = w4 + 4 * e;
                { const int mt = f >> 2, ks = f & 3, tok = 16 * mt + c; const float sc = __expf(gc[tok]) * QSCALE;
                  const u32x2 lo = *(const LAS u32x2*)(q_l + tok * 136 + 32 * ks + 4 * q), hi = *(const LAS u32x2*)(q_l + tok * 136 + 32 * ks + 16 + 4 * q);
                  u32x4 o; o.x = pk2(bflo(lo.x) * sc, bfhi(lo.x) * sc); o.y = pk2(bflo(lo.y) * sc, bfhi(lo.y) * sc); o.z = pk2(bflo(hi.x) * sc, bfhi(hi.x) * sc); o.w = pk2(bflo(hi.y) * sc, bfhi(hi.y) * sc);
                  *(u32x4*)(FRB + FR_QG + (size_t)unit * 8192 + f * 512 + lane * 8) = o; }
                { const int mt = f >> 1, ks2 = f & 1; float kv[8];
#pragma unroll
                  for (int jj = 0; jj < 8; ++jj) { const int tok = 32 * ks2 + 16 * (jj >> 2) + 4 * q + (jj & 3); kv[jj] = bf2f(k_l[tok * 136 + 16 * mt + c]) * __expf(gl - gc[tok]); }
                  u32x4 o; o.x = pk2(kv[0], kv[1]); o.y = pk2(kv[2], kv[3]); o.z = pk2(kv[4], kv[5]); o.w = pk2(kv[6], kv[7]);
                  *(u32x4*)(FRB + FR_KG + (size_t)unit * 8192 + f * 512 + lane * 8) = o; }
            }
        }
        int t5 = t; asm volatile("" : "+v"(t5));
        const int col = t5 & 127, kind = __builtin_amdgcn_readfirstlane(t5 >> 7);
        typedef float f32x2s __attribute__((ext_vector_type(2)));
        f32x2s sp[32];
        {
            const LAS bf16* srcl = kind ? k_l : v_l;
#pragma unroll
            for (int i = 0; i < 64; ++i) { const float m = (kind ? gc + 128 : bt)[i]; sp[i >> 1][i & 1] = bf2f(srcl[i * 136 + col]) * m; }
        }
        __syncthreads();
        {
#pragma clang loop unroll(full)
            for (int j = 0; j < 63; ++j) {
                f32x4 avc[16];
#pragma unroll
                for (int v = (j + 1) >> 2; v < 16; ++v) avc[v] = *(const LAS f32x4*)(A_l + j * 68 + 4 * v);
                __builtin_amdgcn_sched_barrier(0);
                const float sj = sp[j >> 1][j & 1]; const f32x2s sj2 = (f32x2s){sj, sj};
#pragma unroll
                for (int v = (j + 1) >> 2; v < 16; ++v) { const f32x4 a = avc[v];
                    sp[2 * v] -= (f32x2s){a.x, a.y} * sj2; sp[2 * v + 1] -= (f32x2s){a.z, a.w} * sj2; }
                __builtin_amdgcn_sched_barrier(0);
            }
        }
        {
            LAS bf16* dstl = kind ? k_l : v_l;
#pragma unroll
            for (int i = 0; i < 64; ++i) dstl[i * 136 + col] = (bf16)f2bf(sp[i >> 1][i & 1]);
        }
        __syncthreads();
        { int l7 = tid; asm volatile("" : "+v"(l7)); const int c = l7 & 15, q = (l7 >> 4) & 3, lane = l7 & 63;
#pragma unroll
        for (int e = 0; e < 4; ++e) { const int f = w4 + 4 * e, mt = f >> 2, ks = f & 3, tok = 16 * mt + c;
            const u32x2 lo = *(const LAS u32x2*)(k_l + tok * 136 + 32 * ks + 4 * q), hi = *(const LAS u32x2*)(k_l + tok * 136 + 32 * ks + 16 + 4 * q);
            *(u32x4*)(FRB + FR_W + (size_t)unit * 8192 + f * 512 + lane * 8) = (u32x4){lo.x, lo.y, hi.x, hi.y}; }
#pragma unroll
        for (int e = 0; e < 8; ++e) { const int f = w4 + 4 * e, sl = f >> 2, mt = f & 3; const LAS bf16* s = v_l + (16 * mt + 4 * q) * 136 + 16 * sl + c;
            u32x2 o; o.x = (unsigned)s[0] | ((unsigned)s[136] << 16); o.y = (unsigned)s[272] | ((unsigned)s[408] << 16);
            *(u32x2*)(FRB + FR_U + ((size_t)unit * 32 + f) * 256 + lane * 4) = o; }
        }
        __syncthreads();
    }
}

__device__ __forceinline__ void sgu_prompt(const Params& P, LAS unsigned char* lds, int tid, int lane, int wave, int bid, int G) {
    asm volatile("" : "+v"(tid)); lane = tid & 63;
    unsigned char* ws = P.ws; const bf16* PROJ = (const bf16*)(ws + WS_PROJ); bf16* MIX = (bf16*)(ws + WS_MIX); const bf16* WSB = (const bf16*)(ws + WS_WSB);
    const float* lng = P.in[12]; const float* lnb = P.in[13]; const float* b_s = P.in[15];
    LAS bf16* vgT = (LAS bf16*)lds; const int c = lane & 15, q = lane >> 4;
    float lg[8], lb[8];
#pragma unroll
    for (int e = 0; e < 8; ++e) { lg[e] = lng[8 * lane + e]; lb[e] = lnb[8 * lane + e]; }
    for (int su = bid; su < 256; su += G) {
        const int b = su >> 5, n = (su >> 1) & 15, hp = su & 1; const int row0 = b * 2048 + n * 128;
        u32x4 rawv[16];
#pragma unroll
        for (int i = 0; i < 16; ++i) rawv[i] = *(const u32x4*)(PROJ + (size_t)(row0 + 16 * wave + i) * NIN + 2560 + 8 * lane);
        unsigned pkv[8][8];
#pragma unroll
        for (int i2 = 0; i2 < 8; ++i2) {
            float xa[8], xb2[8];
#pragma unroll
            for (int hh = 0; hh < 2; ++hh) {
                const u32x4 raw = rawv[2 * i2 + hh];
                float x[8] = {bflo(raw.x), bfhi(raw.x), bflo(raw.y), bfhi(raw.y), bflo(raw.z), bfhi(raw.z), bflo(raw.w), bfhi(raw.w)};
                float s = 0.f;
#pragma unroll
                for (int e = 0; e < 8; ++e) s += x[e];
                const float mean = wave_sum(s) * (1.f / 512.f); float s2 = 0.f;
#pragma unroll
                for (int e = 0; e < 8; ++e) { x[e] -= mean; s2 += x[e] * x[e]; }
                const float rstd = rsqrtf(wave_sum(s2) * (1.f / 512.f) + EPS);
#pragma unroll
                for (int e = 0; e < 8; ++e) { const float vn_ = x[e] * rstd * lg[e] + lb[e]; if (hh == 0) xa[e] = vn_; else xb2[e] = vn_; }
            }
#pragma unroll
            for (int e = 0; e < 8; ++e) pkv[e][i2] = pk2(xa[e], xb2[e]);
        }
        if ((q >> 1) == hp) {
#pragma unroll
            for (int e = 0; e < 8; ++e) {
                LAS bf16* rowp = vgT + (q & 1) * 17408 + (8 * c + e) * 136;
                *(LAS u32x4*)(rowp + 8 * ((2 * wave) ^ c)) = (u32x4){pkv[e][0], pkv[e][1], pkv[e][2], pkv[e][3]};
                *(LAS u32x4*)(rowp + 8 * ((2 * wave + 1) ^ c)) = (u32x4){pkv[e][4], pkv[e][5], pkv[e][6], pkv[e][7]};
            }
        }
        __syncthreads();
#pragma unroll 1
        for (int hh = 0; hh < 2; ++hh) { const int h = 2 * hp + hh; const LAS bf16* vgh = vgT + hh * 17408;
        f32x4 acc[8]; u32x2 upre[8]; const float bias_pre = b_s[h * 128 + 16 * wave + c];
#pragma unroll
        for (int nt = 0; nt < 8; ++nt) { acc[nt] = (f32x4){0.f, 0.f, 0.f, 0.f}; upre[nt] = *(const u32x2*)(PROJ + ((size_t)row0 + 16 * wave + c) * NIN + 2048 + h * 128 + 16 * nt + 4 * q); }
        for (int ks = 0; ks <= (wave >> 1); ++ks) {
            const bf16x8 bfr = *(const bf16x8*)(WSB + (size_t)(h * 128 + 16 * wave + c) * 128 + 32 * ks + 8 * q);
#pragma unroll
            for (int nt = 0; nt < 8; ++nt) { const int d = 16 * nt + c; const bf16x8 afr = *(const LAS bf16x8*)(vgh + d * 136 + 8 * ((4 * ks + q) ^ ((d >> 3) & 15))); acc[nt] = mfma16(afr, bfr, acc[nt]); }
        }
        { const int tt = 16 * wave + c; const size_t row = (size_t)row0 + tt; const float bias = bias_pre;
#pragma unroll
          for (int nt = 0; nt < 8; ++nt) { const int d0 = 16 * nt + 4 * q; const u32x2 ur = upre[nt];
              f32x4 o; o.x = bflo(ur.x) * (acc[nt].x + bias); o.y = bfhi(ur.x) * (acc[nt].y + bias); o.z = bflo(ur.y) * (acc[nt].z + bias); o.w = bfhi(ur.y) * (acc[nt].w + bias);
              st_bf4(MIX + row * DM + 512 + h * 128 + d0, o); } }
        }
        __syncthreads();
    }
}

__device__ __forceinline__ void sample_gdn(const Params& P, LAS unsigned char* lds, int tid, int lane, int wave, int bid, int G) {
    asm volatile("" : "+v"(tid)); lane = tid & 63;
    unsigned char* ws = P.ws; const bf16* PROJ = (const bf16*)(ws + WS_PROJ); bf16* MIX = (bf16*)(ws + WS_MIX); const float* BETA = (const float*)(ws + WS_BETA); const float* GG = (const float*)(ws + WS_G);
    const float* sconv = P.in[2]; const float* sgdn = P.in[3]; const float* wconv = P.in[8]; const float* gnorm = P.in[11];
    float* NCS = P.out + O_NCS; float* NGS = P.out + O_NGS;
    LAS float* sm = (LAS float*)lds; LAS float* scal = sm + 384; LAS f32x4* red = (LAS f32x4*)(sm + 512);
    const int dv4 = tid & 31, dkg = tid >> 5;
    for (int su = bid; su < 512; su += G) {
        const int bs = su >> 2, h = su & 3; const size_t srow = (size_t)MPR + bs;
        const float* S0 = sgdn + (size_t)(bs * 4 + h) * 16384 + (size_t)(8 * dkg) * 128 + 4 * dv4;
        f32x4 s0[8];
#pragma unroll
        for (int i = 0; i < 8; ++i) s0[i] = *(const f32x4*)(S0 + (size_t)i * 128);
        if (tid < 384) { const int g3 = tid >> 7, ch = tid & 127, col = g3 * 512 + h * 128 + ch;
            const float x = bf2f(PROJ[srow * NIN + col]); const float h0 = sconv[(size_t)(bs * 3 + 0) * 1536 + col], h1 = sconv[(size_t)(bs * 3 + 1) * 1536 + col], h2 = sconv[(size_t)(bs * 3 + 2) * 1536 + col];
            const float yv = siluf_(wconv[col] * h0 + wconv[1536 + col] * h1 + wconv[3072 + col] * h2 + wconv[4608 + col] * x);
            NCS[(size_t)(bs * 3 + 0) * 1536 + col] = h1; NCS[(size_t)(bs * 3 + 1) * 1536 + col] = h2; NCS[(size_t)(bs * 3 + 2) * 1536 + col] = x;
            sm[g3 * 128 + ch] = yv; }
        __syncthreads();
        if (wave < 2) { const float a = sm[wave * 128 + lane], b2 = sm[wave * 128 + 64 + lane]; const float s = wave_sum(a * a + b2 * b2); if (lane == 0) scal[wave] = rsqrtf(s + 1e-6f); }
        __syncthreads();
        const float qn = scal[0], kn = scal[1];
        const float beta = BETA[srow * 4 + h], eg = __expf(GG[srow * 4 + h]);
        float kk[8], qq[8]; f32x4 p = (f32x4){0.f, 0.f, 0.f, 0.f};
#pragma unroll
        for (int i = 0; i < 8; ++i) { kk[i] = sm[128 + 8 * dkg + i] * kn; qq[i] = sm[8 * dkg + i] * qn; p += s0[i] * kk[i]; }
        red[dkg * 32 + dv4] = p;
        __syncthreads();
        f32x4 kS = red[dv4];
#pragma unroll
        for (int g = 1; g < 16; ++g) kS += red[g * 32 + dv4];
        const f32x4 v4 = *(const LAS f32x4*)(sm + 256 + 4 * dv4); const f32x4 vnew = (v4 - kS * eg) * beta;
        __syncthreads();
        f32x4 po = (f32x4){0.f, 0.f, 0.f, 0.f}; float* S1 = NGS + (size_t)(bs * 4 + h) * 16384 + (size_t)(8 * dkg) * 128 + 4 * dv4;
#pragma unroll
        for (int i = 0; i < 8; ++i) { const f32x4 s1 = s0[i] * eg + vnew * kk[i]; *(f32x4*)(S1 + (size_t)i * 128) = s1; po += s1 * qq[i]; }
        red[dkg * 32 + dv4] = po;
        __syncthreads();
        if (tid < 32) { f32x4 o = red[dv4];
#pragma unroll
            for (int g = 1; g < 16; ++g) o += red[g * 32 + dv4];
            o = o * QSCALE; float s = dot4(o); s += __shfl_xor(s, 1); s += __shfl_xor(s, 2); s += __shfl_xor(s, 4); s += __shfl_xor(s, 8); s += __shfl_xor(s, 16);
            const float rs = rsqrtf(s * (1.f / 128.f) + EPS); const u32x2 zr = *(const u32x2*)(PROJ + srow * NIN + 1536 + h * 128 + 4 * dv4); const f32x4 gn = *(const f32x4*)(gnorm + 4 * dv4);
            f32x4 m; m.x = o.x * rs * gn.x * siluf_(bflo(zr.x)); m.y = o.y * rs * gn.y * siluf_(bfhi(zr.x)); m.z = o.z * rs * gn.z * siluf_(bflo(zr.y)); m.w = o.w * rs * gn.w * siluf_(bfhi(zr.y));
            st_bf4(MIX + srow * DM + h * 128 + 4 * dv4, m); }
        __syncthreads();
    }
}

__device__ __forceinline__ void phase2_misc(const Params& P, int tid, int lane, int wave, int bid, int G) {
    unsigned char* ws = P.ws; const bf16* PROJ = (const bf16*)(ws + WS_PROJ); bf16* MIX = (bf16*)(ws + WS_MIX);
    { float* NCP = P.out + O_NCP; for (int i = bid * 512 + tid; i < 36864; i += G * 512) { const int b = i / 4608, rem = i - b * 4608, j = rem / 1536, col = rem - j * 1536; NCP[i] = bf2f(PROJ[(size_t)(b * 2048 + 2045 + j) * NIN + col]); } }
    const int gw = bid * 8 + wave;
    if (gw < MSA) { const int bs = gw; const size_t srow = (size_t)MPR + bs; const float* lng = P.in[12]; const float* lnb = P.in[13]; float* NSV = P.out + O_NSV;
        const u32x4 raw = *(const u32x4*)(PROJ + srow * NIN + 2560 + 8 * lane); const u32x4 uraw = *(const u32x4*)(PROJ + srow * NIN + 2048 + 8 * lane);
        float x[8] = {bflo(raw.x), bfhi(raw.x), bflo(raw.y), bfhi(raw.y), bflo(raw.z), bfhi(raw.z), bflo(raw.w), bfhi(raw.w)};
        const float uu[8] = {bflo(uraw.x), bfhi(uraw.x), bflo(uraw.y), bfhi(uraw.y), bflo(uraw.z), bfhi(uraw.z), bflo(uraw.w), bfhi(uraw.w)};
        float s = 0.f;
#pragma unroll
        for (int e = 0; e < 8; ++e) s += x[e];
        const float mean = wave_sum(s) * (1.f / 512.f); float s2 = 0.f;
#pragma unroll
        for (int e = 0; e < 8; ++e) { x[e] -= mean; s2 += x[e] * x[e]; }
        const float rstd = rsqrtf(wave_sum(s2) * (1.f / 512.f) + EPS); const int h = lane >> 4; const float w00 = P.in[14][(size_t)h * 16384], b0 = P.in[15][h * 128];
        float vg[8], sg[8];
#pragma unroll
        for (int e = 0; e < 8; ++e) { vg[e] = x[e] * rstd * lng[8 * lane + e] + lnb[8 * lane + e]; sg[e] = uu[e] * (w00 * vg[e] + b0); }
        *(f32x4*)(NSV + (size_t)bs * 512 + 8 * lane) = (f32x4){vg[0], vg[1], vg[2], vg[3]}; *(f32x4*)(NSV + (size_t)bs * 512 + 8 * lane + 4) = (f32x4){vg[4], vg[5], vg[6], vg[7]};
        u32x4 o; o.x = pk2(sg[0], sg[1]); o.y = pk2(sg[2], sg[3]); o.z = pk2(sg[4], sg[5]); o.w = pk2(sg[6], sg[7]); *(u32x4*)(MIX + srow * DM + 512 + 8 * lane) = o; }
}

constexpr int ST_BYTES = 60416;
__device__ __forceinline__ void glds16(const void* g, LAS unsigned char* l) { __builtin_amdgcn_global_load_lds((const unsigned*)g, (LAS unsigned*)l, 16, 0, 0); }
__device__ __forceinline__ void scan_issue1(const bf16* FRB, const bf16* ATf, const float* DECF, int unit, int sl, LAS unsigned char* L, int lane) {
    const bf16* w = FRB + FR_W + (size_t)unit * 8192 + lane * 8; const bf16* at = ATf + (size_t)unit * 4096 + lane * 8; const bf16* uu = FRB + FR_U + ((size_t)unit * 8 + sl) * 1024 + lane * 8;
#pragma unroll
    for (int f = 0; f < 16; ++f) glds16(w + f * 512, L + f * 1024);
#pragma unroll
    for (int f = 0; f < 8; ++f) glds16(at + f * 512, L + 49152 + f * 1024);
    glds16(uu, L + 57344); glds16(uu + 512, L + 58368);
    glds16(DECF + (size_t)unit * 256 + lane * 4, L + 59392);
}
__device__ __forceinline__ void scan_issue2(const bf16* FRB, int unit, LAS unsigned char* L, int lane) {
    const bf16* qg = FRB + FR_QG + (size_t)unit * 8192 + lane * 8; const bf16* kg = FRB + FR_KG + (size_t)unit * 8192 + lane * 8;
#pragma unroll
    for (int f = 0; f < 16; ++f) glds16(qg + f * 512, L + 16384 + f * 1024);
#pragma unroll
    for (int f = 0; f < 16; ++f) glds16(kg + f * 512, L + 32768 + f * 1024);
}
__device__ __forceinline__ void gdn_scan(const Params& P, LAS unsigned char* lds, volatile LAS unsigned* flg, int lane, int wave, int bid, int G) {
    if (wave > 2) return;
    asm volatile("" : "+v"(lane));
    unsigned char* ws = P.ws; const bf16* FRB = (const bf16*)P.out; const bf16* ATf = (const bf16*)(ws + WS_AT); const float* DECF = (const float*)(ws + WS_DECF);
    bf16* O = (bf16*)(ws + WS_O); float* NGP = P.out + O_NGP; const int c = lane & 15, q = lane >> 4;
    int gs = 0;
    for (int job = bid; job < 256; job += G, gs += 32) {
        const int bh = (job & 7) + 8 * (job >> 6), sl = (job >> 3) & 7, b = bh >> 2, h = bh & 3;
        if (wave != 0) {
            for (int n = 0; n < 32; ++n) {
                const int s_ = gs + n; LAS unsigned char* L = lds + (s_ & 1) * ST_BYTES;
                while ((int)flg[0] < s_ - 1) __builtin_amdgcn_s_sleep(1);
                asm volatile("" ::: "memory");
                if (wave == 1) scan_issue1(FRB, ATf, DECF, (b * 32 + n) * 4 + h, sl, L, lane); else scan_issue2(FRB, (b * 32 + n) * 4 + h, L, lane);
                asm volatile("s_waitcnt vmcnt(0)" ::: "memory");
                if (lane == 0) flg[wave] = (unsigned)(s_ + 1);
                asm volatile("s_waitcnt lgkmcnt(0)" ::: "memory");
            }
            continue;
        }
        f32x4 S[8];
#pragma unroll
        for (int i = 0; i < 8; ++i) S[i] = (f32x4){0.f, 0.f, 0.f, 0.f};
        for (int n = 0; n < 32; ++n) {
            const int s_ = gs + n; LAS unsigned char* L = lds + (s_ & 1) * ST_BYTES;
            while ((int)flg[1] < s_ + 1 || (int)flg[2] < s_ + 1) __builtin_amdgcn_s_sleep(1);
            asm volatile("" ::: "memory");
            bf16x8 Wfr[16], QGfr[16]; u32x2 Ufr[4];
#pragma unroll
            for (int f = 0; f < 16; ++f) Wfr[f] = *(const LAS bf16x8*)(L + f * 1024 + lane * 16);
#pragma unroll
            for (int mt = 0; mt < 4; ++mt) Ufr[mt] = *(const LAS u32x2*)(L + 57344 + mt * 512 + lane * 8);
#pragma unroll
            for (int f = 0; f < 16; ++f) QGfr[f] = *(const LAS bf16x8*)(L + 16384 + f * 1024 + lane * 16);
            __builtin_amdgcn_sched_barrier(0);
            bf16x8 Sb[4];
#pragma unroll
            for (int ks = 0; ks < 4; ++ks) Sb[ks] = pack8(S[2 * ks], S[2 * ks + 1]);
            f32x4 va[4], oa[4];
#pragma unroll
            for (int mt = 0; mt < 4; ++mt) { va[mt] = (f32x4){0.f, 0.f, 0.f, 0.f}; oa[mt] = va[mt]; }
#pragma unroll
            for (int ks = 0; ks < 4; ++ks)
#pragma unroll
                for (int mt = 0; mt < 4; ++mt) va[mt] = mfma16(Wfr[mt * 4 + ks], Sb[ks], va[mt]);
            __builtin_amdgcn_sched_barrier(0);
            bf16x8 ATfr[8];
#pragma unroll
            for (int f = 0; f < 8; ++f) ATfr[f] = *(const LAS bf16x8*)(L + 49152 + f * 1024 + lane * 16);
            const float dec = *(const LAS float*)(L + 59392 + lane * 4);
            __builtin_amdgcn_sched_barrier(0);
#pragma unroll
            for (int ks = 0; ks < 4; ++ks)
#pragma unroll
                for (int mt = 0; mt < 4; ++mt) oa[mt] = mfma16(QGfr[mt * 4 + ks], Sb[ks], oa[mt]);
            __builtin_amdgcn_sched_barrier(0);
            bf16x8 KGfr[16];
#pragma unroll
            for (int f = 0; f < 16; ++f) KGfr[f] = *(const LAS bf16x8*)(L + 32768 + f * 1024 + lane * 16);
            __builtin_amdgcn_sched_barrier(0);
            f32x4 vn[4];
#pragma unroll
            for (int mt = 0; mt < 4; ++mt) vn[mt] = (f32x4){bflo(Ufr[mt].x) - va[mt].x, bfhi(Ufr[mt].x) - va[mt].y, bflo(Ufr[mt].y) - va[mt].z, bfhi(Ufr[mt].y) - va[mt].w};
            bf16x8 vb[2];
#pragma unroll
            for (int k2 = 0; k2 < 2; ++k2) vb[k2] = pack8(vn[2 * k2], vn[2 * k2 + 1]);
#pragma unroll
            for (int mt = 0; mt < 8; ++mt) S[mt] = S[mt] * dec;
#pragma unroll
            for (int k2 = 0; k2 < 2; ++k2) {
#pragma unroll
                for (int mt = 0; mt < 8; ++mt) S[mt] = mfma16(KGfr[mt * 2 + k2], vb[k2], S[mt]);
#pragma unroll
                for (int mt = 0; mt < 4; ++mt) oa[mt] = mfma16(ATfr[mt * 2 + k2], vb[k2], oa[mt]);
            }
#pragma unroll
            for (int mt = 0; mt < 4; ++mt) {
                const bool od = lane & 1; const float t0 = dpp_get<0xB1, 0xF>(od ? oa[mt].x : oa[mt].z), t1 = dpp_get<0xB1, 0xF>(od ? oa[mt].y : oa[mt].w);
                unsigned* op = (unsigned*)(O + ((size_t)(b * 2048 + n * 64 + 16 * mt + 4 * q + (od ? 2 : 0))) * 512 + h * 128 + 16 * sl + (c & ~1));
                op[0] = od ? pk2(t0, oa[mt].z) : pk2(oa[mt].x, t0); op[256] = od ? pk2(t1, oa[mt].w) : pk2(oa[mt].y, t1); }
            asm volatile("s_waitcnt lgkmcnt(0)" ::: "memory");
            if (lane == 0) flg[0] = (unsigned)(s_ + 1);
            asm volatile("" ::: "memory");
        }
#pragma unroll
        for (int mt = 0; mt < 8; ++mt) { float* sp = NGP + ((size_t)(b * 4 + h) * 128 + 16 * mt + 4 * q) * 128 + 16 * sl + c; sp[0] = S[mt].x; sp[128] = S[mt].y; sp[256] = S[mt].z; sp[384] = S[mt].w; }
        asm volatile("s_waitcnt vmcnt(0)" ::: "memory");
    }
}

__device__ __forceinline__ void gdn_gate(const Params& P, int lane, int wave, int bid, int G) {
    unsigned char* ws = P.ws; const bf16* PROJ = (const bf16*)(ws + WS_PROJ); bf16* MIX = (bf16*)(ws + WS_MIX); const bf16* O = (const bf16*)(ws + WS_O); const float* gnorm = P.in[11];
    float gn[8];
#pragma unroll
    for (int e = 0; e < 8; ++e) gn[e] = gnorm[8 * (lane & 15) + e];
    for (int row0 = bid * 8 + wave; row0 < MPR; row0 += G * 32) {
        f32x4 a[4], b[4]; u32x4 zr[4];
#pragma unroll
        for (int u = 0; u < 4; ++u) { const int row = min(row0 + u * G * 8, MPR - 1); const u32x4 orw = *(const u32x4*)(O + (size_t)row * 512 + 8 * lane);
            a[u] = (f32x4){bflo(orw.x), bfhi(orw.x), bflo(orw.y), bfhi(orw.y)}; b[u] = (f32x4){bflo(orw.z), bfhi(orw.z), bflo(orw.w), bfhi(orw.w)};
            zr[u] = *(const u32x4*)(PROJ + (size_t)row * NIN + 1536 + 8 * lane); }
#pragma unroll
        for (int u = 0; u < 4; ++u) { const int row = row0 + u * G * 8;
            float s = dot4(a[u]) + dot4(b[u]); s += dpp_get<0xB1, 0xF>(s); s += dpp_get<0x4E, 0xF>(s); s += dpp_get<0x141, 0xF>(s); s += dpp_get<0x140, 0xF>(s);
            const float rs = rsqrtf(s * (1.f / 128.f) + EPS);
            u32x4 o; o.x = pk2(a[u].x * rs * gn[0] * siluf_(bflo(zr[u].x)), a[u].y * rs * gn[1] * siluf_(bfhi(zr[u].x))); o.y = pk2(a[u].z * rs * gn[2] * siluf_(bflo(zr[u].y)), a[u].w * rs * gn[3] * siluf_(bfhi(zr[u].y)));
            o.z = pk2(b[u].x * rs * gn[4] * siluf_(bflo(zr[u].z)), b[u].y * rs * gn[5] * siluf_(bfhi(zr[u].z))); o.w = pk2(b[u].z * rs * gn[6] * siluf_(bflo(zr[u].w)), b[u].w * rs * gn[7] * siluf_(bfhi(zr[u].w)));
            if (row < MPR) *(u32x4*)(MIX + (size_t)row * DM + 8 * lane) = o; }
    }
}
__device__ __forceinline__ void final_norm(const Params& P, int lane, int wave, int bid, int G) {
    const float* SS3 = (const float*)(P.ws + WS_SS3); const float* gf = P.in[23]; float* out = P.out; const bf16* X3 = (const bf16*)(P.ws + WS_HID);
    f32x4 g4[4];
#pragma unroll
    for (int j = 0; j < 2; ++j) { g4[2 * j] = *(const f32x4*)(gf + 512 * j + 8 * lane); g4[2 * j + 1] = *(const f32x4*)(gf + 512 * j + 8 * lane + 4); }
    for (int row0 = MPR + bid * 8 + wave; row0 < MT; row0 += G * 32) {
        u32x4 v[4][2]; float rs[4];
#pragma unroll
        for (int u = 0; u < 4; ++u) { const int row = min(row0 + u * G * 8, MT - 1); rs[u] = sum16(SS3 + (size_t)row * 16);
#pragma unroll
            for (int j = 0; j < 2; ++j) v[u][j] = *(const u32x4*)(X3 + (size_t)row * DM + 512 * j + 8 * lane); }
#pragma unroll
        for (int u = 0; u < 4; ++u) { const int row = row0 + u * G * 8; const float r = rsqrtf(rs[u] * (1.f / DM) + EPS);
            if (row < MT) {
#pragma unroll
                for (int j = 0; j < 2; ++j) { const u32x4 w = v[u][j]; float* o = out + (size_t)row * DM + 512 * j + 8 * lane;
                    *(f32x4*)o = (f32x4){bflo(w.x), bfhi(w.x), bflo(w.y), bfhi(w.y)} * r * g4[2 * j];
                    *(f32x4*)(o + 4) = (f32x4){bflo(w.z), bfhi(w.z), bflo(w.w), bfhi(w.w)} * r * g4[2 * j + 1]; } } }
    }
}
#define XB_TMO      128
#define XB_XCNT(j)  (256  + 64 * (j))
#define XB_XSUB(j)  (1280 + 64 * (j))
#define XB_XGEN(j)  (2304 + 64 * (j))
#define XB_TOP      3328
#define XB_TOPGEN   3392
#define XCD_BAR_WORDS 3456
#define XB_SPIN_CAP (1u << 18)

__device__ __forceinline__ unsigned xb_ld(unsigned* p)              { return __hip_atomic_load(p, __ATOMIC_RELAXED, __HIP_MEMORY_SCOPE_AGENT); }
__device__ __forceinline__ unsigned xb_add(unsigned* p, unsigned v) { return __hip_atomic_fetch_add(p, v, __ATOMIC_RELAXED, __HIP_MEMORY_SCOPE_AGENT); }
__device__ __forceinline__ unsigned xb_xcc_id() { return (unsigned)__builtin_amdgcn_s_getreg((3 << 11) | 20) & 0xFu; }
#define XB_SPIN(cond, bar) do { unsigned _sp = 0; while (cond) { __builtin_amdgcn_s_sleep(1); \
    if ((++_sp & 255u) == 0u) { if (xb_ld(&(bar)[XB_TMO])) break; if (_sp > XB_SPIN_CAP) { atomicAdd(&(bar)[XB_TMO], 1u); break; } } } } while (0)

struct XcdBarrier {
    unsigned* bar; unsigned x;
    volatile LAS unsigned* st;
};

__device__ __forceinline__ XcdBarrier xcd_barrier_post(unsigned* bar, volatile LAS unsigned* st) {
    XcdBarrier b; b.bar = bar; b.x = xb_xcc_id(); b.st = st;
    if (threadIdx.x == 0) (void)xb_add(&bar[XB_XCNT(b.x)], 1u);
    return b;
}
__device__ __forceinline__ void xcd_barrier_complete(unsigned* bar, unsigned x, unsigned& nloc, unsigned& nx) {
    const unsigned G = gridDim.x * gridDim.y * gridDim.z;
    unsigned sum, cnt, mine, sp = 0u;
    for (;;) {
        sum = 0u; cnt = 0u; mine = 0u;
#pragma unroll
        for (unsigned j = 0; j < 16; ++j) { const unsigned c = xb_ld(&bar[XB_XCNT(j)]); sum += c; cnt += (c > 0u) ? 1u : 0u; mine = (j == x) ? c : mine; }
        if (sum == G) break;
        __builtin_amdgcn_s_sleep(1);
        if ((++sp & 255u) == 0u) { if (xb_ld(&bar[XB_TMO])) break; if (sp > XB_SPIN_CAP) { atomicAdd(&bar[XB_TMO], 1u); break; } }
    }
    nloc = mine > 0u ? mine : 1u; nx = cnt > 0u ? cnt : 1u;
}

__device__ __forceinline__ void xcd_barrier(const XcdBarrier& b) {
    asm volatile("s_waitcnt vmcnt(0)" ::: "memory");
    __syncthreads();
    if (threadIdx.x == 0) {
        unsigned* bar = b.bar;
        __builtin_amdgcn_s_waitcnt(0);
        unsigned nloc = b.st[0], nx = b.st[1];
        if (nloc == 0u) { xcd_barrier_complete(bar, b.x, nloc, nx); b.st[0] = nloc; b.st[1] = nx; }
        const unsigned old = xb_add(&bar[XB_XSUB(b.x)], 1u);
        const unsigned gen = old / nloc;
        if (old + 1u == (gen + 1u) * nloc) {
            __builtin_amdgcn_fence(__ATOMIC_RELEASE, "agent");
            asm volatile("s_waitcnt vmcnt(0)" ::: "memory");
            const unsigned og = xb_add(&bar[XB_TOP], 1u);
            const unsigned tg = og / nx;
            if (og + 1u == (tg + 1u) * nx) xb_add(&bar[XB_TOPGEN], 1u);
            else XB_SPIN(xb_ld(&bar[XB_TOPGEN]) == tg, bar);
            __builtin_amdgcn_fence(__ATOMIC_ACQUIRE, "agent");
            xb_add(&bar[XB_XGEN(b.x)], 1u);
            asm volatile("s_waitcnt vmcnt(0)" ::: "memory");
        } else {
            XB_SPIN(xb_ld(&bar[XB_XGEN(b.x)]) == gen, bar);
            __builtin_amdgcn_fence(__ATOMIC_ACQUIRE, "agent");
            asm volatile("s_waitcnt vmcnt(0)" ::: "memory");
        }
    }
    __syncthreads();
}

__global__ void __launch_bounds__(512, 2) mega_fwd(Params P) {
    extern __shared__ __attribute__((aligned(16))) unsigned char lds_raw[];
    LAS unsigned char* lds = (LAS unsigned char*)lds_raw;
    const int bid = blockIdx.x, G = gridDim.x;
#define FRESH() int tid = threadIdx.x; asm volatile("" : "+v"(tid)); const int lane = tid & 63, wave = __builtin_amdgcn_readfirstlane(tid >> 6), gw = bid * 8 + wave, NGW = G * 8; (void)gw; (void)NGW; (void)lane

    volatile LAS unsigned* st = (volatile LAS unsigned*)(lds + LDS_BYTES - 64);
    if (threadIdx.x < 16) st[threadIdx.x] = 0u;
    __syncthreads();
    unsigned char* ws = P.ws;
    XcdBarrier bar = xcd_barrier_post((unsigned*)(ws + WS_CTL), st);
#define GRID_BAR() xcd_barrier(bar)
    bf16* XB = (bf16*)(ws + WS_XB); bf16* MIX = (bf16*)(ws + WS_MIX); bf16* PROJ = (bf16*)(ws + WS_PROJ); bf16* HID = (bf16*)(ws + WS_HID); bf16* PB = (bf16*)(ws + WS_PB);
    float* SS1 = (float*)(ws + WS_SS1); float* SS2 = (float*)(ws + WS_SS2); float* SS3 = (float*)(ws + WS_SS3);

    { FRESH(); phase0(P, lds, tid, lane, wave, bid, G); }
    GRID_BAR();
    {   FRESH();
        pg8::Gemm g{XB, (const bf16*)(ws + WS_WIN), MPR, NIN, DM}; pg8::StaticOrder S; S.init(MPR, NIN, G, bid);
        EpiGen<F1> E{F1{nullptr, (const float*)(ws + WS_RS0), PROJ}}; EpiGen8<F1> E8{E.f};
        pg8::gemm_phase<EpiGen8<F1>, pg8::StaticOrder, true, true>(lds, g, S, E8);
        small_gemm<2, 4>(XB + (size_t)MPR * DM, (const bf16*)(ws + WS_WIN), NIN, DM, E.f, lds, bid, G, wave, lane);
    }
    GRID_BAR();
    if ((bid & 3) == 1) { FRESH(); sample_gdn(P, lds, tid, lane, wave, bid, G); }
    if ((bid & 3) == 2) { FRESH(); sgu_prompt(P, lds, tid, lane, wave, bid, G); }
    { FRESH(); gdn_prep(P, lds, tid, lane, wave, bid, G); }
    if ((bid & 3) != 2) { FRESH(); sgu_prompt(P, lds, tid, lane, wave, bid, G); }
    if ((bid & 3) != 1) { FRESH(); sample_gdn(P, lds, tid, lane, wave, bid, G); }
    { FRESH(); phase2_misc(P, tid, lane, wave, bid, G); }
    GRID_BAR();
    { FRESH(); gdn_scan(P, lds, st + 4, lane, wave, bid, G);
      if (wave >= 3 && wave <= 5) weight_items(P, (LAS float*)(lds + 2 * ST_BYTES + (wave - 3) * 8448), lane, 1536, 6784, bid * 3 + (wave - 3), G * 3); }
    GRID_BAR();
    { FRESH(); gdn_gate(P, lane, wave, bid, G); }
    GRID_BAR();
    {   FRESH();
        pg8::Gemm g{MIX, (const bf16*)(ws + WS_WOUT), MPR, DM, DM}; pg8::StaticOrder S; S.init(MPR, DM, G, bid);
        EpiGen<F2> E{F2{SS1, XB}}; EpiGen8<F2> E8{E.f};
        pg8::gemm_phase<EpiGen8<F2>, pg8::StaticOrder, false, true>(lds, g, S, E8);
        small_gemm<2, 4>(MIX + (size_t)MPR * DM, (const bf16*)(ws + WS_WOUT), DM, DM, E.f, lds, bid, G, wave, lane);
    }
    GRID_BAR();
    {   FRESH();
        pg8::Gemm g{XB, (const bf16*)(ws + WS_WUP), MPR, FF, DM}; pg8::StaticOrder S; S.init(MPR, FF, G, bid);
        EpiGen<F3> E{F3{nullptr, SS1, HID}}; EpiGen8<F3> E8{E.f};
        pg8::gemm_phase<EpiGen8<F3>, pg8::StaticOrder, true, true>(lds, g, S, E8);
        small_gemm<2, 4>(XB + (size_t)MPR * DM, (const bf16*)(ws + WS_WUP), FF, DM, E.f, lds, bid, G, wave, lane);
    }
    GRID_BAR();
    {   FRESH();
        pg8::Gemm g{HID, (const bf16*)(ws + WS_WDN), MPR, DM, FF}; pg8::StaticOrder S; S.init(MPR, DM, G, bid);
        EpiGen<F4> E{F4{SS2, XB}}; EpiGen8<F4> E8{E.f};
        pg8::gemm_phase<EpiGen8<F4>, pg8::StaticOrder, false, true>(lds, g, S, E8);
        small_gemm<2, 4>(HID + (size_t)MPR * FF, (const bf16*)(ws + WS_WDN), DM, FF, E.f, lds, bid, G, wave, lane);
    }
    GRID_BAR();
    {   FRESH();
        bf16* PP = MIX;
        { pg8::Gemm g{PB, (const bf16*)(ws + WS_WPLE), MPR, DM, DPLE}; pg8::StaticOrder S; S.init(MPR, DM, G, bid);
          EpiGen<F5a> E{F5a{nullptr, PP}}; EpiGen8<F5a> E8{E.f};
          pg8::gemm_phase<EpiGen8<F5a>, pg8::StaticOrder, false, true>(lds, g, S, E8);
          small_gemm<2, 4>(PB + (size_t)MPR * DPLE, (const bf16*)(ws + WS_WPLE), DM, DPLE, E.f, lds, bid, G, wave, lane); }
        { pg8::Gemm g{XB, (const bf16*)(ws + WS_WG), MPR, DM, DM}; pg8::StaticOrder S; S.init(MPR, DM, G, bid);
          EpiGen<F5b> E{F5b{SS3, SS2, XB, PP, HID}};
          EpiFinal EF{SS2, XB, PP, P.out, P.in[23], (unsigned*)(ws + WS_XBUF), (unsigned*)(ws + WS_CTL + 16384)};
          pg8::gemm_phase<EpiFinal, pg8::StaticOrder, false, true>(lds, g, S, EF);
          small_gemm<2, 4>(XB + (size_t)MPR * DM, (const bf16*)(ws + WS_WG), DM, DM, E.f, lds, bid, G, wave, lane); }
    }
    GRID_BAR();
    { FRESH(); final_norm(P, lane, wave, bid, G); }
}

extern "C" void kernel_launch(void* const* d_in, const int* in_sizes, int n_in, void* d_out, int out_size, void* d_ws, size_t ws_size, hipStream_t stream) {
    static int grid = 0;
    if (grid == 0) {
        int dev = 0, cus = 0;
        if (hipGetDevice(&dev) != hipSuccess || hipDeviceGetAttribute(&cus, hipDeviceAttributeMultiprocessorCount, dev) != hipSuccess) { fprintf(stderr, "kernel_launch: device query failed\n"); grid = -1; return; }
        if (hipFuncSetAttribute((const void*)mega_fwd, hipFuncAttributeMaxDynamicSharedMemorySize, LDS_BYTES) != hipSuccess) { fprintf(stderr, "kernel_launch: hipFuncSetAttribute failed\n"); grid = -1; return; }
        int per_cu = 0;
        if (hipOccupancyMaxActiveBlocksPerMultiprocessor(&per_cu, (const void*)mega_fwd, 512, LDS_BYTES) != hipSuccess || per_cu < 1) fprintf(stderr, "kernel_launch: occupancy query reports %d\n", per_cu);
        (void)hipGetLastError();
        grid = cus < 256 ? cus : 256;
        if (n_in != 24 || ws_size < 256 * MiB) fprintf(stderr, "kernel_launch: unexpected n_in %d / ws %zu\n", n_in, ws_size);
    }
    if (grid < 0) return;
    (void)hipMemsetAsync((char*)d_ws + WS_CTL, 0, CTL_BYTES, stream);
    Params p{};
    for (int i = 0; i < 24; ++i) p.in[i] = (const float*)d_in[i];
    p.out = (float*)d_out; p.ws = (unsigned char*)d_ws;
    hipLaunchKernelGGL(mega_fwd, dim3(grid), dim3(512), LDS_BYTES, stream, p);
}
```

```cpp
#include <hip/hip_runtime.h>
#include <cstdio>
#include <cstdint>
namespace pg8 {
#define PG8_LAS __attribute__((address_space(3)))
typedef unsigned short bf16_t;
typedef short bf16x8 __attribute__((ext_vector_type(8)));
typedef float f32x4 __attribute__((ext_vector_type(4)));
typedef unsigned u32x4 __attribute__((ext_vector_type(4)));
constexpr int BM = 256, BK = 64, HALF = 128, HTB = HALF * BK * 2  , STAGE_BYTES = 8 * HTB, NXCD = 8, WGM = 8;

__host__ __device__ __forceinline__ int lds_byte(int r, int c) { const int st = (r >> 4) * 2 + (c >> 5), rr = r & 15, cc = c & 31, ob = rr * 64 + cc * 2; return st * 1024 + (ob ^ (((ob >> 9) & 1) << 5)); }
__host__ __device__ __forceinline__ void stage_rc(int b, int& R, int& C) { const int st = b / 1024, sb = b % 1024, swz = sb ^ (((sb >> 9) & 1) << 5); R = (st >> 1) * 16 + swz / 64; C = (st & 1) * 32 + (swz % 64) / 2; }
__host__ __device__ __forceinline__ int perm32(int rho) { const int n = rho >> 4, i = rho & 15; return 8 * (i >> 2) + 4 * n + (i & 3); }

struct Unit { int pm, pn; };
struct Gemm { const bf16_t* A; const bf16_t* Bt; int M, N, K; };

struct StaticOrder {
    int nM, nN, nwg, G, c;
    __host__ __device__ void init(int M, int N, int G_, int c_) { nM = M / BM; nN = N / BM; nwg = nM * nN; G = G_; c = c_; }
    __host__ __device__ bool next(int i, Unit& u) const {
        const long L = (long)i * G + c; if (L >= nwg) return false;
        int wgid = (int)L; { const int q = nwg / NXCD, r = nwg % NXCD, xcd = wgid % NXCD, off = wgid / NXCD; wgid = (xcd < r ? xcd * (q + 1) : r * (q + 1) + (xcd - r) * q) + off; }
        const int nig = WGM * nN, gid = wgid / nig, fm = gid * WGM, gsz = (nM - fm) < WGM ? (nM - fm) : WGM;
        u.pm = fm + ((wgid % nig) % gsz); u.pn = (wgid % nig) / gsz; return true;
    }
    __device__ __forceinline__ void a_ready(const Unit&) const {}
    __device__ __forceinline__ void done(const Unit&) const {}
};

__device__ __forceinline__ unsigned cvt_pk_bf16(float lo, float hi) { unsigned r; asm volatile("v_cvt_pk_bf16_f32 %0, %1, %2" : "=v"(r) : "v"(lo), "v"(hi)); return r; }
template <class Epi, class Sched, bool ALIGN_EPI = false, bool SP2 = false>
__device__ __forceinline__ void gemm_phase(PG8_LAS unsigned char* lds, const Gemm g, const Sched& S, const Epi& E) {
    int tid_ = threadIdx.x; asm volatile("" : "+v"(tid_));
    const int tid = tid_, wid = __builtin_amdgcn_readfirstlane(tid >> 6), lane = tid & 63, wr = wid >> 2, wc = wid & 3, fr = lane & 15, fq = lane >> 4;
    const int K = g.K, nt = K / BK;
    unsigned voffA[2], voffB[2];
#pragma unroll
    for (int i = 0; i < 2; ++i) { int R, C; stage_rc(tid * 16 + i * 8192, R, C); const int Rb = Epi::PERM ? ((R & ~31) + perm32(R & 31)) : R;
        voffA[i] = (unsigned)(R * K + C) * 2u; voffB[i] = (unsigned)(Rb * K + C) * 2u; }
    const size_t kstep = (size_t)(BK * 2);
    const size_t hstep = (size_t)HALF * K * 2;
    const size_t tstep = 2 * hstep;
    const unsigned ldsw = (unsigned)wid * 1024u;
    const int aoff = lds_byte(wr * 64 + fr, fq * 8), boff = lds_byte(wc * 32 + fr, fq * 8);
#define PG8_SA(b, h) (((b) * 2 + (h)) * HTB)
#define PG8_SB(b, h) ((4 + (b) * 2 + (h)) * HTB)
#define PG8_STAGE(bufoff, gbase, voff) do { _Pragma("unroll") for (int _i = 0; _i < 2; ++_i) \
        __builtin_amdgcn_global_load_lds((const unsigned*)((const char*)(gbase) + (voff)[_i]), (PG8_LAS unsigned*)(lds + (bufoff) + ldsw + _i * 8192), 16, 0, 0); } while (0)
#define PG8_LDA(dst, b, h) do { _Pragma("unroll") for (int m = 0; m < 4; ++m) _Pragma("unroll") for (int k = 0; k < 2; ++k) dst[m][k] = *(const PG8_LAS bf16x8*)(lds + PG8_SA(b, h) + aoff + m * 2048 + k * 1024); } while (0)
#define PG8_LDB(dst, b, h) do { _Pragma("unroll") for (int n = 0; n < 2; ++n) _Pragma("unroll") for (int k = 0; k < 2; ++k) dst[n][k] = *(const PG8_LAS bf16x8*)(lds + PG8_SB(b, h) + boff + n * 2048 + k * 1024); } while (0)
#define PG8_MMA(ai, bj, At, Bt) do { __builtin_amdgcn_s_setprio(1); _Pragma("unroll") for (int m = 0; m < 4; ++m) _Pragma("unroll") for (int n = 0; n < 2; ++n) _Pragma("unroll") for (int k = 0; k < 2; ++k) \
        acc[ai][bj][m][n] = __builtin_amdgcn_mfma_f32_16x16x32_bf16(Bt[n][k], At[m][k], acc[ai][bj][m][n], 0, 0, 0); __builtin_amdgcn_s_setprio(0); } while (0)
#define PG8_WAIT_V(n) asm volatile("s_waitcnt vmcnt(" #n ")" ::: "memory")
#define PG8_WAIT_L(n) asm volatile("s_waitcnt lgkmcnt(" #n ")" ::: "memory")
#define PG8_BAR __builtin_amdgcn_s_barrier()
#define PG8_SCHED __builtin_amdgcn_sched_barrier(0)
    Unit cur, nxt; int ui = 0;
    if (!S.next(0, cur)) return;
    f32x4 acc[2][2][4][2];
#pragma unroll
    for (int a = 0; a < 2; ++a)
#pragma unroll
        for (int b = 0; b < 2; ++b)
#pragma unroll
            for (int m = 0; m < 4; ++m)
#pragma unroll
                for (int n = 0; n < 2; ++n) acc[a][b][m][n] = (f32x4){0.f, 0.f, 0.f, 0.f};
    bf16x8 At[4][2], B0[2][2], B1[2][2];
    const char* cA = (const char*)g.A + (size_t)cur.pm * tstep; const char* cB = (const char*)g.Bt + (size_t)cur.pn * tstep;
    S.a_ready(cur);
    if constexpr (SP2) {
        PG8_STAGE(PG8_SB(0, 0), cB, voffB); PG8_STAGE(PG8_SB(0, 1), cB + hstep, voffB); PG8_STAGE(PG8_SA(0, 0), cA, voffA); PG8_STAGE(PG8_SA(0, 1), cA + hstep, voffA);
        if (wr == 1) PG8_BAR;
        PG8_WAIT_V(2); PG8_BAR;
        PG8_STAGE(PG8_SB(1, 0), cB + kstep, voffB); PG8_STAGE(PG8_SA(1, 0), cA + kstep, voffA); PG8_STAGE(PG8_SB(1, 1), cB + hstep + kstep, voffB);
        PG8_WAIT_V(6); PG8_BAR;
    } else {
        PG8_STAGE(PG8_SB(0, 0), cB, voffB); PG8_STAGE(PG8_SA(0, 0), cA, voffA); PG8_STAGE(PG8_SB(0, 1), cB + hstep, voffB); PG8_STAGE(PG8_SA(0, 1), cA + hstep, voffA);
        if (wr == 1) PG8_BAR;
        PG8_WAIT_V(4); PG8_BAR;
        PG8_STAGE(PG8_SB(1, 0), cB + kstep, voffB); PG8_STAGE(PG8_SA(1, 0), cA + kstep, voffA); PG8_STAGE(PG8_SB(1, 1), cB + hstep + kstep, voffB);
        PG8_WAIT_V(6); PG8_BAR;
    }
    for (;;) {
        const bool has_next = S.next(ui + 1, nxt);
        const char* nA = has_next ? (const char*)g.A + (size_t)nxt.pm * tstep : cA; const char* nB = has_next ? (const char*)g.Bt + (size_t)nxt.pn * tstep : cB;
        for (int t = 0; t < nt; t += 2) {
            const bool last = (t == nt - 2);
            const char* a1 = cA + (size_t)(t + 1) * kstep;
            const char* a2 = last ? nA : cA + (size_t)(t + 2) * kstep; const char* b2 = last ? nB : cB + (size_t)(t + 2) * kstep;
            const char* a3 = a2 + kstep; const char* b3 = b2 + kstep;
            if (last && has_next) S.a_ready(nxt);
            if constexpr (SP2) {
            PG8_LDB(B0, 0, 0); PG8_LDB(B1, 0, 1); PG8_SCHED; PG8_LDA(At, 0, 0); PG8_STAGE(PG8_SA(1, 1), a1 + hstep, voffA);
            PG8_WAIT_V(8); PG8_WAIT_L(0); PG8_BAR; PG8_MMA(0, 0, At, B0); PG8_MMA(0, 1, At, B1); PG8_BAR; PG8_SCHED;
            PG8_LDA(At, 0, 1); PG8_STAGE(PG8_SB(0, 0), b2, voffB); PG8_STAGE(PG8_SB(0, 1), b2 + hstep, voffB); PG8_STAGE(PG8_SA(0, 0), a2, voffA);
            PG8_WAIT_V(8); PG8_WAIT_L(0); PG8_BAR; PG8_MMA(1, 0, At, B0); PG8_MMA(1, 1, At, B1); PG8_BAR; PG8_SCHED;
            PG8_LDB(B0, 1, 0); PG8_LDB(B1, 1, 1); PG8_SCHED; PG8_LDA(At, 1, 0); PG8_STAGE(PG8_SA(0, 1), a2 + hstep, voffA);
            PG8_WAIT_V(8); PG8_WAIT_L(0); PG8_BAR; PG8_MMA(0, 0, At, B0); PG8_MMA(0, 1, At, B1); PG8_BAR; PG8_SCHED;
            PG8_LDA(At, 1, 1); PG8_STAGE(PG8_SB(1, 0), b3, voffB); PG8_STAGE(PG8_SB(1, 1), b3 + hstep, voffB); PG8_STAGE(PG8_SA(1, 0), a3, voffA);
            PG8_WAIT_V(8); PG8_WAIT_L(0); PG8_BAR; PG8_MMA(1, 0, At, B0); PG8_MMA(1, 1, At, B1); PG8_BAR; PG8_SCHED;
            } else {
            PG8_LDB(B0, 0, 0); PG8_SCHED; PG8_LDA(At, 0, 0); PG8_STAGE(PG8_SA(1, 1), a1 + hstep, voffA);
            PG8_WAIT_L(8); PG8_BAR; PG8_WAIT_L(0); PG8_MMA(0, 0, At, B0); PG8_BAR; PG8_SCHED;
            PG8_LDB(B1, 0, 1); PG8_STAGE(PG8_SB(0, 0), b2, voffB);
            PG8_BAR; PG8_WAIT_L(0); PG8_MMA(0, 1, At, B1); PG8_BAR;
            PG8_LDA(At, 0, 1); PG8_STAGE(PG8_SA(0, 0), a2, voffA);
            PG8_BAR; PG8_WAIT_L(0); PG8_MMA(1, 0, At, B0); PG8_BAR; PG8_SCHED;
            PG8_STAGE(PG8_SB(0, 1), b2 + hstep, voffB);
            PG8_WAIT_V(6); PG8_BAR; PG8_MMA(1, 1, At, B1); PG8_BAR;
            PG8_LDB(B0, 1, 0); PG8_SCHED; PG8_LDA(At, 1, 0); PG8_STAGE(PG8_SA(0, 1), a2 + hstep, voffA);
            PG8_WAIT_L(8); PG8_BAR; PG8_WAIT_L(0); PG8_MMA(0, 0, At, B0); PG8_BAR; PG8_SCHED;
            PG8_LDB(B1, 1, 1); PG8_STAGE(PG8_SB(1, 0), b3, voffB);
            PG8_BAR; PG8_WAIT_L(0); PG8_MMA(0, 1, At, B1); PG8_BAR;
            PG8_LDA(At, 1, 1); PG8_STAGE(PG8_SA(1, 0), a3, voffA);
            PG8_BAR; PG8_WAIT_L(0); PG8_MMA(1, 0, At, B0); PG8_BAR; PG8_SCHED;
            PG8_STAGE(PG8_SB(1, 1), b3 + hstep, voffB);
            PG8_WAIT_V(6); PG8_BAR; PG8_MMA(1, 1, At, B1); PG8_BAR;
            }
        }
        if constexpr (ALIGN_EPI) { if (wr == 0) PG8_BAR; }
        if constexpr (!Epi::AFTER_DRAIN) { E(acc, cur, wr, wc, fr, fq); S.done(cur); }
        if (!has_next) break;
#pragma unroll
        for (int a = 0; a < 2; ++a)
#pragma unroll
            for (int b = 0; b < 2; ++b)
#pragma unroll
                for (int m = 0; m < 4; ++m)
#pragma unroll
                    for (int n = 0; n < 2; ++n) acc[a][b][m][n] = (f32x4){0.f, 0.f, 0.f, 0.f};
        cur = nxt; cA = nA; cB = nB; ++ui;
        if constexpr (ALIGN_EPI) { if (wr == 1) PG8_BAR; }
    }
    PG8_WAIT_V(0);
    if constexpr (!ALIGN_EPI) { if (wr == 0) PG8_BAR; }
    PG8_BAR;
    if constexpr (Epi::AFTER_DRAIN) { E.fused(acc, cur, wr, wc, fr, fq, lds, wid, lane); S.done(cur); }
#undef PG8_SA
#undef PG8_SB
#undef PG8_STAGE
#undef PG8_LDA
#undef PG8_LDB
#undef PG8_MMA
#undef PG8_WAIT_V
#undef PG8_WAIT_L
#undef PG8_BAR
#undef PG8_SCHED
}
}

#define LAS __attribute__((address_space(3)))
typedef unsigned short bf16;
typedef float f32x4 __attribute__((ext_vector_type(4)));
typedef short bf16x8 __attribute__((ext_vector_type(8)));
typedef unsigned u32x4 __attribute__((ext_vector_type(4)));
typedef unsigned u32x2 __attribute__((ext_vector_type(2)));
#define LDS_WAIT() asm volatile("s_waitcnt lgkmcnt(0)" ::: "memory")
#define VM_WAIT() asm volatile("s_waitcnt vmcnt(0)" ::: "memory")

constexpr int MPR = 16384, MSA = 128, MT = MPR + MSA, DM = 1024, NIN = 3072, FF = 4096, DPLE = 256, SRCN = 3080;
constexpr float EPS = 1e-6f, QSCALE = 0.08838834764831845f;
constexpr int LDS_BYTES = 147456;
constexpr size_t MiB = 1u << 20;
constexpr size_t WS_RS0 = 0, WS_BETA = 128 * 1024, WS_G = 448 * 1024, WS_WSB = 1 * MiB, WS_SS1 = 2 * MiB, WS_SS2 = 3 * MiB + 256 * 1024, WS_SS3 = 4 * MiB + 512 * 1024;
constexpr size_t WS_WIN = 6 * MiB, WS_WOUT = 12 * MiB, WS_WUP = 14 * MiB, WS_WDN = 22 * MiB, WS_WG = 30 * MiB, WS_WPLE = 32 * MiB;
constexpr size_t WS_PB = 33 * MiB, WS_XB = 42 * MiB, WS_MIX = 75 * MiB, WS_PROJ = 108 * MiB, WS_HID = 108 * MiB, WS_AT = 205 * MiB, WS_O = 213 * MiB, WS_DECF = 246 * MiB, WS_XBUF = 247 * MiB, WS_CTL = 255 * MiB;
constexpr size_t CTL_BYTES = 32768;
constexpr size_t O_Y = 0, O_NCP = 16908288, O_NGP = 16945152, O_NCS = 17469440, O_NGS = 18059264, O_NSV = 26447872;
constexpr size_t FR_W = 0, FR_QG = 8 * MiB, FR_KG = 16 * MiB, FR_U = 24 * MiB;

__device__ __forceinline__ unsigned f2bf(float f) { unsigned u = __builtin_bit_cast(unsigned, f); return (u + 0x7fffu + ((u >> 16) & 1u)) >> 16; }
typedef float f32x2_t_ __attribute__((ext_vector_type(2))); typedef __bf16 bf16x2_t_ __attribute__((ext_vector_type(2)));
__device__ __forceinline__ unsigned pk2(float lo, float hi) { const f32x2_t_ v = {lo, hi}; const bf16x2_t_ b = __builtin_convertvector(v, bf16x2_t_); return __builtin_bit_cast(unsigned, b); }
__device__ __forceinline__ float bflo(unsigned u) { return __builtin_bit_cast(float, u << 16); }
__device__ __forceinline__ float bfhi(unsigned u) { return __builtin_bit_cast(float, u & 0xffff0000u); }
__device__ __forceinline__ float bf2f(bf16 v) { return __builtin_bit_cast(float, (unsigned)v << 16); }
__device__ __forceinline__ float sigmoidf_(float x) { return __builtin_amdgcn_rcpf(1.f + __expf(-x)); }
__device__ __forceinline__ float siluf_(float x) { return x * __builtin_amdgcn_rcpf(1.f + __expf(-x)); }
__device__ __forceinline__ float geluf_(float x) { const float u = 1.5957691216057308f * (x + 0.044715f * x * x * x); return x * __builtin_amdgcn_rcpf(1.f + __expf(-u)); }
template <int CTRL, int ROWMASK> __device__ __forceinline__ float dpp_get(float v) { return __builtin_bit_cast(float, __builtin_amdgcn_update_dpp(0, __builtin_bit_cast(int, v), CTRL, ROWMASK, 0xF, false)); }
__device__ __forceinline__ float wave_sum(float v) {
    v += dpp_get<0xB1, 0xF>(v); v += dpp_get<0x4E, 0xF>(v); v += dpp_get<0x141, 0xF>(v); v += dpp_get<0x140, 0xF>(v);
    v += dpp_get<0x142, 0xA>(v); v += dpp_get<0x143, 0xC>(v);
    return __builtin_bit_cast(float, __builtin_amdgcn_readlane(__builtin_bit_cast(int, v), 63));
}
__device__ __forceinline__ f32x4 mfma16(bf16x8 a, bf16x8 b, f32x4 c) { return __builtin_amdgcn_mfma_f32_16x16x32_bf16(a, b, c, 0, 0, 0); }
__device__ __forceinline__ bf16x8 pack8(f32x4 a, f32x4 b) { u32x4 w; w.x = pk2(a.x, a.y); w.y = pk2(a.z, a.w); w.z = pk2(b.x, b.y); w.w = pk2(b.z, b.w); return __builtin_bit_cast(bf16x8, w); }

struct Params { const float* in[24]; float* out; unsigned char* ws; };

template <class F> struct EpiGen {
    static constexpr bool PERM = false, AFTER_DRAIN = false;
    F f;
    __device__ __forceinline__ void operator()(const pg8::f32x4 (&acc)[2][2][4][2], const pg8::Unit& u, int wr, int wc, int fr, int fq) const {
#pragma unroll
        for (int ai = 0; ai < 2; ++ai)
#pragma unroll
            for (int m = 0; m < 4; ++m) {
                const int row = u.pm * 256 + ai * 128 + wr * 64 + m * 16 + fr;
                const float ctx = f.rowctx(row); float ss = 0.f;
#pragma unroll
                for (int bj = 0; bj < 2; ++bj)
#pragma unroll
                    for (int n = 0; n < 2; ++n) ss += f(row, u.pn * 256 + bj * 128 + wc * 32 + n * 16 + 4 * fq, acc[ai][bj][m][n], ctx);
                if (F::STATS) { ss += __shfl_xor(ss, 16); ss += __shfl_xor(ss, 32); if (fq == 0) f.ss[(size_t)row * 16 + u.pn * 4 + wc] = ss; }
            }
    }
};
template <class F> struct EpiGen8 {
    static constexpr bool PERM = true, AFTER_DRAIN = false;
    F f;
    __device__ __forceinline__ void operator()(const pg8::f32x4 (&acc)[2][2][4][2], const pg8::Unit& u, int wr, int wc, int fr, int fq) const {
#pragma unroll
        for (int ai = 0; ai < 2; ++ai)
#pragma unroll
            for (int m = 0; m < 4; ++m) {
                const int row = u.pm * 256 + ai * 128 + wr * 64 + m * 16 + fr; const float ctx = f.rowctx(row); float ss = 0.f;
#pragma unroll
                for (int bj = 0; bj < 2; ++bj) ss += f.op8(row, u.pn * 256 + bj * 128 + wc * 32 + 8 * fq, acc[ai][bj][m][0], acc[ai][bj][m][1], ctx);
                if (F::STATS) { ss += __shfl_xor(ss, 16); ss += __shfl_xor(ss, 32); if (fq == 0) f.ss[(size_t)row * 16 + u.pn * 4 + wc] = ss; }
            }
    }
};
__device__ __forceinline__ float sum16(const float* p) { const f32x4 a = *(const f32x4*)p, b = *(const f32x4*)(p + 4), c = *(const f32x4*)(p + 8), d = *(const f32x4*)(p + 12);
    return ((a.x + a.y) + (a.z + a.w)) + ((b.x + b.y) + (b.z + b.w)) + ((c.x + c.y) + (c.z + c.w)) + ((d.x + d.y) + (d.z + d.w)); }
__device__ __forceinline__ void st_bf4(bf16* p, f32x4 v) { u32x2 w; w.x = pk2(v.x, v.y); w.y = pk2(v.z, v.w); *(u32x2*)p = w; }
__device__ __forceinline__ float dot4(f32x4 v) { return (v.x * v.x + v.y * v.y) + (v.z * v.z + v.w * v.w); }

struct F1 { static constexpr bool STATS = false; float* ss; const float* rs0; bf16* proj;
    __device__ __forceinline__ float rowctx(int row) const { return rs0[row]; }
    __device__ __forceinline__ float operator()(int row, int col, f32x4 a, float rs) const { f32x4 v = a * rs;
        if (col >= 2048) { v.x = geluf_(v.x); v.y = geluf_(v.y); v.z = geluf_(v.z); v.w = geluf_(v.w); }
        st_bf4(proj + (size_t)row * NIN + col, v); return 0.f; }
    __device__ __forceinline__ float op8(int row, int col, f32x4 a0, f32x4 a1, float rs) const { f32x4 v0 = a0 * rs, v1 = a1 * rs;
        if (col >= 2048) { v0.x = geluf_(v0.x); v0.y = geluf_(v0.y); v0.z = geluf_(v0.z); v0.w = geluf_(v0.w); v1.x = geluf_(v1.x); v1.y = geluf_(v1.y); v1.z = geluf_(v1.z); v1.w = geluf_(v1.w); }
        u32x4 w; w.x = pk2(v0.x, v0.y); w.y = pk2(v0.z, v0.w); w.z = pk2(v1.x, v1.y); w.w = pk2(v1.z, v1.w); *(u32x4*)(proj + (size_t)row * NIN + col) = w; return 0.f; } };
struct F2 { static constexpr bool STATS = true; float* ss; bf16* xb;
    __device__ __forceinline__ float rowctx(int) const { return 0.f; }
    __device__ __forceinline__ float operator()(int row, int col, f32x4 a, float) const { bf16* p = xb + (size_t)row * DM + col; const u32x2 r = *(const u32x2*)p;
        const f32x4 x = (f32x4){bflo(r.x) + a.x, bfhi(r.x) + a.y, bflo(r.y) + a.z, bfhi(r.y) + a.w}; st_bf4(p, x); return dot4(x); }
    __device__ __forceinline__ float op8(int row, int col, f32x4 a0, f32x4 a1, float) const { bf16* p = xb + (size_t)row * DM + col; const u32x4 r = *(const u32x4*)p;
        const f32x4 x0 = (f32x4){bflo(r.x) + a0.x, bfhi(r.x) + a0.y, bflo(r.y) + a0.z, bfhi(r.y) + a0.w}, x1 = (f32x4){bflo(r.z) + a1.x, bfhi(r.z) + a1.y, bflo(r.w) + a1.z, bfhi(r.w) + a1.w};
        u32x4 w; w.x = pk2(x0.x, x0.y); w.y = pk2(x0.z, x0.w); w.z = pk2(x1.x, x1.y); w.w = pk2(x1.z, x1.w); *(u32x4*)p = w; return dot4(x0) + dot4(x1); } };
struct F3 { static constexpr bool STATS = false; float* ss; const float* ss1; bf16* hid;
    __device__ __forceinline__ float rowctx(int row) const { return rsqrtf(sum16(ss1 + (size_t)row * 16) * (1.f / DM) + EPS); }
    __device__ __forceinline__ float operator()(int row, int col, f32x4 a, float rs) const { f32x4 v = a * rs; v.x = fmaxf(v.x, 0.f); v.y = fmaxf(v.y, 0.f); v.z = fmaxf(v.z, 0.f); v.w = fmaxf(v.w, 0.f);
        st_bf4(hid + (size_t)row * FF + col, v * v); return 0.f; }
    __device__ __forceinline__ float op8(int row, int col, f32x4 a0, f32x4 a1, float rs) const { f32x4 v0 = a0 * rs, v1 = a1 * rs;
        v0.x = fmaxf(v0.x, 0.f); v0.y = fmaxf(v0.y, 0.f); v0.z = fmaxf(v0.z, 0.f); v0.w = fmaxf(v0.w, 0.f); v1.x = fmaxf(v1.x, 0.f); v1.y = fmaxf(v1.y, 0.f); v1.z = fmaxf(v1.z, 0.f); v1.w = fmaxf(v1.w, 0.f);
        v0 = v0 * v0; v1 = v1 * v1; u32x4 w; w.x = pk2(v0.x, v0.y); w.y = pk2(v0.z, v0.w); w.z = pk2(v1.x, v1.y); w.w = pk2(v1.z, v1.w); *(u32x4*)(hid + (size_t)row * FF + col) = w; return 0.f; } };
struct F4 { static constexpr bool STATS = true; float* ss; bf16* xb;
    __device__ __forceinline__ float rowctx(int) const { return 0.f; }
    __device__ __forceinline__ float operator()(int row, int col, f32x4 a, float) const { bf16* p = xb + (size_t)row * DM + col; const u32x2 r = *(const u32x2*)p;
        const f32x4 x = (f32x4){bflo(r.x) + a.x, bfhi(r.x) + a.y, bflo(r.y) + a.z, bfhi(r.y) + a.w}; st_bf4(p, x); return dot4(x); }
    __device__ __forceinline__ float op8(int row, int col, f32x4 a0, f32x4 a1, float) const { bf16* p = xb + (size_t)row * DM + col; const u32x4 r = *(const u32x4*)p;
        const f32x4 x0 = (f32x4){bflo(r.x) + a0.x, bfhi(r.x) + a0.y, bflo(r.y) + a0.z, bfhi(r.y) + a0.w}, x1 = (f32x4){bflo(r.z) + a1.x, bfhi(r.z) + a1.y, bflo(r.w) + a1.z, bfhi(r.w) + a1.w};
        u32x4 w; w.x = pk2(x0.x, x0.y); w.y = pk2(x0.z, x0.w); w.z = pk2(x1.x, x1.y); w.w = pk2(x1.z, x1.w); *(u32x4*)p = w; return dot4(x0) + dot4(x1); } };
struct F5a { static constexpr bool STATS = false; float* ss; bf16* pp;
    __device__ __forceinline__ float rowctx(int) const { return 0.f; }
    __device__ __forceinline__ float operator()(int row, int col, f32x4 a, float) const { st_bf4(pp + (size_t)row * DM + col, a); return 0.f; }
    __device__ __forceinline__ float op8(int row, int col, f32x4 a0, f32x4 a1, float) const { u32x4 w; w.x = pk2(a0.x, a0.y); w.y = pk2(a0.z, a0.w); w.z = pk2(a1.x, a1.y); w.w = pk2(a1.z, a1.w);
        *(u32x4*)(pp + (size_t)row * DM + col) = w; return 0.f; } };
struct F5b { static constexpr bool STATS = true; float* ss; const float* ss2; const bf16* xb; const bf16* pp; bf16* x3;
    __device__ __forceinline__ float rowctx(int row) const { return rsqrtf(sum16(ss2 + (size_t)row * 16) * (1.f / DM) + EPS); }
    __device__ __forceinline__ float operator()(int row, int col, f32x4 a, float rs) const { const size_t o = (size_t)row * DM + col; const u32x2 pr = *(const u32x2*)(pp + o), xr = *(const u32x2*)(xb + o);
        f32x4 x; x.x = bflo(xr.x) + bflo(pr.x) * sigmoidf_(a.x * rs); x.y = bfhi(xr.x) + bfhi(pr.x) * sigmoidf_(a.y * rs); x.z = bflo(xr.y) + bflo(pr.y) * sigmoidf_(a.z * rs); x.w = bfhi(xr.y) + bfhi(pr.y) * sigmoidf_(a.w * rs);
        st_bf4(x3 + o, x); return dot4(x); } };

struct EpiFinal {
    static constexpr bool PERM = true, AFTER_DRAIN = true;
    const float* ss2; const bf16* xb; const bf16* pp; float* out; const float* gfin; unsigned* xbuf; unsigned* cnt;
    __device__ __forceinline__ void fused(pg8::f32x4 (&acc)[2][2][4][2], const pg8::Unit& u, int wr, int wc, int fr, int fq, LAS unsigned char* lds, int wid, int lane) const {
        LAS float* Pt = (LAS float*)lds; LAS float* St = (LAS float*)(lds + 4096);
#pragma unroll
        for (int ai = 0; ai < 2; ++ai)
#pragma unroll
            for (int m = 0; m < 4; ++m) {
                const int row_l = ai * 128 + wr * 64 + m * 16 + fr; const size_t row = (size_t)u.pm * 256 + row_l;
                const float rs = rsqrtf(sum16(ss2 + row * 16) * (1.f / DM) + EPS); float ss = 0.f;
#pragma unroll
                for (int bj = 0; bj < 2; ++bj) { const size_t o = row * DM + u.pn * 256 + bj * 128 + wc * 32 + 8 * fq; const u32x4 pr = *(const u32x4*)(pp + o), xr = *(const u32x4*)(xb + o);
                    const f32x4 a0 = acc[ai][bj][m][0], a1 = acc[ai][bj][m][1]; f32x4 x0, x1;
                    x0.x = bflo(xr.x) + bflo(pr.x) * sigmoidf_(a0.x * rs); x0.y = bfhi(xr.x) + bfhi(pr.x) * sigmoidf_(a0.y * rs); x0.z = bflo(xr.y) + bflo(pr.y) * sigmoidf_(a0.z * rs); x0.w = bfhi(xr.y) + bfhi(pr.y) * sigmoidf_(a0.w * rs);
                    x1.x = bflo(xr.z) + bflo(pr.z) * sigmoidf_(a1.x * rs); x1.y = bfhi(xr.z) + bfhi(pr.z) * sigmoidf_(a1.y * rs); x1.z = bflo(xr.w) + bflo(pr.w) * sigmoidf_(a1.z * rs); x1.w = bfhi(xr.w) + bfhi(pr.w) * sigmoidf_(a1.w * rs);
                    acc[ai][bj][m][0] = x0; acc[ai][bj][m][1] = x1; ss += dot4(x0) + dot4(x1); }
                ss += __shfl_xor(ss, 16); ss += __shfl_xor(ss, 32);
                if (fq == 0) Pt[row_l * 4 + wc] = ss;
            }
        asm volatile("s_waitcnt lgkmcnt(0)" ::: "memory"); __builtin_amdgcn_s_barrier(); asm volatile("" ::: "memory");
        const int rl = wid * 32 + (lane & 31);
        if (lane < 32) { const f32x4 p4 = *(const LAS f32x4*)(Pt + rl * 4); const float tot = (p4.x + p4.y) + (p4.z + p4.w);
            __hip_atomic_store(xbuf + ((size_t)u.pm * 256 + rl) * 4 + u.pn, __builtin_bit_cast(unsigned, tot), __ATOMIC_RELAXED, __HIP_MEMORY_SCOPE_AGENT); }
        asm volatile("s_waitcnt vmcnt(0)" ::: "memory");
        if (lane == 0) __hip_atomic_fetch_add(cnt + 64 * u.pm, 1u, __ATOMIC_RELAXED, __HIP_MEMORY_SCOPE_AGENT);
        if (wid == 0) {
            unsigned sp = 0;
            while ((unsigned)__builtin_amdgcn_readfirstlane(__hip_atomic_load(cnt + 64 * u.pm, __ATOMIC_RELAXED, __HIP_MEMORY_SCOPE_AGENT)) < 32u) { __builtin_amdgcn_s_sleep(2); if (++sp > (1u << 22)) break; }
            __builtin_amdgcn_fence(__ATOMIC_ACQUIRE, "agent");
        }
        asm volatile("s_waitcnt vmcnt(0) lgkmcnt(0)" ::: "memory"); __builtin_amdgcn_s_barrier(); asm volatile("" ::: "memory");
        if (lane < 32) { float t = 0.f;
#pragma unroll
            for (int k = 0; k < 4; ++k) t += __builtin_bit_cast(float, __hip_atomic_load(xbuf + ((size_t)u.pm * 256 + rl) * 4 + k, __ATOMIC_RELAXED, __HIP_MEMORY_SCOPE_AGENT));
            St[rl] = rsqrtf(t * (1.f / DM) + EPS); }
        asm volatile("s_waitcnt lgkmcnt(0)" ::: "memory"); __builtin_amdgcn_s_barrier(); asm volatile("" ::: "memory");
#pragma unroll
        for (int ai = 0; ai < 2; ++ai)
#pragma unroll
            for (int m = 0; m < 4; ++m) {
                const int row_l = ai * 128 + wr * 64 + m * 16 + fr; const size_t row = (size_t)u.pm * 256 + row_l; const float r = St[row_l];
#pragma unroll
                for (int bj = 0; bj < 2; ++bj)
#pragma unroll
                    for (int n = 0; n < 2; ++n) { const int col = u.pn * 256 + bj * 128 + wc * 32 + 8 * fq + 4 * n;
                        *(f32x4*)(out + row * DM + col) = acc[ai][bj][m][n] * r * *(const f32x4*)(gfin + col); }
            }
    }
};

template <int RT, int UNR, class F> __device__ __forceinline__ void small_gemm(const bf16* A, const bf16* Bt, int N, int K, const F& f, LAS unsigned char* lds, int bid, int G, int wave, int lane) {
    const int c = lane & 15, q = lane >> 4; constexpr int NMH = 8 / RT; const int ntask = NMH * (N >> 6); const int kw = K >> 3;
    LAS f32x4* red = (LAS f32x4*)lds;
    for (int t = bid; t < ntask; t += G) {
        const int mh = t % NMH, ns = t / NMH;
        const bf16* ap = A + (size_t)(mh * RT * 16 + c) * K + wave * kw + 8 * q;
        const bf16* bp = Bt + (size_t)(ns * 64 + c) * K + wave * kw + 8 * q;
        f32x4 acc[RT][4];
#pragma unroll
        for (int i = 0; i < RT; ++i)
#pragma unroll
            for (int j = 0; j < 4; ++j) acc[i][j] = (f32x4){0.f, 0.f, 0.f, 0.f};
#pragma unroll UNR
        for (int k = 0; k < kw; k += 32) {
            bf16x8 a[RT], b[4];
#pragma unroll
            for (int i = 0; i < RT; ++i) a[i] = *(const bf16x8*)(ap + (size_t)i * 16 * K + k);
#pragma unroll
            for (int j = 0; j < 4; ++j) b[j] = *(const bf16x8*)(bp + (size_t)j * 16 * K + k);
#pragma unroll
            for (int i = 0; i < RT; ++i)
#pragma unroll
                for (int j = 0; j < 4; ++j) acc[i][j] = mfma16(b[j], a[i], acc[i][j]);
        }
#pragma unroll
        for (int i = 0; i < RT; ++i)
#pragma unroll
            for (int j = 0; j < 4; ++j) red[(wave * (RT * 4) + i * 4 + j) * 64 + lane] = acc[i][j];
        __syncthreads();
        if (wave < RT) {
            const int i = wave; const int row = MPR + mh * RT * 16 + i * 16 + c; const float ctx = f.rowctx(row); float ss = 0.f;
#pragma unroll
            for (int j = 0; j < 4; ++j) { f32x4 s = red[(i * 4 + j) * 64 + lane];
#pragma unroll
                for (int w = 1; w < 8; ++w) s += red[(w * (RT * 4) + i * 4 + j) * 64 + lane];
                ss += f(row, ns * 64 + j * 16 + 4 * q, s, ctx); }
            if (F::STATS) { ss += __shfl_xor(ss, 16); ss += __shfl_xor(ss, 32); if (q == 0) f.ss[(size_t)row * 16 + ns] = ss; }
        }
        __syncthreads();
    }
}

__device__ __forceinline__ void tr_item(const float* __restrict__ W, int N, int src_c0, bf16* WT, int K, int dst_r0, const float* __restrict__ gain, LAS float* scr, int k0, int lane) {
    const float gv = gain ? gain[k0 + lane] : 1.f;
    f32x4 wv[8];
#pragma unroll
    for (int i = 0; i < 8; ++i) wv[i] = *(const f32x4*)(W + (size_t)(k0 + 8 * i + (lane >> 3)) * N + src_c0 + 4 * (lane & 7));
#pragma unroll
    for (int i = 0; i < 8; ++i) {
        float g = 0.f;
#pragma unroll
        for (int r = 0; r < 8; ++r) { const float gr = __builtin_bit_cast(float, __builtin_amdgcn_readlane(__builtin_bit_cast(int, gv), 8 * i + r)); g = ((lane >> 3) == r) ? gr : g; }
        LAS float* d = scr + (8 * i + (lane >> 3)) * 33 + 4 * (lane & 7);
        d[0] = wv[i].x * g; d[1] = wv[i].y * g; d[2] = wv[i].z * g; d[3] = wv[i].w * g;
    }
    LDS_WAIT();
    const int c = lane & 7;
#pragma unroll
    for (int j = 0; j < 4; ++j) { const int n = (lane >> 3) + 8 * j; const LAS float* s = scr + (8 * c) * 33 + n;
        u32x4 o; o.x = pk2(s[0], s[33]); o.y = pk2(s[66], s[99]); o.z = pk2(s[132], s[165]); o.w = pk2(s[198], s[231]);
        *(u32x4*)(WT + (size_t)(dst_r0 + n) * K + k0 + 8 * c) = o; }
    LDS_WAIT();
}

__device__ __forceinline__ void weight_items(const Params& P, LAS float* scr, int lane, int first, int last, int start, int stride) {
    unsigned char* ws = P.ws; const float* w_in = P.in[7]; const float* g_mix = P.in[6];
    for (int it = first + start; it < last; it += stride) {
        int r = it;
        if (r < 1536) { const int nb = r >> 4, kb = r & 15; tr_item(w_in, SRCN, nb * 32 + (nb >= 64 ? 8 : 0), (bf16*)(ws + WS_WIN), 1024, nb * 32, g_mix, scr, kb * 64, lane); continue; } r -= 1536;
        if (r < 512) { const int nb = r >> 4, kb = r & 15; tr_item(P.in[16], 1024, nb * 32, (bf16*)(ws + WS_WOUT), 1024, nb * 32, nullptr, scr, kb * 64, lane); continue; } r -= 512;
        if (r < 2048) { const int nb = r >> 4, kb = r & 15; tr_item(P.in[18], 4096, nb * 32, (bf16*)(ws + WS_WUP), 1024, nb * 32, P.in[17], scr, kb * 64, lane); continue; } r -= 2048;
        if (r < 2048) { const int nb = r >> 6, kb = r & 63; tr_item(P.in[19], 1024, nb * 32, (bf16*)(ws + WS_WDN), 4096, nb * 32, nullptr, scr, kb * 64, lane); continue; } r -= 2048;
        if (r < 512) { const int nb = r >> 4, kb = r & 15; tr_item(P.in[22], 1024, nb * 32, (bf16*)(ws + WS_WG), 1024, nb * 32, P.in[20], scr, kb * 64, lane); continue; } r -= 512;
        { const int nb = r >> 2, kb = r & 3; tr_item(P.in[21], 1024, nb * 32, (bf16*)(ws + WS_WPLE), 256, nb * 32, nullptr, scr, kb * 64, lane); }
    }
}

__device__ __forceinline__ void phase0(const Params& P, LAS unsigned char* lds, int tid, int lane, int wave, int bid, int G) {
    unsigned char* ws = P.ws; const int gw = bid * 8 + wave, NGW = G * 8, gt = bid * 512 + tid, NGT = G * 512;
    const float* w_in = P.in[7]; const float* g_mix = P.in[6];
    LAS f32x4* W8 = (LAS f32x4*)(lds + 67584);
    for (int idx = tid; idx < 2048; idx += 512) {
        const int l = idx & 63, half = (idx >> 6) & 1, je = idx >> 7; const int k = 256 * (je >> 2) + 4 * l + (je & 3);
        const float g = g_mix[k]; const float* s = w_in + (size_t)k * SRCN + 2048 + 4 * half;
        W8[idx] = (f32x4){s[0] * g, s[1] * g, s[2] * g, s[3] * g};
    }
    { const float* w_s = P.in[14]; bf16* WSB = (bf16*)(ws + WS_WSB);
      for (int i = gt; i < 65536; i += NGT) { const int t = (i >> 7) & 127, s = i & 127; WSB[i] = (bf16)f2bf(s <= t ? w_s[i] : 0.f); } }
    { bf16* PB = (bf16*)(ws + WS_PB); const float* pp = P.in[4]; const float* ps = P.in[5];
      for (int i = gt; i < MT * 32; i += NGT) { const int row = i >> 5, c8 = i & 31; const float* src = row < MPR ? pp + (size_t)row * DPLE + c8 * 8 : ps + (size_t)(row - MPR) * DPLE + c8 * 8;
          const f32x4 a = *(const f32x4*)src, b = *(const f32x4*)(src + 4); u32x4 o; o.x = pk2(a.x, a.y); o.y = pk2(a.z, a.w); o.z = pk2(b.x, b.y); o.w = pk2(b.z, b.w); *(u32x4*)(PB + (size_t)i * 8) = o; } }
    weight_items(P, (LAS float*)(lds + wave * 8448), lane, 0, 1536, gw, NGW);
    __syncthreads();
    float* RS0 = (float*)(ws + WS_RS0); float* BETA = (float*)(ws + WS_BETA); float* GG = (float*)(ws + WS_G); bf16* XB = (bf16*)(ws + WS_XB);
    const float* a_log = P.in[9]; const float* dt_bias = P.in[10];
    f32x4 vnx[4];
    { const int row = gw < MT ? gw : MT - 1; const float* xr = row < MPR ? P.in[0] + (size_t)row * DM : P.in[1] + (size_t)(row - MPR) * DM;
#pragma unroll
      for (int j = 0; j < 4; ++j) vnx[j] = *(const f32x4*)(xr + 256 * j + 4 * lane); }
    for (int row = gw; row < MT; row += NGW) {
        f32x4 v[4]; float ss = 0.f;
#pragma unroll
        for (int j = 0; j < 4; ++j) { v[j] = vnx[j]; ss += dot4(v[j]); }
        { const int rn = (row + NGW < MT) ? row + NGW : row; const float* xr = rn < MPR ? P.in[0] + (size_t)rn * DM : P.in[1] + (size_t)(rn - MPR) * DM;
#pragma unroll
          for (int j = 0; j < 4; ++j) vnx[j] = *(const f32x4*)(xr + 256 * j + 4 * lane); }
#pragma unroll
        for (int j = 0; j < 4; ++j) st_bf4(XB + (size_t)row * DM + 256 * j + 4 * lane, v[j]);
        f32x4 d0 = (f32x4){0.f, 0.f, 0.f, 0.f}, d1 = d0;
#pragma unroll
        for (int j = 0; j < 4; ++j)
#pragma unroll
            for (int e = 0; e < 4; ++e) { const float xv = v[j][e]; d0 += W8[((j * 4 + e) * 2 + 0) * 64 + lane] * xv; d1 += W8[((j * 4 + e) * 2 + 1) * 64 + lane] * xv; }
        const bool b0 = lane & 1, b1 = lane & 2, b2 = lane & 4;
        float t0 = (b0 ? d1.x : d0.x) + __shfl_xor(b0 ? d0.x : d1.x, 1), t1 = (b0 ? d1.y : d0.y) + __shfl_xor(b0 ? d0.y : d1.y, 1);
        float t2 = (b0 ? d1.z : d0.z) + __shfl_xor(b0 ? d0.z : d1.z, 1), t3 = (b0 ? d1.w : d0.w) + __shfl_xor(b0 ? d0.w : d1.w, 1);
        float u0 = (b1 ? t2 : t0) + __shfl_xor(b1 ? t0 : t2, 2), u1 = (b1 ? t3 : t1) + __shfl_xor(b1 ? t1 : t3, 2);
        float w = (b2 ? u1 : u0) + __shfl_xor(b2 ? u0 : u1, 4);
        w += __shfl_xor(w, 8); w += __shfl_xor(w, 16); w += __shfl_xor(w, 32);
        ss = wave_sum(ss); const float rs = rsqrtf(ss * (1.f / DM) + EPS);
        if (lane < 8) { const int hh = 2 * ((lane >> 1) & 1) + ((lane >> 2) & 1);
            if (!(lane & 1)) BETA[(size_t)row * 4 + hh] = sigmoidf_(w * rs);
            else { const float xa = w * rs + dt_bias[hh]; const float sp = fmaxf(xa, 0.f) + log1pf(expf(-fabsf(xa))); GG[(size_t)row * 4 + hh] = -expf(a_log[hh]) * sp; } }
        if (lane == 0) RS0[row] = rs;
    }
}

__device__ __forceinline__ void gdn_prep(const Params& P, LAS unsigned char* lds, int tid, int lane, int wave, int bid, int G) {
    unsigned char* ws = P.ws; const bf16* PROJ = (const bf16*)(ws + WS_PROJ); const float* BETA = (const float*)(ws + WS_BETA); const float* GG = (const float*)(ws + WS_G);
    bf16* FRB = (bf16*)P.out; bf16* ATf = (bf16*)(ws + WS_AT); float* DECF = (float*)(ws + WS_DECF); const float* wconv = P.in[8];
    const int tid0 = tid;
    for (int u0 = bid * 2; u0 < 1024; u0 += G * 2) {
        int tid = tid0; asm volatile("" : "+v"(tid));
        const int lane = tid & 63, wv = __builtin_amdgcn_readfirstlane(tid >> 6), hb = wv >> 2, t = tid & 255, w4 = wv & 3, c = lane & 15, q = lane >> 4;
        LAS unsigned char* base = lds + hb * 70656;
        LAS bf16* q_l = (LAS bf16*)base; LAS bf16* k_l = (LAS bf16*)(base + 17408); LAS bf16* v_l = (LAS bf16*)(base + 34816);
        LAS float* A_l = (LAS float*)(base + 52224); LAS float* gc = (LAS float*)(base + 69632); LAS float* bt = gc + 64;
        const int unit = u0 + hb, cg = unit >> 2, h = unit & 3, n = cg & 31; const int row0 = cg * 64, tokb = 16 * w4;
        float y[3][16][2];
#pragma unroll
        for (int g3 = 0; g3 < 3; ++g3) {
            const int col = g3 * 512 + h * 128 + 2 * lane;
            const float w0a = wconv[col], w0b = wconv[col + 1], w1a = wconv[1536 + col], w1b = wconv[1536 + col + 1], w2a = wconv[3072 + col], w2b = wconv[3072 + col + 1], w3a = wconv[4608 + col], w3b = wconv[4608 + col + 1];
            const bf16* src = PROJ + (size_t)(row0 + tokb) * NIN + col;
            unsigned raw[19];
            const bool nohist = (n == 0 && w4 == 0);
#pragma unroll
            for (int i = 0; i < 19; ++i) raw[i] = (i < 3 && nohist) ? 0u : *(const unsigned*)(src + (ptrdiff_t)(i - 3) * NIN);
            typedef float f32x2c __attribute__((ext_vector_type(2)));
            const f32x2c w0 = (f32x2c){w0a, w0b}, w1 = (f32x2c){w1a, w1b}, w2 = (f32x2c){w2a, w2b}, w3 = (f32x2c){w3a, w3b};
            f32x2c xr2[19];
#pragma unroll
            for (int i = 0; i < 19; ++i) xr2[i] = (f32x2c){bflo(raw[i]), bfhi(raw[i])};
#pragma unroll
            for (int i = 0; i < 16; ++i) { const f32x2c yy = w0 * xr2[i] + w1 * xr2[i + 1] + w2 * xr2[i + 2] + w3 * xr2[i + 3];
                y[g3][i][0] = siluf_(yy.x); y[g3][i][1] = siluf_(yy.y); }
        }
#pragma unroll
        for (int g3 = 0; g3 < 2; ++g3)
#pragma unroll
            for (int i = 0; i < 16; ++i) { const float s = wave_sum(y[g3][i][0] * y[g3][i][0] + y[g3][i][1] * y[g3][i][1]); const float r = rsqrtf(s + 1e-6f); y[g3][i][0] *= r; y[g3][i][1] *= r; }
#pragma unroll
        for (int i = 0; i < 16; ++i) {
            *(LAS unsigned*)(q_l + (tokb + i) * 136 + 2 * lane) = pk2(y[0][i][0], y[0][i][1]);
            *(LAS unsigned*)(k_l + (tokb + i) * 136 + 2 * lane) = pk2(y[1][i][0], y[1][i][1]);
            *(LAS unsigned*)(v_l + (tokb + i) * 136 + 2 * lane) = pk2(y[2][i][0], y[2][i][1]);
        }
        if (w4 == 0) {
            int lane = tid; asm volatile("" : "+v"(lane)); lane &= 63;
            float g = GG[(size_t)(row0 + lane) * 4 + h];
#pragma unroll
            for (int o = 1; o < 64; o <<= 1) { const float tt = __shfl_up(g, o); if (lane >= o) g += tt; }
            const float btv = BETA[(size_t)(row0 + lane) * 4 + h]; gc[lane] = g; bt[lane] = btv; gc[128 + lane] = btv * __expf(g); gc[192 + lane] = __expf(__shfl(g, 63) - g);
            const float dl = __expf(__shfl(g, 63));
            *(f32x4*)(DECF + (size_t)unit * 256 + lane * 4) = (f32x4){dl, dl, dl, dl};
        }
        __syncthreads();
        {
            const int it = w4; bf16x8 qf[4], kif[4];
#pragma unroll
            for (int kd = 0; kd < 4; ++kd) { qf[kd] = *(const LAS bf16x8*)(q_l + (16 * it + c) * 136 + 32 * kd + 8 * q); kif[kd] = *(const LAS bf16x8*)(k_l + (16 * it + c) * 136 + 32 * kd + 8 * q); }
            const int ii = 16 * it + c; const float gci = gc[ii];
            float atv[2][8];
#pragma unroll
            for (int jt = 0; jt < 4; ++jt) {
                if (jt <= it) {
                    f32x4 aq = (f32x4){0.f, 0.f, 0.f, 0.f}, ak = aq;
#pragma unroll
                    for (int kd = 0; kd < 4; ++kd) { const bf16x8 kjf = *(const LAS bf16x8*)(k_l + (16 * jt + c) * 136 + 32 * kd + 8 * q); aq = mfma16(kjf, qf[kd], aq); ak = mfma16(kif[kd], kjf, ak); }
                    const f32x4 gj = *(const LAS f32x4*)(gc + 16 * jt + 4 * q); f32x4 av;
                    const f32x4 gi4 = *(const LAS f32x4*)(gc + 16 * it + 4 * q), bi4 = *(const LAS f32x4*)(bt + 16 * it + 4 * q); const float gcj = gc[16 * jt + c];
#pragma unroll
                    for (int r = 0; r < 4; ++r) { const int j = 16 * jt + 4 * q + r; const float dec = (j <= ii) ? __expf(gci - gj[r]) : 0.f;
                        atv[jt >> 1][(jt & 1) * 4 + r] = aq[r] * dec * QSCALE;
                        const int i2 = 16 * it + 4 * q + r, j2 = 16 * jt + c; av[r] = (j2 < i2) ? ak[r] * bi4[r] * __expf(gi4[r] - gcj) : 0.f; }
                    *(LAS f32x4*)(A_l + (16 * jt + c) * 68 + 16 * it + 4 * q) = av;
                } else {
#pragma unroll
                    for (int r = 0; r < 4; ++r) atv[jt >> 1][(jt & 1) * 4 + r] = 0.f;
                }
            }
#pragma unroll
            for (int ks = 0; ks < 2; ++ks) { u32x4 o; o.x = pk2(atv[ks][0], atv[ks][1]); o.y = pk2(atv[ks][2], atv[ks][3]); o.z = pk2(atv[ks][4], atv[ks][5]); o.w = pk2(atv[ks][6], atv[ks][7]);
                *(u32x4*)(ATf + ((size_t)unit * 8 + it * 2 + ks) * 512 + lane * 8) = o; }
        }
        {
            const float gl = gc[63];
#pragma unroll
            for (int e = 0; e < 4; ++e) {
                const int f = w4 + 4 * e;
                { const int mt = f >> 2, ks = f & 3, tok = 16 * mt + c; const float sc = __expf(gc[tok]) * QSCALE;
                  const u32x2 lo = *(const LAS u32x2*)(q_l + tok * 136 + 32 * ks + 4 * q), hi = *(const LAS u32x2*)(q_l + tok * 136 + 32 * ks + 16 + 4 * q);
                  u32x4 o; o.x = pk2(bflo(lo.x) * sc, bfhi(lo.x) * sc); o.y = pk2(bflo(lo.y) * sc, bfhi(lo.y) * sc); o.z = pk2(bflo(hi.x) * sc, bfhi(hi.x) * sc); o.w = pk2(bflo(hi.y) * sc, bfhi(hi.y) * sc);
                  *(u32x4*)(FRB + FR_QG + (size_t)unit * 8192 + f * 512 + lane * 8) = o; }
                { const int mt = f >> 1, ks2 = f & 1; float kv[8];
#pragma unroll
                  for (int jj = 0; jj < 8; ++jj) { const int tok = 32 * ks2 + 16 * (jj >> 2) + 4 * q + (jj & 3); kv[jj] = bf2f(k_l[tok * 136 + 16 * mt + c]) * gc[192 + tok]; }
                  u32x4 o; o.x = pk2(kv[0], kv[1]); o.y = pk2(kv[2], kv[3]); o.z = pk2(kv[4], kv[5]); o.w = pk2(kv[6], kv[7]);
                  *(u32x4*)(FRB + FR_KG + (size_t)unit * 8192 + f * 512 + lane * 8) = o; }
            }
        }
        int t5 = t; asm volatile("" : "+v"(t5));
        const int col = t5 & 127, kind = __builtin_amdgcn_readfirstlane(t5 >> 7);
        typedef float f32x2s __attribute__((ext_vector_type(2)));
        f32x2s sp[32];
        {
            const LAS bf16* srcl = kind ? k_l : v_l;
#pragma unroll
            for (int i = 0; i < 64; ++i) { const float m = (kind ? gc + 128 : bt)[i]; sp[i >> 1][i & 1] = bf2f(srcl[i * 136 + col]) * m; }
        }
        __syncthreads();
        {
#pragma clang loop unroll(full)
            for (int j = 0; j < 63; ++j) {
                f32x4 avc[16];
#pragma unroll
                for (int v = (j + 1) >> 2; v < 16; ++v) avc[v] = *(const LAS f32x4*)(A_l + j * 68 + 4 * v);
                __builtin_amdgcn_sched_barrier(0);
                const float sj = sp[j >> 1][j & 1]; const f32x2s sj2 = (f32x2s){sj, sj};
#pragma unroll
                for (int v = (j + 1) >> 2; v < 16; ++v) { const f32x4 a = avc[v];
                    sp[2 * v] -= (f32x2s){a.x, a.y} * sj2; sp[2 * v + 1] -= (f32x2s){a.z, a.w} * sj2; }
                __builtin_amdgcn_sched_barrier(0);
            }
        }
        {
            LAS bf16* dstl = kind ? k_l : v_l;
#pragma unroll
            for (int i = 0; i < 64; ++i) dstl[i * 136 + col] = (bf16)f2bf(sp[i >> 1][i & 1]);
        }
        __syncthreads();
        { int l7 = tid; asm volatile("" : "+v"(l7)); const int c = l7 & 15, q = (l7 >> 4) & 3, lane = l7 & 63;
#pragma unroll
        for (int e = 0; e < 4; ++e) { const int f = w4 + 4 * e, mt = f >> 2, ks = f & 3, tok = 16 * mt + c;
            const u32x2 lo = *(const LAS u32x2*)(k_l + tok * 136 + 32 * ks + 4 * q), hi = *(const LAS u32x2*)(k_l + tok * 136 + 32 * ks + 16 + 4 * q);
            *(u32x4*)(FRB + FR_W + (size_t)unit * 8192 + f * 512 + lane * 8) = (u32x4){lo.x, lo.y, hi.x, hi.y}; }
#pragma unroll
        for (int e = 0; e < 8; ++e) { const int f = w4 + 4 * e, sl = f >> 2, mt = f & 3; const LAS bf16* s = v_l + (16 * mt + 4 * q) * 136 + 16 * sl + c;
            u32x2 o; o.x = (unsigned)s[0] | ((unsigned)s[136] << 16); o.y = (unsigned)s[272] | ((unsigned)s[408] << 16);
            *(u32x2*)(FRB + FR_U + ((size_t)unit * 32 + f) * 256 + lane * 4) = o; }
        }
        __syncthreads();
    }
}

__device__ __forceinline__ void sgu_prompt(const Params& P, LAS unsigned char* lds, int tid, int lane, int wave, int bid, int G) {
    asm volatile("" : "+v"(tid)); lane = tid & 63;
    unsigned char* ws = P.ws; const bf16* PROJ = (const bf16*)(ws + WS_PROJ); bf16* MIX = (bf16*)(ws + WS_MIX); const bf16* WSB = (const bf16*)(ws + WS_WSB);
    const float* lng = P.in[12]; const float* lnb = P.in[13]; const float* b_s = P.in[15];
    LAS bf16* vgT = (LAS bf16*)lds; const int c = lane & 15, q = lane >> 4;
    float lg[8], lb[8];
#pragma unroll
    for (int e = 0; e < 8; ++e) { lg[e] = lng[8 * lane + e]; lb[e] = lnb[8 * lane + e]; }
    for (int su = bid; su < 256; su += G) {
        const int b = su >> 5, n = (su >> 1) & 15, hp = su & 1; const int row0 = b * 2048 + n * 128;
        u32x4 rawv[16];
#pragma unroll
        for (int i = 0; i < 16; ++i) rawv[i] = *(const u32x4*)(PROJ + (size_t)(row0 + 16 * wave + i) * NIN + 2560 + 8 * lane);
        unsigned pkv[8][8];
#pragma unroll
        for (int i2 = 0; i2 < 8; ++i2) {
            float xa[8], xb2[8];
#pragma unroll
            for (int hh = 0; hh < 2; ++hh) {
                const u32x4 raw = rawv[2 * i2 + hh];
                float x[8] = {bflo(raw.x), bfhi(raw.x), bflo(raw.y), bfhi(raw.y), bflo(raw.z), bfhi(raw.z), bflo(raw.w), bfhi(raw.w)};
                float s = 0.f;
#pragma unroll
                for (int e = 0; e < 8; ++e) s += x[e];
                const float mean = wave_sum(s) * (1.f / 512.f); float s2 = 0.f;
#pragma unroll
                for (int e = 0; e < 8; ++e) { x[e] -= mean; s2 += x[e] * x[e]; }
                const float rstd = rsqrtf(wave_sum(s2) * (1.f / 512.f) + EPS);
#pragma unroll
                for (int e = 0; e < 8; ++e) { const float vn_ = x[e] * rstd * lg[e] + lb[e]; if (hh == 0) xa[e] = vn_; else xb2[e] = vn_; }
            }
#pragma unroll
            for (int e = 0; e < 8; ++e) pkv[e][i2] = pk2(xa[e], xb2[e]);
        }
        if ((q >> 1) == hp) {
#pragma unroll
            for (int e = 0; e < 8; ++e) {
                LAS bf16* rowp = vgT + (q & 1) * 17408 + (8 * c + e) * 136;
                *(LAS u32x4*)(rowp + 8 * ((2 * wave) ^ c)) = (u32x4){pkv[e][0], pkv[e][1], pkv[e][2], pkv[e][3]};
                *(LAS u32x4*)(rowp + 8 * ((2 * wave + 1) ^ c)) = (u32x4){pkv[e][4], pkv[e][5], pkv[e][6], pkv[e][7]};
            }
        }
        __syncthreads();
#pragma unroll 1
        for (int hh = 0; hh < 2; ++hh) { const int h = 2 * hp + hh; const LAS bf16* vgh = vgT + hh * 17408;
        f32x4 acc[8]; u32x2 upre[8]; const float bias_pre = b_s[h * 128 + 16 * wave + c];
#pragma unroll
        for (int nt = 0; nt < 8; ++nt) { acc[nt] = (f32x4){0.f, 0.f, 0.f, 0.f}; upre[nt] = *(const u32x2*)(PROJ + ((size_t)row0 + 16 * wave + c) * NIN + 2048 + h * 128 + 16 * nt + 4 * q); }
        for (int ks = 0; ks <= (wave >> 1); ++ks) {
            const bf16x8 bfr = *(const bf16x8*)(WSB + (size_t)(h * 128 + 16 * wave + c) * 128 + 32 * ks + 8 * q);
#pragma unroll
            for (int nt = 0; nt < 8; ++nt) { const int d = 16 * nt + c; const bf16x8 afr = *(const LAS bf16x8*)(vgh + d * 136 + 8 * ((4 * ks + q) ^ ((d >> 3) & 15))); acc[nt] = mfma16(afr, bfr, acc[nt]); }
        }
        { const int tt = 16 * wave + c; const size_t row = (size_t)row0 + tt; const float bias = bias_pre;
#pragma unroll
          for (int nt = 0; nt < 8; ++nt) { const int d0 = 16 * nt + 4 * q; const u32x2 ur = upre[nt];
              f32x4 o; o.x = bflo(ur.x) * (acc[nt].x + bias); o.y = bfhi(ur.x) * (acc[nt].y + bias); o.z = bflo(ur.y) * (acc[nt].z + bias); o.w = bfhi(ur.y) * (acc[nt].w + bias);
              st_bf4(MIX + row * DM + 512 + h * 128 + d0, o); } }
        }
        __syncthreads();
    }
}

__device__ __forceinline__ void sample_gdn(const Params& P, LAS unsigned char* lds, int tid, int lane, int wave, int bid, int G) {
    asm volatile("" : "+v"(tid)); lane = tid & 63;
    unsigned char* ws = P.ws; const bf16* PROJ = (const bf16*)(ws + WS_PROJ); bf16* MIX = (bf16*)(ws + WS_MIX); const float* BETA = (const float*)(ws + WS_BETA); const float* GG = (const float*)(ws + WS_G);
    const float* sconv = P.in[2]; const float* sgdn = P.in[3]; const float* wconv = P.in[8]; const float* gnorm = P.in[11];
    float* NCS = P.out + O_NCS; float* NGS = P.out + O_NGS;
    LAS float* sm = (LAS float*)lds; LAS float* scal = sm + 384; LAS f32x4* red = (LAS f32x4*)(sm + 512);
    const int dv4 = tid & 31, dkg = tid >> 5;
    for (int su = bid; su < 512; su += G) {
        const int bs = su >> 2, h = su & 3; const size_t srow = (size_t)MPR + bs;
        const float* S0 = sgdn + (size_t)(bs * 4 + h) * 16384 + (size_t)(8 * dkg) * 128 + 4 * dv4;
        f32x4 s0[8];
#pragma unroll
        for (int i = 0; i < 8; ++i) s0[i] = *(const f32x4*)(S0 + (size_t)i * 128);
        if (tid < 384) { const int g3 = tid >> 7, ch = tid & 127, col = g3 * 512 + h * 128 + ch;
            const float x = bf2f(PROJ[srow * NIN + col]); const float h0 = sconv[(size_t)(bs * 3 + 0) * 1536 + col], h1 = sconv[(size_t)(bs * 3 + 1) * 1536 + col], h2 = sconv[(size_t)(bs * 3 + 2) * 1536 + col];
            const float yv = siluf_(wconv[col] * h0 + wconv[1536 + col] * h1 + wconv[3072 + col] * h2 + wconv[4608 + col] * x);
            NCS[(size_t)(bs * 3 + 0) * 1536 + col] = h1; NCS[(size_t)(bs * 3 + 1) * 1536 + col] = h2; NCS[(size_t)(bs * 3 + 2) * 1536 + col] = x;
            sm[g3 * 128 + ch] = yv; }
        __syncthreads();
        if (wave < 2) { const float a = sm[wave * 128 + lane], b2 = sm[wave * 128 + 64 + lane]; const float s = wave_sum(a * a + b2 * b2); if (lane == 0) scal[wave] = rsqrtf(s + 1e-6f); }
        __syncthreads();
        const float qn = scal[0], kn = scal[1];
        const float beta = BETA[srow * 4 + h], eg = __expf(GG[srow * 4 + h]);
        float kk[8], qq[8]; f32x4 p = (f32x4){0.f, 0.f, 0.f, 0.f};
#pragma unroll
        for (int i = 0; i < 8; ++i) { kk[i] = sm[128 + 8 * dkg + i] * kn; qq[i] = sm[8 * dkg + i] * qn; p += s0[i] * kk[i]; }
        red[dkg * 32 + dv4] = p;
        __syncthreads();
        f32x4 kS = red[dv4];
#pragma unroll
        for (int g = 1; g < 16; ++g) kS += red[g * 32 + dv4];
        const f32x4 v4 = *(const LAS f32x4*)(sm + 256 + 4 * dv4); const f32x4 vnew = (v4 - kS * eg) * beta;
        __syncthreads();
        f32x4 po = (f32x4){0.f, 0.f, 0.f, 0.f}; float* S1 = NGS + (size_t)(bs * 4 + h) * 16384 + (size_t)(8 * dkg) * 128 + 4 * dv4;
#pragma unroll
        for (int i = 0; i < 8; ++i) { const f32x4 s1 = s0[i] * eg + vnew * kk[i]; *(f32x4*)(S1 + (size_t)i * 128) = s1; po += s1 * qq[i]; }
        red[dkg * 32 + dv4] = po;
        __syncthreads();
        if (tid < 32) { f32x4 o = red[dv4];
#pragma unroll
            for (int g = 1; g < 16; ++g) o += red[g * 32 + dv4];
            o = o * QSCALE; float s = dot4(o); s += __shfl_xor(s, 1); s += __shfl_xor(s, 2); s += __shfl_xor(s, 4); s += __shfl_xor(s, 8); s += __shfl_xor(s, 16);
            const float rs = rsqrtf(s * (1.f / 128.f) + EPS); const u32x2 zr = *(const u32x2*)(PROJ + srow * NIN + 1536 + h * 128 + 4 * dv4); const f32x4 gn = *(const f32x4*)(gnorm + 4 * dv4);
            f32x4 m; m.x = o.x * rs * gn.x * siluf_(bflo(zr.x)); m.y = o.y * rs * gn.y * siluf_(bfhi(zr.x)); m.z = o.z * rs * gn.z * siluf_(bflo(zr.y)); m.w = o.w * rs * gn.w * siluf_(bfhi(zr.y));
            st_bf4(MIX + srow * DM + h * 128 + 4 * dv4, m); }
        __syncthreads();
    }
}

__device__ __forceinline__ void phase2_misc(const Params& P, int tid, int lane, int wave, int bid, int G) {
    unsigned char* ws = P.ws; const bf16* PROJ = (const bf16*)(ws + WS_PROJ); bf16* MIX = (bf16*)(ws + WS_MIX);
    { float* NCP = P.out + O_NCP; for (int i = bid * 512 + tid; i < 36864; i += G * 512) { const int b = i / 4608, rem = i - b * 4608, j = rem / 1536, col = rem - j * 1536; NCP[i] = bf2f(PROJ[(size_t)(b * 2048 + 2045 + j) * NIN + col]); } }
    const int gw = bid * 8 + wave;
    if (gw < MSA) { const int bs = gw; const size_t srow = (size_t)MPR + bs; const float* lng = P.in[12]; const float* lnb = P.in[13]; float* NSV = P.out + O_NSV;
        const u32x4 raw = *(const u32x4*)(PROJ + srow * NIN + 2560 + 8 * lane); const u32x4 uraw = *(const u32x4*)(PROJ + srow * NIN + 2048 + 8 * lane);
        float x[8] = {bflo(raw.x), bfhi(raw.x), bflo(raw.y), bfhi(raw.y), bflo(raw.z), bfhi(raw.z), bflo(raw.w), bfhi(raw.w)};
        const float uu[8] = {bflo(uraw.x), bfhi(uraw.x), bflo(uraw.y), bfhi(uraw.y), bflo(uraw.z), bfhi(uraw.z), bflo(uraw.w), bfhi(uraw.w)};
        float s = 0.f;
#pragma unroll
        for (int e = 0; e < 8; ++e) s += x[e];
        const float mean = wave_sum(s) * (1.f / 512.f); float s2 = 0.f;
#pragma unroll
        for (int e = 0; e < 8; ++e) { x[e] -= mean; s2 += x[e] * x[e]; }
        const float rstd = rsqrtf(wave_sum(s2) * (1.f / 512.f) + EPS); const int h = lane >> 4; const float w00 = P.in[14][(size_t)h * 16384], b0 = P.in[15][h * 128];
        float vg[8], sg[8];
#pragma unroll
        for (int e = 0; e < 8; ++e) { vg[e] = x[e] * rstd * lng[8 * lane + e] + lnb[8 * lane + e]; sg[e] = uu[e] * (w00 * vg[e] + b0); }
        *(f32x4*)(NSV + (size_t)bs * 512 + 8 * lane) = (f32x4){vg[0], vg[1], vg[2], vg[3]}; *(f32x4*)(NSV + (size_t)bs * 512 + 8 * lane + 4) = (f32x4){vg[4], vg[5], vg[6], vg[7]};
        u32x4 o; o.x = pk2(sg[0], sg[1]); o.y = pk2(sg[2], sg[3]); o.z = pk2(sg[4], sg[5]); o.w = pk2(sg[6], sg[7]); *(u32x4*)(MIX + srow * DM + 512 + 8 * lane) = o; }
}

constexpr int ST_BYTES = 60416;
__device__ __forceinline__ void glds16(const void* g, LAS unsigned char* l) { __builtin_amdgcn_global_load_lds((const unsigned*)g, (LAS unsigned*)l, 16, 0, 0); }
__device__ __forceinline__ void scan_issue1(const bf16* FRB, const bf16* ATf, const float* DECF, int unit, int sl, LAS unsigned char* L, int lane) {
    const bf16* w = FRB + FR_W + (size_t)unit * 8192 + lane * 8; const bf16* at = ATf + (size_t)unit * 4096 + lane * 8; const bf16* uu = FRB + FR_U + ((size_t)unit * 8 + sl) * 1024 + lane * 8;
#pragma unroll
    for (int f = 0; f < 16; ++f) glds16(w + f * 512, L + f * 1024);
#pragma unroll
    for (int f = 0; f < 8; ++f) glds16(at + f * 512, L + 49152 + f * 1024);
    glds16(uu, L + 57344); glds16(uu + 512, L + 58368);
    glds16(DECF + (size_t)unit * 256 + lane * 4, L + 59392);
}
__device__ __forceinline__ void scan_issue2(const bf16* FRB, int unit, LAS unsigned char* L, int lane) {
    const bf16* qg = FRB + FR_QG + (size_t)unit * 8192 + lane * 8; const bf16* kg = FRB + FR_KG + (size_t)unit * 8192 + lane * 8;
#pragma unroll
    for (int f = 0; f < 16; ++f) glds16(qg + f * 512, L + 16384 + f * 1024);
#pragma unroll
    for (int f = 0; f < 16; ++f) glds16(kg + f * 512, L + 32768 + f * 1024);
}
__device__ __forceinline__ void gdn_scan(const Params& P, LAS unsigned char* lds, volatile LAS unsigned* flg, int lane, int wave, int bid, int G) {
    if (wave > 2) return;
    asm volatile("" : "+v"(lane));
    unsigned char* ws = P.ws; const bf16* FRB = (const bf16*)P.out; const bf16* ATf = (const bf16*)(ws + WS_AT); const float* DECF = (const float*)(ws + WS_DECF);
    bf16* O = (bf16*)(ws + WS_O); float* NGP = P.out + O_NGP; const int c = lane & 15, q = lane >> 4;
    int gs = 0;
    for (int job = bid; job < 256; job += G, gs += 32) {
        const int bh = (job & 7) + 8 * (job >> 6), sl = (job >> 3) & 7, b = bh >> 2, h = bh & 3;
        if (wave != 0) {
            for (int n = 0; n < 32; ++n) {
                const int s_ = gs + n; LAS unsigned char* L = lds + (s_ & 1) * ST_BYTES;
                while ((int)flg[0] < s_ - 1) __builtin_amdgcn_s_sleep(1);
                asm volatile("" ::: "memory");
                if (wave == 1) scan_issue1(FRB, ATf, DECF, (b * 32 + n) * 4 + h, sl, L, lane); else scan_issue2(FRB, (b * 32 + n) * 4 + h, L, lane);
                asm volatile("s_waitcnt vmcnt(0)" ::: "memory");
                if (lane == 0) flg[wave] = (unsigned)(s_ + 1);
                asm volatile("s_waitcnt lgkmcnt(0)" ::: "memory");
            }
            continue;
        }
        f32x4 S[8];
#pragma unroll
        for (int i = 0; i < 8; ++i) S[i] = (f32x4){0.f, 0.f, 0.f, 0.f};
        for (int n = 0; n < 32; ++n) {
            const int s_ = gs + n; LAS unsigned char* L = lds + (s_ & 1) * ST_BYTES;
            while ((int)flg[1] < s_ + 1 || (int)flg[2] < s_ + 1) __builtin_amdgcn_s_sleep(1);
            asm volatile("" ::: "memory");
            bf16x8 Wfr[16], QGfr[16]; u32x2 Ufr[4];
#pragma unroll
            for (int f = 0; f < 16; ++f) Wfr[f] = *(const LAS bf16x8*)(L + f * 1024 + lane * 16);
#pragma unroll
            for (int mt = 0; mt < 4; ++mt) Ufr[mt] = *(const LAS u32x2*)(L + 57344 + mt * 512 + lane * 8);
#pragma unroll
            for (int f = 0; f < 16; ++f) QGfr[f] = *(const LAS bf16x8*)(L + 16384 + f * 1024 + lane * 16);
            __builtin_amdgcn_sched_barrier(0);
            bf16x8 Sb[4];
#pragma unroll
            for (int ks = 0; ks < 4; ++ks) Sb[ks] = pack8(S[2 * ks], S[2 * ks + 1]);
            f32x4 va[4], oa[4];
#pragma unroll
            for (int mt = 0; mt < 4; ++mt) { va[mt] = (f32x4){0.f, 0.f, 0.f, 0.f}; oa[mt] = va[mt]; }
#pragma unroll
            for (int ks = 0; ks < 4; ++ks)
#pragma unroll
                for (int mt = 0; mt < 4; ++mt) va[mt] = mfma16(Wfr[mt * 4 + ks], Sb[ks], va[mt]);
            __builtin_amdgcn_sched_barrier(0);
            bf16x8 ATfr[8];
#pragma unroll
            for (int f = 0; f < 8; ++f) ATfr[f] = *(const LAS bf16x8*)(L + 49152 + f * 1024 + lane * 16);
            const float dec = *(const LAS float*)(L + 59392 + lane * 4);
            __builtin_amdgcn_sched_barrier(0);
#pragma unroll
            for (int ks = 0; ks < 4; ++ks)
#pragma unroll
                for (int mt = 0; mt < 4; ++mt) oa[mt] = mfma16(QGfr[mt * 4 + ks], Sb[ks], oa[mt]);
            __builtin_amdgcn_sched_barrier(0);
            bf16x8 KGfr[16];
#pragma unroll
            for (int f = 0; f < 16; ++f) KGfr[f] = *(const LAS bf16x8*)(L + 32768 + f * 1024 + lane * 16);
            __builtin_amdgcn_sched_barrier(0);
            f32x4 vn[4];
#pragma unroll
            for (int mt = 0; mt < 4; ++mt) vn[mt] = (f32x4){bflo(Ufr[mt].x) - va[mt].x, bfhi(Ufr[mt].x) - va[mt].y, bflo(Ufr[mt].y) - va[mt].z, bfhi(Ufr[mt].y) - va[mt].w};
            bf16x8 vb[2];
#pragma unroll
            for (int k2 = 0; k2 < 2; ++k2) vb[k2] = pack8(vn[2 * k2], vn[2 * k2 + 1]);
#pragma unroll
            for (int mt = 0; mt < 8; ++mt) S[mt] = S[mt] * dec;
#pragma unroll
            for (int k2 = 0; k2 < 2; ++k2) {
#pragma unroll
                for (int mt = 0; mt < 8; ++mt) S[mt] = mfma16(KGfr[mt * 2 + k2], vb[k2], S[mt]);
#pragma unroll
                for (int mt = 0; mt < 4; ++mt) oa[mt] = mfma16(ATfr[mt * 2 + k2], vb[k2], oa[mt]);
            }
#pragma unroll
            for (int mt = 0; mt < 4; ++mt) {
                const bool od = lane & 1; const float t0 = dpp_get<0xB1, 0xF>(od ? oa[mt].x : oa[mt].z), t1 = dpp_get<0xB1, 0xF>(od ? oa[mt].y : oa[mt].w);
                unsigned* op = (unsigned*)(O + ((size_t)(b * 2048 + n * 64 + 16 * mt + 4 * q + (od ? 2 : 0))) * 512 + h * 128 + 16 * sl + (c & ~1));
                op[0] = od ? pk2(t0, oa[mt].z) : pk2(oa[mt].x, t0); op[256] = od ? pk2(t1, oa[mt].w) : pk2(oa[mt].y, t1); }
            asm volatile("s_waitcnt lgkmcnt(0)" ::: "memory");
            if (lane == 0) flg[0] = (unsigned)(s_ + 1);
            asm volatile("" ::: "memory");
        }
#pragma unroll
        for (int mt = 0; mt < 8; ++mt) { float* sp = NGP + ((size_t)(b * 4 + h) * 128 + 16 * mt + 4 * q) * 128 + 16 * sl + c; sp[0] = S[mt].x; sp[128] = S[mt].y; sp[256] = S[mt].z; sp[384] = S[mt].w; }
        asm volatile("s_waitcnt vmcnt(0)" ::: "memory");
    }
}

__device__ __forceinline__ void gdn_gate(const Params& P, int lane, int wave, int bid, int G) {
    unsigned char* ws = P.ws; const bf16* PROJ = (const bf16*)(ws + WS_PROJ); bf16* MIX = (bf16*)(ws + WS_MIX); const bf16* O = (const bf16*)(ws + WS_O); const float* gnorm = P.in[11];
    float gn[8];
#pragma unroll
    for (int e = 0; e < 8; ++e) gn[e] = gnorm[8 * (lane & 15) + e];
    for (int row0 = bid * 8 + wave; row0 < MPR; row0 += G * 32) {
        f32x4 a[4], b[4]; u32x4 zr[4];
#pragma unroll
        for (int u = 0; u < 4; ++u) { const int row = min(row0 + u * G * 8, MPR - 1); const u32x4 orw = *(const u32x4*)(O + (size_t)row * 512 + 8 * lane);
            a[u] = (f32x4){bflo(orw.x), bfhi(orw.x), bflo(orw.y), bfhi(orw.y)}; b[u] = (f32x4){bflo(orw.z), bfhi(orw.z), bflo(orw.w), bfhi(orw.w)};
            zr[u] = *(const u32x4*)(PROJ + (size_t)row * NIN + 1536 + 8 * lane); }
#pragma unroll
        for (int u = 0; u < 4; ++u) { const int row = row0 + u * G * 8;
            float s = dot4(a[u]) + dot4(b[u]); s += dpp_get<0xB1, 0xF>(s); s += dpp_get<0x4E, 0xF>(s); s += dpp_get<0x141, 0xF>(s); s += dpp_get<0x140, 0xF>(s);
            const float rs = rsqrtf(s * (1.f / 128.f) + EPS);
            u32x4 o; o.x = pk2(a[u].x * rs * gn[0] * siluf_(bflo(zr[u].x)), a[u].y * rs * gn[1] * siluf_(bfhi(zr[u].x))); o.y = pk2(a[u].z * rs * gn[2] * siluf_(bflo(zr[u].y)), a[u].w * rs * gn[3] * siluf_(bfhi(zr[u].y)));
            o.z = pk2(b[u].x * rs * gn[4] * siluf_(bflo(zr[u].z)), b[u].y * rs * gn[5] * siluf_(bfhi(zr[u].z))); o.w = pk2(b[u].z * rs * gn[6] * siluf_(bflo(zr[u].w)), b[u].w * rs * gn[7] * siluf_(bfhi(zr[u].w)));
            if (row < MPR) *(u32x4*)(MIX + (size_t)row * DM + 8 * lane) = o; }
    }
}
__device__ __forceinline__ void final_norm(const Params& P, int lane, int wave, int bid, int G) {
    const float* SS3 = (const float*)(P.ws + WS_SS3); const float* gf = P.in[23]; float* out = P.out; const bf16* X3 = (const bf16*)(P.ws + WS_HID);
    f32x4 g4[4];
#pragma unroll
    for (int j = 0; j < 2; ++j) { g4[2 * j] = *(const f32x4*)(gf + 512 * j + 8 * lane); g4[2 * j + 1] = *(const f32x4*)(gf + 512 * j + 8 * lane + 4); }
    for (int row0 = MPR + bid * 8 + wave; row0 < MT; row0 += G * 32) {
        u32x4 v[4][2]; float rs[4];
#pragma unroll
        for (int u = 0; u < 4; ++u) { const int row = min(row0 + u * G * 8, MT - 1); rs[u] = sum16(SS3 + (size_t)row * 16);
#pragma unroll
            for (int j = 0; j < 2; ++j) v[u][j] = *(const u32x4*)(X3 + (size_t)row * DM + 512 * j + 8 * lane); }
#pragma unroll
        for (int u = 0; u < 4; ++u) { const int row = row0 + u * G * 8; const float r = rsqrtf(rs[u] * (1.f / DM) + EPS);
            if (row < MT) {
#pragma unroll
                for (int j = 0; j < 2; ++j) { const u32x4 w = v[u][j]; float* o = out + (size_t)row * DM + 512 * j + 8 * lane;
                    *(f32x4*)o = (f32x4){bflo(w.x), bfhi(w.x), bflo(w.y), bfhi(w.y)} * r * g4[2 * j];
                    *(f32x4*)(o + 4) = (f32x4){bflo(w.z), bfhi(w.z), bflo(w.w), bfhi(w.w)} * r * g4[2 * j + 1]; } } }
    }
}
#define XB_TMO      128
#define XB_XCNT(j)  (256  + 64 * (j))
#define XB_XSUB(j)  (1280 + 64 * (j))
#define XB_XGEN(j)  (2304 + 64 * (j))
#define XB_TOP      3328
#define XB_TOPGEN   3392
#define XCD_BAR_WORDS 3456
#define XB_SPIN_CAP (1u << 18)

__device__ __forceinline__ unsigned xb_ld(unsigned* p)              { return __hip_atomic_load(p, __ATOMIC_RELAXED, __HIP_MEMORY_SCOPE_AGENT); }
__device__ __forceinline__ unsigned xb_add(unsigned* p, unsigned v) { return __hip_atomic_fetch_add(p, v, __ATOMIC_RELAXED, __HIP_MEMORY_SCOPE_AGENT); }
__device__ __forceinline__ unsigned xb_xcc_id() { return (unsigned)__builtin_amdgcn_s_getreg((3 << 11) | 20) & 0xFu; }
#define XB_SPIN(cond, bar) do { unsigned _sp = 0; while (cond) { __builtin_amdgcn_s_sleep(1); \
    if ((++_sp & 255u) == 0u) { if (xb_ld(&(bar)[XB_TMO])) break; if (_sp > XB_SPIN_CAP) { atomicAdd(&(bar)[XB_TMO], 1u); break; } } } } while (0)

struct XcdBarrier {
    unsigned* bar; unsigned x;
    volatile LAS unsigned* st;
};

__device__ __forceinline__ XcdBarrier xcd_barrier_post(unsigned* bar, volatile LAS unsigned* st) {
    XcdBarrier b; b.bar = bar; b.x = xb_xcc_id(); b.st = st;
    if (threadIdx.x == 0) (void)xb_add(&bar[XB_XCNT(b.x)], 1u);
    return b;
}
__device__ __forceinline__ void xcd_barrier_complete(unsigned* bar, unsigned x, unsigned& nloc, unsigned& nx) {
    const unsigned G = gridDim.x * gridDim.y * gridDim.z;
    unsigned sum, cnt, mine, sp = 0u;
    for (;;) {
        sum = 0u; cnt = 0u; mine = 0u;
#pragma unroll
        for (unsigned j = 0; j < 16; ++j) { const unsigned c = xb_ld(&bar[XB_XCNT(j)]); sum += c; cnt += (c > 0u) ? 1u : 0u; mine = (j == x) ? c : mine; }
        if (sum == G) break;
        __builtin_amdgcn_s_sleep(1);
        if ((++sp & 255u) == 0u) { if (xb_ld(&bar[XB_TMO])) break; if (sp > XB_SPIN_CAP) { atomicAdd(&bar[XB_TMO], 1u); break; } }
    }
    nloc = mine > 0u ? mine : 1u; nx = cnt > 0u ? cnt : 1u;
}

__device__ __forceinline__ void xcd_barrier(const XcdBarrier& b) {
    asm volatile("s_waitcnt vmcnt(0)" ::: "memory");
    __syncthreads();
    if (threadIdx.x == 0) {
        unsigned* bar = b.bar;
        __builtin_amdgcn_s_waitcnt(0);
        unsigned nloc = b.st[0], nx = b.st[1];
        if (nloc == 0u) { xcd_barrier_complete(bar, b.x, nloc, nx); b.st[0] = nloc; b.st[1] = nx; }
        const unsigned old = xb_add(&bar[XB_XSUB(b.x)], 1u);
        const unsigned gen = old / nloc;
        if (old + 1u == (gen + 1u) * nloc) {
            __builtin_amdgcn_fence(__ATOMIC_RELEASE, "agent");
            asm volatile("s_waitcnt vmcnt(0)" ::: "memory");
            const unsigned og = xb_add(&bar[XB_TOP], 1u);
            const unsigned tg = og / nx;
            if (og + 1u == (tg + 1u) * nx) xb_add(&bar[XB_TOPGEN], 1u);
            else XB_SPIN(xb_ld(&bar[XB_TOPGEN]) == tg, bar);
            __builtin_amdgcn_fence(__ATOMIC_ACQUIRE, "agent");
            xb_add(&bar[XB_XGEN(b.x)], 1u);
            asm volatile("s_waitcnt vmcnt(0)" ::: "memory");
        } else {
            XB_SPIN(xb_ld(&bar[XB_XGEN(b.x)]) == gen, bar);
            __builtin_amdgcn_fence(__ATOMIC_ACQUIRE, "agent");
            asm volatile("s_waitcnt vmcnt(0)" ::: "memory");
        }
    }
    __syncthreads();
}

__global__ void __launch_bounds__(512, 2) mega_fwd(Params P) {
    extern __shared__ __attribute__((aligned(16))) unsigned char lds_raw[];
    LAS unsigned char* lds = (LAS unsigned char*)lds_raw;
    const int bid = blockIdx.x, G = gridDim.x;
#define FRESH() int tid = threadIdx.x; asm volatile("" : "+v"(tid)); const int lane = tid & 63, wave = __builtin_amdgcn_readfirstlane(tid >> 6), gw = bid * 8 + wave, NGW = G * 8; (void)gw; (void)NGW; (void)lane

    volatile LAS unsigned* st = (volatile LAS unsigned*)(lds + LDS_BYTES - 64);
    if (threadIdx.x < 16) st[threadIdx.x] = 0u;
    __syncthreads();
    unsigned char* ws = P.ws;
    XcdBarrier bar = xcd_barrier_post((unsigned*)(ws + WS_CTL), st);
#define GRID_BAR() xcd_barrier(bar)
    bf16* XB = (bf16*)(ws + WS_XB); bf16* MIX = (bf16*)(ws + WS_MIX); bf16* PROJ = (bf16*)(ws + WS_PROJ); bf16* HID = (bf16*)(ws + WS_HID); bf16* PB = (bf16*)(ws + WS_PB);
    float* SS1 = (float*)(ws + WS_SS1); float* SS2 = (float*)(ws + WS_SS2); float* SS3 = (float*)(ws + WS_SS3);

    { FRESH(); phase0(P, lds, tid, lane, wave, bid, G); }
    GRID_BAR();
    {   FRESH();
        pg8::Gemm g{XB, (const bf16*)(ws + WS_WIN), MPR, NIN, DM}; pg8::StaticOrder S; S.init(MPR, NIN, G, bid);
        EpiGen<F1> E{F1{nullptr, (const float*)(ws + WS_RS0), PROJ}}; EpiGen8<F1> E8{E.f};
        pg8::gemm_phase<EpiGen8<F1>, pg8::StaticOrder, true, true>(lds, g, S, E8);
        small_gemm<2, 4>(XB + (size_t)MPR * DM, (const bf16*)(ws + WS_WIN), NIN, DM, E.f, lds, bid, G, wave, lane);
    }
    GRID_BAR();
    if ((bid & 3) == 1) { FRESH(); sample_gdn(P, lds, tid, lane, wave, bid, G); }
    if ((bid & 3) == 2) { FRESH(); sgu_prompt(P, lds, tid, lane, wave, bid, G); }
    { FRESH(); gdn_prep(P, lds, tid, lane, wave, bid, G); }
    if ((bid & 3) != 2) { FRESH(); sgu_prompt(P, lds, tid, lane, wave, bid, G); }
    if ((bid & 3) != 1) { FRESH(); sample_gdn(P, lds, tid, lane, wave, bid, G); }
    { FRESH(); phase2_misc(P, tid, lane, wave, bid, G); }
    GRID_BAR();
    { FRESH(); gdn_scan(P, lds, st + 4, lane, wave, bid, G);
      if (wave >= 3 && wave <= 5) weight_items(P, (LAS float*)(lds + 2 * ST_BYTES + (wave - 3) * 8448), lane, 1536, 6784, bid * 3 + (wave - 3), G * 3); }
    GRID_BAR();
    { FRESH(); gdn_gate(P, lane, wave, bid, G); }
    GRID_BAR();
    {   FRESH();
        pg8::Gemm g{MIX, (const bf16*)(ws + WS_WOUT), MPR, DM, DM}; pg8::StaticOrder S; S.init(MPR, DM, G, bid);
        EpiGen<F2> E{F2{SS1, XB}}; EpiGen8<F2> E8{E.f};
        pg8::gemm_phase<EpiGen8<F2>, pg8::StaticOrder, false, true>(lds, g, S, E8);
        small_gemm<2, 4>(MIX + (size_t)MPR * DM, (const bf16*)(ws + WS_WOUT), DM, DM, E.f, lds, bid, G, wave, lane);
    }
    GRID_BAR();
    {   FRESH();
        pg8::Gemm g{XB, (const bf16*)(ws + WS_WUP), MPR, FF, DM}; pg8::StaticOrder S; S.init(MPR, FF, G, bid);
        EpiGen<F3> E{F3{nullptr, SS1, HID}}; EpiGen8<F3> E8{E.f};
        pg8::gemm_phase<EpiGen8<F3>, pg8::StaticOrder, true, true>(lds, g, S, E8);
        small_gemm<2, 4>(XB + (size_t)MPR * DM, (const bf16*)(ws + WS_WUP), FF, DM, E.f, lds, bid, G, wave, lane);
    }
    GRID_BAR();
    {   FRESH();
        pg8::Gemm g{HID, (const bf16*)(ws + WS_WDN), MPR, DM, FF}; pg8::StaticOrder S; S.init(MPR, DM, G, bid);
        EpiGen<F4> E{F4{SS2, XB}}; EpiGen8<F4> E8{E.f};
        pg8::gemm_phase<EpiGen8<F4>, pg8::StaticOrder, false, true>(lds, g, S, E8);
        small_gemm<2, 4>(HID + (size_t)MPR * FF, (const bf16*)(ws + WS_WDN), DM, FF, E.f, lds, bid, G, wave, lane);
    }
    GRID_BAR();
    {   FRESH();
        bf16* PP = MIX;
        { pg8::Gemm g{PB, (const bf16*)(ws + WS_WPLE), MPR, DM, DPLE}; pg8::StaticOrder S; S.init(MPR, DM, G, bid);
          EpiGen<F5a> E{F5a{nullptr, PP}}; EpiGen8<F5a> E8{E.f};
          pg8::gemm_phase<EpiGen8<F5a>, pg8::StaticOrder, false, true>(lds, g, S, E8);
          small_gemm<2, 4>(PB + (size_t)MPR * DPLE, (const bf16*)(ws + WS_WPLE), DM, DPLE, E.f, lds, bid, G, wave, lane); }
        { pg8::Gemm g{XB, (const bf16*)(ws + WS_WG), MPR, DM, DM}; pg8::StaticOrder S; S.init(MPR, DM, G, bid);
          EpiGen<F5b> E{F5b{SS3, SS2, XB, PP, HID}};
          EpiFinal EF{SS2, XB, PP, P.out, P.in[23], (unsigned*)(ws + WS_XBUF), (unsigned*)(ws + WS_CTL + 16384)};
          pg8::gemm_phase<EpiFinal, pg8::StaticOrder, false, true>(lds, g, S, EF);
          small_gemm<2, 4>(XB + (size_t)MPR * DM, (const bf16*)(ws + WS_WG), DM, DM, E.f, lds, bid, G, wave, lane); }
    }
    GRID_BAR();
    { FRESH(); final_norm(P, lane, wave, bid, G); }
}

extern "C" void kernel_launch(void* const* d_in, const int* in_sizes, int n_in, void* d_out, int out_size, void* d_ws, size_t ws_size, hipStream_t stream) {
    static int grid = 0;
    if (grid == 0) {
        int dev = 0, cus = 0;
        if (hipGetDevice(&dev) != hipSuccess || hipDeviceGetAttribute(&cus, hipDeviceAttributeMultiprocessorCount, dev) != hipSuccess) { fprintf(stderr, "kernel_launch: device query failed\n"); grid = -1; return; }
        if (hipFuncSetAttribute((const void*)mega_fwd, hipFuncAttributeMaxDynamicSharedMemorySize, LDS_BYTES) != hipSuccess) { fprintf(stderr, "kernel_launch: hipFuncSetAttribute failed\n"); grid = -1; return; }
        int per_cu = 0;
        if (hipOccupancyMaxActiveBlocksPerMultiprocessor(&per_cu, (const void*)mega_fwd, 512, LDS_BYTES) != hipSuccess || per_cu < 1) fprintf(stderr, "kernel_launch: occupancy query reports %d\n", per_cu);
        (void)hipGetLastError();
        grid = cus < 256 ? cus : 256;
        if (n_in != 24 || ws_size < 256 * MiB) fprintf(stderr, "kernel_launch: unexpected n_in %d / ws %zu\n", n_in, ws_size);
    }
    if (grid < 0) return;
    (void)hipMemsetAsync((char*)d_ws + WS_CTL, 0, CTL_BYTES, stream);
    Params p{};
    for (int i = 0; i < 24; ++i) p.in[i] = (const float*)d_in[i];
    p.out = (float*)d_out; p.ws = (unsigned char*)d_ws;
    hipLaunchKernelGGL(mega_fwd, dim3(grid), dim3(512), LDS_BYTES, stream, p);
}
```

```cpp
#include <hip/hip_runtime.h>
#include <cstdio>
#include <cstdint>
namespace pg8 {
#define PG8_LAS __attribute__((address_space(3)))
typedef unsigned short bf16_t;
typedef short bf16x8 __attribute__((ext_vector_type(8)));
typedef float f32x4 __attribute__((ext_vector_type(4)));
typedef unsigned u32x4 __attribute__((ext_vector_type(4)));
constexpr int BM = 256, BK = 64, HALF = 128, HTB = HALF * BK * 2  , STAGE_BYTES = 8 * HTB, NXCD = 8, WGM = 8;

__host__ __device__ __forceinline__ int lds_byte(int r, int c) { const int st = (r >> 4) * 2 + (c >> 5), rr = r & 15, cc = c & 31, ob = rr * 64 + cc * 2; return st * 1024 + (ob ^ (((ob >> 9) & 1) << 5)); }
__host__ __device__ __forceinline__ void stage_rc(int b, int& R, int& C) { const int st = b / 1024, sb = b % 1024, swz = sb ^ (((sb >> 9) & 1) << 5); R = (st >> 1) * 16 + swz / 64; C = (st & 1) * 32 + (swz % 64) / 2; }
__host__ __device__ __forceinline__ int perm32(int rho) { const int n = rho >> 4, i = rho & 15; return 8 * (i >> 2) + 4 * n + (i & 3); }

struct Unit { int pm, pn; };
struct Gemm { const bf16_t* A; const bf16_t* Bt; int M, N, K; };

struct StaticOrder {
    int nM, nN, nwg, G, c;
    __host__ __device__ void init(int M, int N, int G_, int c_) { nM = M / BM; nN = N / BM; nwg = nM * nN; G = G_; c = c_; }
    __host__ __device__ bool next(int i, Unit& u) const {
        const long L = (long)i * G + c; if (L >= nwg) return false;
        int wgid = (int)L; { const int q = nwg / NXCD, r = nwg % NXCD, xcd = wgid % NXCD, off = wgid / NXCD; wgid = (xcd < r ? xcd * (q + 1) : r * (q + 1) + (xcd - r) * q) + off; }
        const int nig = WGM * nN, gid = wgid / nig, fm = gid * WGM, gsz = (nM - fm) < WGM ? (nM - fm) : WGM;
        u.pm = fm + ((wgid % nig) % gsz); u.pn = (wgid % nig) / gsz; return true;
    }
    __device__ __forceinline__ void a_ready(const Unit&) const {}
    __device__ __forceinline__ void done(const Unit&) const {}
};

__device__ __forceinline__ unsigned cvt_pk_bf16(float lo, float hi) { unsigned r; asm volatile("v_cvt_pk_bf16_f32 %0, %1, %2" : "=v"(r) : "v"(lo), "v"(hi)); return r; }
template <class Epi, class Sched, bool ALIGN_EPI = false, bool SP2 = false>
__device__ __forceinline__ void gemm_phase(PG8_LAS unsigned char* lds, const Gemm g, const Sched& S, const Epi& E) {
    int tid_ = threadIdx.x; asm volatile("" : "+v"(tid_));
    const int tid = tid_, wid = __builtin_amdgcn_readfirstlane(tid >> 6), lane = tid & 63, wr = wid >> 2, wc = wid & 3, fr = lane & 15, fq = lane >> 4;
    const int K = g.K, nt = K / BK;
    unsigned voffA[2], voffB[2];
#pragma unroll
    for (int i = 0; i < 2; ++i) { int R, C; stage_rc(tid * 16 + i * 8192, R, C); const int Rb = Epi::PERM ? ((R & ~31) + perm32(R & 31)) : R;
        voffA[i] = (unsigned)(R * K + C) * 2u; voffB[i] = (unsigned)(Rb * K + C) * 2u; }
    const size_t kstep = (size_t)(BK * 2);
    const size_t hstep = (size_t)HALF * K * 2;
    const size_t tstep = 2 * hstep;
    const unsigned ldsw = (unsigned)wid * 1024u;
    const int aoff = lds_byte(wr * 64 + fr, fq * 8), boff = lds_byte(wc * 32 + fr, fq * 8);
#define PG8_SA(b, h) (((b) * 2 + (h)) * HTB)
#define PG8_SB(b, h) ((4 + (b) * 2 + (h)) * HTB)
#define PG8_STAGE(bufoff, gbase, voff) do { _Pragma("unroll") for (int _i = 0; _i < 2; ++_i) \
        __builtin_amdgcn_global_load_lds((const unsigned*)((const char*)(gbase) + (voff)[_i]), (PG8_LAS unsigned*)(lds + (bufoff) + ldsw + _i * 8192), 16, 0, 0); } while (0)
#define PG8_LDA(dst, b, h) do { _Pragma("unroll") for (int m = 0; m < 4; ++m) _Pragma("unroll") for (int k = 0; k < 2; ++k) dst[m][k] = *(const PG8_LAS bf16x8*)(lds + PG8_SA(b, h) + aoff + m * 2048 + k * 1024); } while (0)
#define PG8_LDB(dst, b, h) do { _Pragma("unroll") for (int n = 0; n < 2; ++n) _Pragma("unroll") for (int k = 0; k < 2; ++k) dst[n][k] = *(const PG8_LAS bf16x8*)(lds + PG8_SB(b, h) + boff + n * 2048 + k * 1024); } while (0)
#define PG8_MMA(ai, bj, At, Bt) do { __builtin_amdgcn_s_setprio(1); _Pragma("unroll") for (int m = 0; m < 4; ++m) _Pragma("unroll") for (int n = 0; n < 2; ++n) _Pragma("unroll") for (int k = 0; k < 2; ++k) \
        acc[ai][bj][m][n] = __builtin_amdgcn_mfma_f32_16x16x32_bf16(Bt[n][k], At[m][k], acc[ai][bj][m][n], 0, 0, 0); __builtin_amdgcn_s_setprio(0); } while (0)
#define PG8_WAIT_V(n) asm volatile("s_waitcnt vmcnt(" #n ")" ::: "memory")
#define PG8_WAIT_L(n) asm volatile("s_waitcnt lgkmcnt(" #n ")" ::: "memory")
#define PG8_BAR __builtin_amdgcn_s_barrier()
#define PG8_SCHED __builtin_amdgcn_sched_barrier(0)
    Unit cur, nxt; int ui = 0;
    if (!S.next(0, cur)) return;
    f32x4 acc[2][2][4][2];
#pragma unroll
    for (int a = 0; a < 2; ++a)
#pragma unroll
        for (int b = 0; b < 2; ++b)
#pragma unroll
            for (int m = 0; m < 4; ++m)
#pragma unroll
                for (int n = 0; n < 2; ++n) acc[a][b][m][n] = (f32x4){0.f, 0.f, 0.f, 0.f};
    bf16x8 At[4][2], B0[2][2], B1[2][2];
    const char* cA = (const char*)g.A + (size_t)cur.pm * tstep; const char* cB = (const char*)g.Bt + (size_t)cur.pn * tstep;
    S.a_ready(cur);
    if constexpr (SP2) {
        PG8_STAGE(PG8_SB(0, 0), cB, voffB); PG8_STAGE(PG8_SB(0, 1), cB + hstep, voffB); PG8_STAGE(PG8_SA(0, 0), cA, voffA); PG8_STAGE(PG8_SA(0, 1), cA + hstep, voffA);
        if (wr == 1) PG8_BAR;
        PG8_WAIT_V(2); PG8_BAR;
        PG8_STAGE(PG8_SB(1, 0), cB + kstep, voffB); PG8_STAGE(PG8_SA(1, 0), cA + kstep, voffA); PG8_STAGE(PG8_SB(1, 1), cB + hstep + kstep, voffB);
        PG8_WAIT_V(6); PG8_BAR;
    } else {
        PG8_STAGE(PG8_SB(0, 0), cB, voffB); PG8_STAGE(PG8_SA(0, 0), cA, voffA); PG8_STAGE(PG8_SB(0, 1), cB + hstep, voffB); PG8_STAGE(PG8_SA(0, 1), cA + hstep, voffA);
        if (wr == 1) PG8_BAR;
        PG8_WAIT_V(4); PG8_BAR;
        PG8_STAGE(PG8_SB(1, 0), cB + kstep, voffB); PG8_STAGE(PG8_SA(1, 0), cA + kstep, voffA); PG8_STAGE(PG8_SB(1, 1), cB + hstep + kstep, voffB);
        PG8_WAIT_V(6); PG8_BAR;
    }
    for (;;) {
        const bool has_next = S.next(ui + 1, nxt);
        const char* nA = has_next ? (const char*)g.A + (size_t)nxt.pm * tstep : cA; const char* nB = has_next ? (const char*)g.Bt + (size_t)nxt.pn * tstep : cB;
        for (int t = 0; t < nt; t += 2) {
            const bool last = (t == nt - 2);
            const char* a1 = cA + (size_t)(t + 1) * kstep;
            const char* a2 = last ? nA : cA + (size_t)(t + 2) * kstep; const char* b2 = last ? nB : cB + (size_t)(t + 2) * kstep;
            const char* a3 = a2 + kstep; const char* b3 = b2 + kstep;
            if (last && has_next) S.a_ready(nxt);
            if constexpr (SP2) {
            PG8_LDB(B0, 0, 0); PG8_LDB(B1, 0, 1); PG8_SCHED; PG8_LDA(At, 0, 0); PG8_STAGE(PG8_SA(1, 1), a1 + hstep, voffA);
            PG8_WAIT_V(8); PG8_WAIT_L(0); PG8_BAR; PG8_MMA(0, 0, At, B0); PG8_MMA(0, 1, At, B1); PG8_BAR; PG8_SCHED;
            PG8_LDA(At, 0, 1); PG8_STAGE(PG8_SB(0, 0), b2, voffB); PG8_STAGE(PG8_SB(0, 1), b2 + hstep, voffB); PG8_STAGE(PG8_SA(0, 0), a2, voffA);
            PG8_WAIT_V(8); PG8_WAIT_L(0); PG8_BAR; PG8_MMA(1, 0, At, B0); PG8_MMA(1, 1, At, B1); PG8_BAR; PG8_SCHED;
            PG8_LDB(B0, 1, 0); PG8_LDB(B1, 1, 1); PG8_SCHED; PG8_LDA(At, 1, 0); PG8_STAGE(PG8_SA(0, 1), a2 + hstep, voffA);
            PG8_WAIT_V(8); PG8_WAIT_L(0); PG8_BAR; PG8_MMA(0, 0, At, B0); PG8_MMA(0, 1, At, B1); PG8_BAR; PG8_SCHED;
            PG8_LDA(At, 1, 1); PG8_STAGE(PG8_SB(1, 0), b3, voffB); PG8_STAGE(PG8_SB(1, 1), b3 + hstep, voffB); PG8_STAGE(PG8_SA(1, 0), a3, voffA);
            PG8_WAIT_V(8); PG8_WAIT_L(0); PG8_BAR; PG8_MMA(1, 0, At, B0); PG8_MMA(1, 1, At, B1); PG8_BAR; PG8_SCHED;
            } else {
            PG8_LDB(B0, 0, 0); PG8_SCHED; PG8_LDA(At, 0, 0); PG8_STAGE(PG8_SA(1, 1), a1 + hstep, voffA);
            PG8_WAIT_L(8); PG8_BAR; PG8_WAIT_L(0); PG8_MMA(0, 0, At, B0); PG8_BAR; PG8_SCHED;
            PG8_LDB(B1, 0, 1); PG8_STAGE(PG8_SB(0, 0), b2, voffB);
            PG8_BAR; PG8_WAIT_L(0); PG8_MMA(0, 1, At, B1); PG8_BAR;
            PG8_LDA(At, 0, 1); PG8_STAGE(PG8_SA(0, 0), a2, voffA);
            PG8_BAR; PG8_WAIT_L(0); PG8_MMA(1, 0, At, B0); PG8_BAR; PG8_SCHED;
            PG8_STAGE(PG8_SB(0, 1), b2 + hstep, voffB);
            PG8_WAIT_V(6); PG8_BAR; PG8_MMA(1, 1, At, B1); PG8_BAR;
            PG8_LDB(B0, 1, 0); PG8_SCHED; PG8_LDA(At, 1, 0); PG8_STAGE(PG8_SA(0, 1), a2 + hstep, voffA);
            PG8_WAIT_L(8); PG8_BAR; PG8_WAIT_L(0); PG8_MMA(0, 0, At, B0); PG8_BAR; PG8_SCHED;
            PG8_LDB(B1, 1, 1); PG8_STAGE(PG8_SB(1, 0), b3, voffB);
            PG8_BAR; PG8_WAIT_L(0); PG8_MMA(0, 1, At, B1); PG8_BAR;
            PG8_LDA(At, 1, 1); PG8_STAGE(PG8_SA(1, 0), a3, voffA);
            PG8_BAR; PG8_WAIT_L(0); PG8_MMA(1, 0, At, B0); PG8_BAR; PG8_SCHED;
            PG8_STAGE(PG8_SB(1, 1), b3 + hstep, voffB);
            PG8_WAIT_V(6); PG8_BAR; PG8_MMA(1, 1, At, B1); PG8_BAR;
            }
        }
        if constexpr (ALIGN_EPI) { if (wr == 0) PG8_BAR; }
        if constexpr (!Epi::AFTER_DRAIN) { E(acc, cur, wr, wc, fr, fq); S.done(cur); }
        if (!has_next) break;
#pragma unroll
        for (int a = 0; a < 2; ++a)
#pragma unroll
            for (int b = 0; b < 2; ++b)
#pragma unroll
                for (int m = 0; m < 4; ++m)
#pragma unroll
                    for (int n = 0; n < 2; ++n) acc[a][b][m][n] = (f32x4){0.f, 0.f, 0.f, 0.f};
        cur = nxt; cA = nA; cB = nB; ++ui;
        if constexpr (ALIGN_EPI) { if (wr == 1) PG8_BAR; }
    }
    PG8_WAIT_V(0);
    if constexpr (!ALIGN_EPI) { if (wr == 0) PG8_BAR; }
    PG8_BAR;
    if constexpr (Epi::AFTER_DRAIN) { E.fused(acc, cur, wr, wc, fr, fq, lds, wid, lane); S.done(cur); }
#undef PG8_SA
#undef PG8_SB
#undef PG8_STAGE
#undef PG8_LDA
#undef PG8_LDB
#undef PG8_MMA
#undef PG8_WAIT_V
#undef PG8_WAIT_L
#undef PG8_BAR
#undef PG8_SCHED
}
}

#define LAS __attribute__((address_space(3)))
typedef unsigned short bf16;
typedef float f32x4 __attribute__((ext_vector_type(4)));
typedef short bf16x8 __attribute__((ext_vector_type(8)));
typedef unsigned u32x4 __attribute__((ext_vector_type(4)));
typedef unsigned u32x2 __attribute__((ext_vector_type(2)));
#define LDS_WAIT() asm volatile("s_waitcnt lgkmcnt(0)" ::: "memory")
#define VM_WAIT() asm volatile("s_waitcnt vmcnt(0)" ::: "memory")

constexpr int MPR = 16384, MSA = 128, MT = MPR + MSA, DM = 1024, NIN = 3072, FF = 4096, DPLE = 256, SRCN = 3080;
constexpr float EPS = 1e-6f, QSCALE = 0.08838834764831845f;
constexpr int LDS_BYTES = 147456;
constexpr size_t MiB = 1u << 20;
constexpr size_t WS_RS0 = 0, WS_BETA = 128 * 1024, WS_G = 448 * 1024, WS_WSB = 1 * MiB, WS_SS1 = 2 * MiB, WS_SS2 = 3 * MiB + 256 * 1024, WS_SS3 = 4 * MiB + 512 * 1024;
constexpr size_t WS_WIN = 6 * MiB, WS_WOUT = 12 * MiB, WS_WUP = 14 * MiB, WS_WDN = 22 * MiB, WS_WG = 30 * MiB, WS_WPLE = 32 * MiB;
constexpr size_t WS_PB = 33 * MiB, WS_XB = 42 * MiB, WS_MIX = 75 * MiB, WS_PROJ = 108 * MiB, WS_HID = 108 * MiB, WS_AT = 205 * MiB, WS_O = 213 * MiB, WS_DECF = 246 * MiB, WS_XBUF = 247 * MiB, WS_CTL = 255 * MiB;
constexpr size_t CTL_BYTES = 32768;
constexpr size_t O_Y = 0, O_NCP = 16908288, O_NGP = 16945152, O_NCS = 17469440, O_NGS = 18059264, O_NSV = 26447872;
constexpr size_t FR_W = 0, FR_QG = 8 * MiB, FR_KG = 16 * MiB, FR_U = 24 * MiB;

__device__ __forceinline__ unsigned f2bf(float f) { unsigned u = __builtin_bit_cast(unsigned, f); return (u + 0x7fffu + ((u >> 16) & 1u)) >> 16; }
typedef float f32x2_t_ __attribute__((ext_vector_type(2))); typedef __bf16 bf16x2_t_ __attribute__((ext_vector_type(2)));
__device__ __forceinline__ unsigned pk2(float lo, float hi) { const f32x2_t_ v = {lo, hi}; const bf16x2_t_ b = __builtin_convertvector(v, bf16x2_t_); return __builtin_bit_cast(unsigned, b); }
__device__ __forceinline__ float bflo(unsigned u) { return __builtin_bit_cast(float, u << 16); }
__device__ __forceinline__ float bfhi(unsigned u) { return __builtin_bit_cast(float, u & 0xffff0000u); }
__device__ __forceinline__ float bf2f(bf16 v) { return __builtin_bit_cast(float, (unsigned)v << 16); }
__device__ __forceinline__ float sigmoidf_(float x) { return __builtin_amdgcn_rcpf(1.f + __expf(-x)); }
__device__ __forceinline__ float siluf_(float x) { return x * __builtin_amdgcn_rcpf(1.f + __expf(-x)); }
__device__ __forceinline__ float geluf_(float x) { const float u = 1.5957691216057308f * (x + 0.044715f * x * x * x); return x * __builtin_amdgcn_rcpf(1.f + __expf(-u)); }
template <int CTRL, int ROWMASK> __device__ __forceinline__ float dpp_get(float v) { return __builtin_bit_cast(float, __builtin_amdgcn_update_dpp(0, __builtin_bit_cast(int, v), CTRL, ROWMASK, 0xF, false)); }
__device__ __forceinline__ float wave_sum(float v) {
    v += dpp_get<0xB1, 0xF>(v); v += dpp_get<0x4E, 0xF>(v); v += dpp_get<0x141, 0xF>(v); v += dpp_get<0x140, 0xF>(v);
    v += dpp_get<0x142, 0xA>(v); v += dpp_get<0x143, 0xC>(v);
    return __builtin_bit_cast(float, __builtin_amdgcn_readlane(__builtin_bit_cast(int, v), 63));
}
__device__ __forceinline__ f32x4 mfma16(bf16x8 a, bf16x8 b, f32x4 c) { return __builtin_amdgcn_mfma_f32_16x16x32_bf16(a, b, c, 0, 0, 0); }
__device__ __forceinline__ bf16x8 pack8(f32x4 a, f32x4 b) { u32x4 w; w.x = pk2(a.x, a.y); w.y = pk2(a.z, a.w); w.z = pk2(b.x, b.y); w.w = pk2(b.z, b.w); return __builtin_bit_cast(bf16x8, w); }

struct Params { const float* in[24]; float* out; unsigned char* ws; };

template <class F> struct EpiGen {
    static constexpr bool PERM = false, AFTER_DRAIN = false;
    F f;
    __device__ __forceinline__ void operator()(const pg8::f32x4 (&acc)[2][2][4][2], const pg8::Unit& u, int wr, int wc, int fr, int fq) const {
#pragma unroll
        for (int ai = 0; ai < 2; ++ai)
#pragma unroll
            for (int m = 0; m < 4; ++m) {
                const int row = u.pm * 256 + ai * 128 + wr * 64 + m * 16 + fr;
                const float ctx = f.rowctx(row); float ss = 0.f;
#pragma unroll
                for (int bj = 0; bj < 2; ++bj)
#pragma unroll
                    for (int n = 0; n < 2; ++n) ss += f(row, u.pn * 256 + bj * 128 + wc * 32 + n * 16 + 4 * fq, acc[ai][bj][m][n], ctx);
                if (F::STATS) { ss += __shfl_xor(ss, 16); ss += __shfl_xor(ss, 32); if (fq == 0) f.ss[(size_t)row * 16 + u.pn * 4 + wc] = ss; }
            }
    }
};
template <class F> struct EpiGen8 {
    static constexpr bool PERM = true, AFTER_DRAIN = false;
    F f;
    __device__ __forceinline__ void operator()(const pg8::f32x4 (&acc)[2][2][4][2], const pg8::Unit& u, int wr, int wc, int fr, int fq) const {
#pragma unroll
        for (int ai = 0; ai < 2; ++ai)
#pragma unroll
            for (int m = 0; m < 4; ++m) {
                const int row = u.pm * 256 + ai * 128 + wr * 64 + m * 16 + fr; const float ctx = f.rowctx(row); float ss = 0.f;
#pragma unroll
                for (int bj = 0; bj < 2; ++bj) ss += f.op8(row, u.pn * 256 + bj * 128 + wc * 32 + 8 * fq, acc[ai][bj][m][0], acc[ai][bj][m][1], ctx);
                if (F::STATS) { ss += __shfl_xor(ss, 16); ss += __shfl_xor(ss, 32); if (fq == 0) f.ss[(size_t)row * 16 + u.pn * 4 + wc] = ss; }
            }
    }
};
__device__ __forceinline__ float sum16(const float* p) { const f32x4 a = *(const f32x4*)p, b = *(const f32x4*)(p + 4), c = *(const f32x4*)(p + 8), d = *(const f32x4*)(p + 12);
    return ((a.x + a.y) + (a.z + a.w)) + ((b.x + b.y) + (b.z + b.w)) + ((c.x + c.y) + (c.z + c.w)) + ((d.x + d.y) + (d.z + d.w)); }
__device__ __forceinline__ void st_bf4(bf16* p, f32x4 v) { u32x2 w; w.x = pk2(v.x, v.y); w.y = pk2(v.z, v.w); *(u32x2*)p = w; }
__device__ __forceinline__ float dot4(f32x4 v) { return (v.x * v.x + v.y * v.y) + (v.z * v.z + v.w * v.w); }

struct F1 { static constexpr bool STATS = false; float* ss; const float* rs0; bf16* proj;
    __device__ __forceinline__ float rowctx(int row) const { return rs0[row]; }
    __device__ __forceinline__ float operator()(int row, int col, f32x4 a, float rs) const { f32x4 v = a * rs;
        if (col >= 2048) { v.x = geluf_(v.x); v.y = geluf_(v.y); v.z = geluf_(v.z); v.w = geluf_(v.w); }
        st_bf4(proj + (size_t)row * NIN + col, v); return 0.f; }
    __device__ __forceinline__ float op8(int row, int col, f32x4 a0, f32x4 a1, float rs) const { f32x4 v0 = a0 * rs, v1 = a1 * rs;
        if (col >= 2048) { v0.x = geluf_(v0.x); v0.y = geluf_(v0.y); v0.z = geluf_(v0.z); v0.w = geluf_(v0.w); v1.x = geluf_(v1.x); v1.y = geluf_(v1.y); v1.z = geluf_(v1.z); v1.w = geluf_(v1.w); }
        u32x4 w; w.x = pk2(v0.x, v0.y); w.y = pk2(v0.z, v0.w); w.z = pk2(v1.x, v1.y); w.w = pk2(v1.z, v1.w); *(u32x4*)(proj + (size_t)row * NIN + col) = w; return 0.f; } };
struct F2 { static constexpr bool STATS = true; float* ss; bf16* xb;
    __device__ __forceinline__ float rowctx(int) const { return 0.f; }
    __device__ __forceinline__ float operator()(int row, int col, f32x4 a, float) const { bf16* p = xb + (size_t)row * DM + col; const u32x2 r = *(const u32x2*)p;
        const f32x4 x = (f32x4){bflo(r.x) + a.x, bfhi(r.x) + a.y, bflo(r.y) + a.z, bfhi(r.y) + a.w}; st_bf4(p, x); return dot4(x); }
    __device__ __forceinline__ float op8(int row, int col, f32x4 a0, f32x4 a1, float) const { bf16* p = xb + (size_t)row * DM + col; const u32x4 r = *(const u32x4*)p;
        const f32x4 x0 = (f32x4){bflo(r.x) + a0.x, bfhi(r.x) + a0.y, bflo(r.y) + a0.z, bfhi(r.y) + a0.w}, x1 = (f32x4){bflo(r.z) + a1.x, bfhi(r.z) + a1.y, bflo(r.w) + a1.z, bfhi(r.w) + a1.w};
        u32x4 w; w.x = pk2(x0.x, x0.y); w.y = pk2(x0.z, x0.w); w.z = pk2(x1.x, x1.y); w.w = pk2(x1.z, x1.w); *(u32x4*)p = w; return dot4(x0) + dot4(x1); } };
struct F3 { static constexpr bool STATS = false; float* ss; const float* ss1; bf16* hid;
    __device__ __forceinline__ float rowctx(int row) const { return rsqrtf(sum16(ss1 + (size_t)row * 16) * (1.f / DM) + EPS); }
    __device__ __forceinline__ float operator()(int row, int col, f32x4 a, float rs) const { f32x4 v = a * rs; v.x = fmaxf(v.x, 0.f); v.y = fmaxf(v.y, 0.f); v.z = fmaxf(v.z, 0.f); v.w = fmaxf(v.w, 0.f);
        st_bf4(hid + (size_t)row * FF + col, v * v); return 0.f; }
    __device__ __forceinline__ float op8(int row, int col, f32x4 a0, f32x4 a1, float rs) const { f32x4 v0 = a0 * rs, v1 = a1 * rs;
        v0.x = fmaxf(v0.x, 0.f); v0.y = fmaxf(v0.y, 0.f); v0.z = fmaxf(v0.z, 0.f); v0.w = fmaxf(v0.w, 0.f); v1.x = fmaxf(v1.x, 0.f); v1.y = fmaxf(v1.y, 0.f); v1.z = fmaxf(v1.z, 0.f); v1.w = fmaxf(v1.w, 0.f);
        v0 = v0 * v0; v1 = v1 * v1; u32x4 w; w.x = pk2(v0.x, v0.y); w.y = pk2(v0.z, v0.w); w.z = pk2(v1.x, v1.y); w.w = pk2(v1.z, v1.w); *(u32x4*)(hid + (size_t)row * FF + col) = w; return 0.f; } };
struct F4 { static constexpr bool STATS = true; float* ss; bf16* xb;
    __device__ __forceinline__ float rowctx(int) const { return 0.f; }
    __device__ __forceinline__ float operator()(int row, int col, f32x4 a, float) const { bf16* p = xb + (size_t)row * DM + col; const u32x2 r = *(const u32x2*)p;
        const f32x4 x = (f32x4){bflo(r.x) + a.x, bfhi(r.x) + a.y, bflo(r.y) + a.z, bfhi(r.y) + a.w}; st_bf4(p, x); return dot4(x); }
    __device__ __forceinline__ float op8(int row, int col, f32x4 a0, f32x4 a1, float) const { bf16* p = xb + (size_t)row * DM + col; const u32x4 r = *(const u32x4*)p;
        const f32x4 x0 = (f32x4){bflo(r.x) + a0.x, bfhi(r.x) + a0.y, bflo(r.y) + a0.z, bfhi(r.y) + a0.w}, x1 = (f32x4){bflo(r.z) + a1.x, bfhi(r.z) + a1.y, bflo(r.w) + a1.z, bfhi(r.w) + a1.w};
        u32x4 w; w.x = pk2(x0.x, x0.y); w.y = pk2(x0.z, x0.w); w.z = pk2(x1.x, x1.y); w.w = pk2(x1.z, x1.w); *(u32x4*)p = w; return dot4(x0) + dot4(x1); } };
struct F5a { static constexpr bool STATS = false; float* ss; bf16* pp;
    __device__ __forceinline__ float rowctx(int) const { return 0.f; }
    __device__ __forceinline__ float operator()(int row, int col, f32x4 a, float) const { st_bf4(pp + (size_t)row * DM + col, a); return 0.f; }
    __device__ __forceinline__ float op8(int row, int col, f32x4 a0, f32x4 a1, float) const { u32x4 w; w.x = pk2(a0.x, a0.y); w.y = pk2(a0.z, a0.w); w.z = pk2(a1.x, a1.y); w.w = pk2(a1.z, a1.w);
        *(u32x4*)(pp + (size_t)row * DM + col) = w; return 0.f; } };
struct F5b { static constexpr bool STATS = true; float* ss; const float* ss2; const bf16* xb; const bf16* pp; bf16* x3;
    __device__ __forceinline__ float rowctx(int row) const { return rsqrtf(sum16(ss2 + (size_t)row * 16) * (1.f / DM) + EPS); }
    __device__ __forceinline__ float operator()(int row, int col, f32x4 a, float rs) const { const size_t o = (size_t)row * DM + col; const u32x2 pr = *(const u32x2*)(pp + o), xr = *(const u32x2*)(xb + o);
        f32x4 x; x.x = bflo(xr.x) + bflo(pr.x) * sigmoidf_(a.x * rs); x.y = bfhi(xr.x) + bfhi(pr.x) * sigmoidf_(a.y * rs); x.z = bflo(xr.y) + bflo(pr.y) * sigmoidf_(a.z * rs); x.w = bfhi(xr.y) + bfhi(pr.y) * sigmoidf_(a.w * rs);
        st_bf4(x3 + o, x); return dot4(x); } };

struct EpiFinal {
    static constexpr bool PERM = true, AFTER_DRAIN = true;
    const float* ss2; const bf16* xb; const bf16* pp; float* out; const float* gfin; unsigned* xbuf; unsigned* cnt;
    __device__ __forceinline__ void fused(pg8::f32x4 (&acc)[2][2][4][2], const pg8::Unit& u, int wr, int wc, int fr, int fq, LAS unsigned char* lds, int wid, int lane) const {
        LAS float* Pt = (LAS float*)lds; LAS float* St = (LAS float*)(lds + 4096);
#pragma unroll
        for (int ai = 0; ai < 2; ++ai)
#pragma unroll
            for (int m = 0; m < 4; ++m) {
                const int row_l = ai * 128 + wr * 64 + m * 16 + fr; const size_t row = (size_t)u.pm * 256 + row_l;
                const float rs = rsqrtf(sum16(ss2 + row * 16) * (1.f / DM) + EPS); float ss = 0.f;
#pragma unroll
                for (int bj = 0; bj < 2; ++bj) { const size_t o = row * DM + u.pn * 256 + bj * 128 + wc * 32 + 8 * fq; const u32x4 pr = *(const u32x4*)(pp + o), xr = *(const u32x4*)(xb + o);
                    const f32x4 a0 = acc[ai][bj][m][0], a1 = acc[ai][bj][m][1]; f32x4 x0, x1;
                    x0.x = bflo(xr.x) + bflo(pr.x) * sigmoidf_(a0.x * rs); x0.y = bfhi(xr.x) + bfhi(pr.x) * sigmoidf_(a0.y * rs); x0.z = bflo(xr.y) + bflo(pr.y) * sigmoidf_(a0.z * rs); x0.w = bfhi(xr.y) + bfhi(pr.y) * sigmoidf_(a0.w * rs);
                    x1.x = bflo(xr.z) + bflo(pr.z) * sigmoidf_(a1.x * rs); x1.y = bfhi(xr.z) + bfhi(pr.z) * sigmoidf_(a1.y * rs); x1.z = bflo(xr.w) + bflo(pr.w) * sigmoidf_(a1.z * rs); x1.w = bfhi(xr.w) + bfhi(pr.w) * sigmoidf_(a1.w * rs);
                    acc[ai][bj][m][0] = x0; acc[ai][bj][m][1] = x1; ss += dot4(x0) + dot4(x1); }
                ss += __shfl_xor(ss, 16); ss += __shfl_xor(ss, 32);
                if (fq == 0) Pt[row_l * 4 + wc] = ss;
            }
        asm volatile("s_waitcnt lgkmcnt(0)" ::: "memory"); __builtin_amdgcn_s_barrier(); asm volatile("" ::: "memory");
        const int rl = wid * 32 + (lane & 31);
        if (lane < 32) { const f32x4 p4 = *(const LAS f32x4*)(Pt + rl * 4); const float tot = (p4.x + p4.y) + (p4.z + p4.w);
            __hip_atomic_store(xbuf + ((size_t)u.pm * 256 + rl) * 4 + u.pn, __builtin_bit_cast(unsigned, tot), __ATOMIC_RELAXED, __HIP_MEMORY_SCOPE_AGENT); }
        asm volatile("s_waitcnt vmcnt(0)" ::: "memory");
        if (lane == 0) __hip_atomic_fetch_add(cnt + 64 * u.pm, 1u, __ATOMIC_RELAXED, __HIP_MEMORY_SCOPE_AGENT);
        if (wid == 0) {
            unsigned sp = 0;
            while ((unsigned)__builtin_amdgcn_readfirstlane(__hip_atomic_load(cnt + 64 * u.pm, __ATOMIC_RELAXED, __HIP_MEMORY_SCOPE_AGENT)) < 32u) { __builtin_amdgcn_s_sleep(2); if (++sp > (1u << 22)) break; }
            __builtin_amdgcn_fence(__ATOMIC_ACQUIRE, "agent");
        }
        asm volatile("s_waitcnt vmcnt(0) lgkmcnt(0)" ::: "memory"); __builtin_amdgcn_s_barrier(); asm volatile("" ::: "memory");
        if (lane < 32) { float t = 0.f;
#pragma unroll
            for (int k = 0; k < 4; ++k) t += __builtin_bit_cast(float, __hip_atomic_load(xbuf + ((size_t)u.pm * 256 + rl) * 4 + k, __ATOMIC_RELAXED, __HIP_MEMORY_SCOPE_AGENT));
            St[rl] = rsqrtf(t * (1.f / DM) + EPS); }
        asm volatile("s_waitcnt lgkmcnt(0)" ::: "memory"); __builtin_amdgcn_s_barrier(); asm volatile("" ::: "memory");
#pragma unroll
        for (int ai = 0; ai < 2; ++ai)
#pragma unroll
            for (int m = 0; m < 4; ++m) {
                const int row_l = ai * 128 + wr * 64 + m * 16 + fr; const size_t row = (size_t)u.pm * 256 + row_l; const float r = St[row_l];
#pragma unroll
                for (int bj = 0; bj < 2; ++bj)
#pragma unroll
                    for (int n = 0; n < 2; ++n) { const int col = u.pn * 256 + bj * 128 + wc * 32 + 8 * fq + 4 * n;
                        *(f32x4*)(out + row * DM + col) = acc[ai][bj][m][n] * r * *(const f32x4*)(gfin + col); }
            }
    }
};

template <int RT, int UNR, class F> __device__ __forceinline__ void small_gemm(const bf16* A, const bf16* Bt, int N, int K, const F& f, LAS unsigned char* lds, int bid, int G, int wave, int lane) {
    const int c = lane & 15, q = lane >> 4; constexpr int NMH = 8 / RT; const int ntask = NMH * (N >> 6); const int kw = K >> 3;
    LAS f32x4* red = (LAS f32x4*)lds;
    for (int t = bid; t < ntask; t += G) {
        const int mh = t % NMH, ns = t / NMH;
        const bf16* ap = A + (size_t)(mh * RT * 16 + c) * K + wave * kw + 8 * q;
        const bf16* bp = Bt + (size_t)(ns * 64 + c) * K + wave * kw + 8 * q;
        f32x4 acc[RT][4];
#pragma unroll
        for (int i = 0; i < RT; ++i)
#pragma unroll
            for (int j = 0; j < 4; ++j) acc[i][j] = (f32x4){0.f, 0.f, 0.f, 0.f};
#pragma unroll UNR
        for (int k = 0; k < kw; k += 32) {
            bf16x8 a[RT], b[4];
#pragma unroll
            for (int i = 0; i < RT; ++i) a[i] = *(const bf16x8*)(ap + (size_t)i * 16 * K + k);
#pragma unroll
            for (int j = 0; j < 4; ++j) b[j] = *(const bf16x8*)(bp + (size_t)j * 16 * K + k);
#pragma unroll
            for (int i = 0; i < RT; ++i)
#pragma unroll
                for (int j = 0; j < 4; ++j) acc[i][j] = mfma16(b[j], a[i], acc[i][j]);
        }
#pragma unroll
        for (int i = 0; i < RT; ++i)
#pragma unroll
            for (int j = 0; j < 4; ++j) red[(wave * (RT * 4) + i * 4 + j) * 64 + lane] = acc[i][j];
        __syncthreads();
        if (wave < RT) {
            const int i = wave; const int row = MPR + mh * RT * 16 + i * 16 + c; const float ctx = f.rowctx(row); float ss = 0.f;
#pragma unroll
            for (int j = 0; j < 4; ++j) { f32x4 s = red[(i * 4 + j) * 64 + lane];
#pragma unroll
                for (int w = 1; w < 8; ++w) s += red[(w * (RT * 4) + i * 4 + j) * 64 + lane];
                ss += f(row, ns * 64 + j * 16 + 4 * q, s, ctx); }
            if (F::STATS) { ss += __shfl_xor(ss, 16); ss += __shfl_xor(ss, 32); if (q == 0) f.ss[(size_t)row * 16 + ns] = ss; }
        }
        __syncthreads();
    }
}

__device__ __forceinline__ void tr_item(const float* __restrict__ W, int N, int src_c0, bf16* WT, int K, int dst_r0, const float* __restrict__ gain, LAS float* scr, int k0, int lane) {
    const float gv = gain ? gain[k0 + lane] : 1.f;
    f32x4 wv[8];
#pragma unroll
    for (int i = 0; i < 8; ++i) wv[i] = *(const f32x4*)(W + (size_t)(k0 + 8 * i + (lane >> 3)) * N + src_c0 + 4 * (lane & 7));
#pragma unroll
    for (int i = 0; i < 8; ++i) {
        float g = 0.f;
#pragma unroll
        for (int r = 0; r < 8; ++r) { const float gr = __builtin_bit_cast(float, __builtin_amdgcn_readlane(__builtin_bit_cast(int, gv), 8 * i + r)); g = ((lane >> 3) == r) ? gr : g; }
        LAS float* d = scr + (8 * i + (lane >> 3)) * 33 + 4 * (lane & 7);
        d[0] = wv[i].x * g; d[1] = wv[i].y * g; d[2] = wv[i].z * g; d[3] = wv[i].w * g;
    }
    LDS_WAIT();
    const int c = lane & 7;
#pragma unroll
    for (int j = 0; j < 4; ++j) { const int n = (lane >> 3) + 8 * j; const LAS float* s = scr + (8 * c) * 33 + n;
        u32x4 o; o.x = pk2(s[0], s[33]); o.y = pk2(s[66], s[99]); o.z = pk2(s[132], s[165]); o.w = pk2(s[198], s[231]);
        *(u32x4*)(WT + (size_t)(dst_r0 + n) * K + k0 + 8 * c) = o; }
    LDS_WAIT();
}

__device__ __forceinline__ void weight_items(const Params& P, LAS float* scr, int lane, int first, int last, int start, int stride) {
    unsigned char* ws = P.ws; const float* w_in = P.in[7]; const float* g_mix = P.in[6];
    for (int it = first + start; it < last; it += stride) {
        int r = it;
        if (r < 1536) { const int nb = r >> 4, kb = r & 15; tr_item(w_in, SRCN, nb * 32 + (nb >= 64 ? 8 : 0), (bf16*)(ws + WS_WIN), 1024, nb * 32, g_mix, scr, kb * 64, lane); continue; } r -= 1536;
        if (r < 512) { const int nb = r >> 4, kb = r & 15; tr_item(P.in[16], 1024, nb * 32, (bf16*)(ws + WS_WOUT), 1024, nb * 32, nullptr, scr, kb * 64, lane); continue; } r -= 512;
        if (r < 2048) { const int nb = r >> 4, kb = r & 15; tr_item(P.in[18], 4096, nb * 32, (bf16*)(ws + WS_WUP), 1024, nb * 32, P.in[17], scr, kb * 64, lane); continue; } r -= 2048;
        if (r < 2048) { const int nb = r >> 6, kb = r & 63; tr_item(P.in[19], 1024, nb * 32, (bf16*)(ws + WS_WDN), 4096, nb * 32, nullptr, scr, kb * 64, lane); continue; } r -= 2048;
        if (r < 512) { const int nb = r >> 4, kb = r & 15; tr_item(P.in[22], 1024, nb * 32, (bf16*)(ws + WS_WG), 1024, nb * 32, P.in[20], scr, kb * 64, lane); continue; } r -= 512;
        { const int nb = r >> 2, kb = r & 3; tr_item(P.in[21], 1024, nb * 32, (bf16*)(ws + WS_WPLE), 256, nb * 32, nullptr, scr, kb * 64, lane); }
    }
}

__device__ __forceinline__ void phase0(const Params& P, LAS unsigned char* lds, int tid, int lane, int wave, int bid, int G) {
    unsigned char* ws = P.ws; const int gw = bid * 8 + wave, NGW = G * 8, gt = bid * 512 + tid, NGT = G * 512;
    const float* w_in = P.in[7]; const float* g_mix = P.in[6];
    LAS f32x4* W8 = (LAS f32x4*)(lds + 67584);
    for (int idx = tid; idx < 2048; idx += 512) {
        const int l = idx & 63, half = (idx >> 6) & 1, je = idx >> 7; const int k = 256 * (je >> 2) + 4 * l + (je & 3);
        const float g = g_mix[k]; const float* s = w_in + (size_t)k * SRCN + 2048 + 4 * half;
        W8[idx] = (f32x4){s[0] * g, s[1] * g, s[2] * g, s[3] * g};
    }
    { const float* w_s = P.in[14]; bf16* WSB = (bf16*)(ws + WS_WSB);
      for (int i = gt; i < 65536; i += NGT) { const int t = (i >> 7) & 127, s = i & 127; WSB[i] = (bf16)f2bf(s <= t ? w_s[i] : 0.f); } }
    { bf16* PB = (bf16*)(ws + WS_PB); const float* pp = P.in[4]; const float* ps = P.in[5];
      for (int i = gt; i < MT * 32; i += NGT) { const int row = i >> 5, c8 = i & 31; const float* src = row < MPR ? pp + (size_t)row * DPLE + c8 * 8 : ps + (size_t)(row - MPR) * DPLE + c8 * 8;
          const f32x4 a = *(const f32x4*)src, b = *(const f32x4*)(src + 4); u32x4 o; o.x = pk2(a.x, a.y); o.y = pk2(a.z, a.w); o.z = pk2(b.x, b.y); o.w = pk2(b.z, b.w); *(u32x4*)(PB + (size_t)i * 8) = o; } }
    weight_items(P, (LAS float*)(lds + wave * 8448), lane, 0, 1536, gw, NGW);
    __syncthreads();
    float* RS0 = (float*)(ws + WS_RS0); float* BETA = (float*)(ws + WS_BETA); float* GG = (float*)(ws + WS_G); bf16* XB = (bf16*)(ws + WS_XB);
    const float* a_log = P.in[9]; const float* dt_bias = P.in[10];
    f32x4 vnx[4];
    { const int row = gw < MT ? gw : MT - 1; const float* xr = row < MPR ? P.in[0] + (size_t)row * DM : P.in[1] + (size_t)(row - MPR) * DM;
#pragma unroll
      for (int j = 0; j < 4; ++j) vnx[j] = *(const f32x4*)(xr + 256 * j + 4 * lane); }
    for (int row = gw; row < MT; row += NGW) {
        f32x4 v[4]; float ss = 0.f;
#pragma unroll
        for (int j = 0; j < 4; ++j) { v[j] = vnx[j]; ss += dot4(v[j]); }
        { const int rn = (row + NGW < MT) ? row + NGW : row; const float* xr = rn < MPR ? P.in[0] + (size_t)rn * DM : P.in[1] + (size_t)(rn - MPR) * DM;
#pragma unroll
          for (int j = 0; j < 4; ++j) vnx[j] = *(const f32x4*)(xr + 256 * j + 4 * lane); }
#pragma unroll
        for (int j = 0; j < 4; ++j) st_bf4(XB + (size_t)row * DM + 256 * j + 4 * lane, v[j]);
        f32x4 d0 = (f32x4){0.f, 0.f, 0.f, 0.f}, d1 = d0;
#pragma unroll
        for (int j = 0; j < 4; ++j)
#pragma unroll
            for (int e = 0; e < 4; ++e) { const float xv = v[j][e]; d0 += W8[((j * 4 + e) * 2 + 0) * 64 + lane] * xv; d1 += W8[((j * 4 + e) * 2 + 1) * 64 + lane] * xv; }
        const bool b0 = lane & 1, b1 = lane & 2, b2 = lane & 4;
        float t0 = (b0 ? d1.x : d0.x) + __shfl_xor(b0 ? d0.x : d1.x, 1), t1 = (b0 ? d1.y : d0.y) + __shfl_xor(b0 ? d0.y : d1.y, 1);
        float t2 = (b0 ? d1.z : d0.z) + __shfl_xor(b0 ? d0.z : d1.z, 1), t3 = (b0 ? d1.w : d0.w) + __shfl_xor(b0 ? d0.w : d1.w, 1);
        float u0 = (b1 ? t2 : t0) + __shfl_xor(b1 ? t0 : t2, 2), u1 = (b1 ? t3 : t1) + __shfl_xor(b1 ? t1 : t3, 2);
        float w = (b2 ? u1 : u0) + __shfl_xor(b2 ? u0 : u1, 4);
        w += __shfl_xor(w, 8); w += __shfl_xor(w, 16); w += __shfl_xor(w, 32);
        ss = wave_sum(ss); const float rs = rsqrtf(ss * (1.f / DM) + EPS);
        if (lane < 8) { const int hh = 2 * ((lane >> 1) & 1) + ((lane >> 2) & 1);
            if (!(lane & 1)) BETA[(size_t)row * 4 + hh] = sigmoidf_(w * rs);
            else { const float xa = w * rs + dt_bias[hh]; const float sp = fmaxf(xa, 0.f) + log1pf(expf(-fabsf(xa))); GG[(size_t)row * 4 + hh] = -expf(a_log[hh]) * sp; } }
        if (lane == 0) RS0[row] = rs;
    }
}

__device__ __forceinline__ void gdn_prep(const Params& P, LAS unsigned char* lds, int tid, int lane, int wave, int bid, int G) {
    unsigned char* ws = P.ws; const bf16* PROJ = (const bf16*)(ws + WS_PROJ); const float* BETA = (const float*)(ws + WS_BETA); const float* GG = (const float*)(ws + WS_G);
    bf16* FRB = (bf16*)P.out; bf16* ATf = (bf16*)(ws + WS_AT); float* DECF = (float*)(ws + WS_DECF); const float* wconv = P.in[8];
    const int tid0 = tid;
    for (int u0 = bid * 2; u0 < 1024; u0 += G * 2) {
        int tid = tid0; asm volatile("" : "+v"(tid));
        const int lane = tid & 63, wv = __builtin_amdgcn_readfirstlane(tid >> 6), hb = wv >> 2, t = tid & 255, w4 = wv & 3, c = lane & 15, q = lane >> 4;
        LAS unsigned char* base = lds + hb * 70656;
        LAS bf16* q_l = (LAS bf16*)base; LAS bf16* k_l = (LAS bf16*)(base + 17408); LAS bf16* v_l = (LAS bf16*)(base + 34816);
        LAS float* A_l = (LAS float*)(base + 52224); LAS float* gc = (LAS float*)(base + 69632); LAS float* bt = gc + 64;
        const int unit = u0 + hb, cg = unit >> 2, h = unit & 3, n = cg & 31; const int row0 = cg * 64, tokb = 16 * w4;
        float y[3][16][2];
#pragma unroll
        for (int g3 = 0; g3 < 3; ++g3) {
            const int col = g3 * 512 + h * 128 + 2 * lane;
            const float w0a = wconv[col], w0b = wconv[col + 1], w1a = wconv[1536 + col], w1b = wconv[1536 + col + 1], w2a = wconv[3072 + col], w2b = wconv[3072 + col + 1], w3a = wconv[4608 + col], w3b = wconv[4608 + col + 1];
            const bf16* src = PROJ + (size_t)(row0 + tokb) * NIN + col;
            unsigned raw[19];
            const bool nohist = (n == 0 && w4 == 0);
#pragma unroll
            for (int i = 0; i < 19; ++i) raw[i] = (i < 3 && nohist) ? 0u : *(const unsigned*)(src + (ptrdiff_t)(i - 3) * NIN);
            typedef float f32x2c __attribute__((ext_vector_type(2)));
            const f32x2c w0 = (f32x2c){w0a, w0b}, w1 = (f32x2c){w1a, w1b}, w2 = (f32x2c){w2a, w2b}, w3 = (f32x2c){w3a, w3b};
            f32x2c xr2[19];
#pragma unroll
            for (int i = 0; i < 19; ++i) xr2[i] = (f32x2c){bflo(raw[i]), bfhi(raw[i])};
#pragma unroll
            for (int i = 0; i < 16; ++i) { const f32x2c yy = w0 * xr2[i] + w1 * xr2[i + 1] + w2 * xr2[i + 2] + w3 * xr2[i + 3];
                y[g3][i][0] = siluf_(yy.x); y[g3][i][1] = siluf_(yy.y); }
        }
#pragma unroll
        for (int g3 = 0; g3 < 2; ++g3)
#pragma unroll
            for (int i = 0; i < 16; ++i) { const float s = wave_sum(y[g3][i][0] * y[g3][i][0] + y[g3][i][1] * y[g3][i][1]); const float r = rsqrtf(s + 1e-6f); y[g3][i][0] *= r; y[g3][i][1] *= r; }
#pragma unroll
        for (int i = 0; i < 16; ++i) {
            *(LAS unsigned*)(q_l + (tokb + i) * 136 + 2 * lane) = pk2(y[0][i][0], y[0][i][1]);
            *(LAS unsigned*)(k_l + (tokb + i) * 136 + 2 * lane) = pk2(y[1][i][0], y[1][i][1]);
            *(LAS unsigned*)(v_l + (tokb + i) * 136 + 2 * lane) = pk2(y[2][i][0], y[2][i][1]);
        }
        if (w4 == 0) {
            int lane = tid; asm volatile("" : "+v"(lane)); lane &= 63;
            float g = GG[(size_t)(row0 + lane) * 4 + h];
#pragma unroll
            for (int o = 1; o < 64; o <<= 1) { const float tt = __shfl_up(g, o); if (lane >= o) g += tt; }
            const float btv = BETA[(size_t)(row0 + lane) * 4 + h]; gc[lane] = g; bt[lane] = btv; gc[128 + lane] = btv * __expf(g); gc[192 + lane] = __expf(__shfl(g, 63) - g);
            const float dl = __expf(__shfl(g, 63));
            *(f32x4*)(DECF + (size_t)unit * 256 + lane * 4) = (f32x4){dl, dl, dl, dl};
        }
        __syncthreads();
        {
            const int it = w4; bf16x8 qf[4], kif[4];
#pragma unroll
            for (int kd = 0; kd < 4; ++kd) { qf[kd] = *(const LAS bf16x8*)(q_l + (16 * it + c) * 136 + 32 * kd + 8 * q); kif[kd] = *(const LAS bf16x8*)(k_l + (16 * it + c) * 136 + 32 * kd + 8 * q); }
            const int ii = 16 * it + c; const float gci = gc[ii];
            float atv[2][8];
#pragma unroll
            for (int jt = 0; jt < 4; ++jt) {
                if (jt <= it) {
                    f32x4 aq = (f32x4){0.f, 0.f, 0.f, 0.f}, ak = aq;
#pragma unroll
                    for (int kd = 0; kd < 4; ++kd) { const bf16x8 kjf = *(const LAS bf16x8*)(k_l + (16 * jt + c) * 136 + 32 * kd + 8 * q); aq = mfma16(kjf, qf[kd], aq); ak = mfma16(kif[kd], kjf, ak); }
                    const f32x4 gj = *(const LAS f32x4*)(gc + 16 * jt + 4 * q); f32x4 av;
                    const f32x4 gi4 = *(const LAS f32x4*)(gc + 16 * it + 4 * q), bi4 = *(const LAS f32x4*)(bt + 16 * it + 4 * q); const float gcj = gc[16 * jt + c];
#pragma unroll
                    for (int r = 0; r < 4; ++r) { const int j = 16 * jt + 4 * q + r; const float dec = (j <= ii) ? __expf(gci - gj[r]) : 0.f;
                        atv[jt >> 1][(jt & 1) * 4 + r] = aq[r] * dec * QSCALE;
                        const int i2 = 16 * it + 4 * q + r, j2 = 16 * jt + c; av[r] = (j2 < i2) ? ak[r] * bi4[r] * __expf(gi4[r] - gcj) : 0.f; }
                    *(LAS f32x4*)(A_l + (16 * jt + c) * 68 + 16 * it + 4 * q) = av;
                } else {
#pragma unroll
                    for (int r = 0; r < 4; ++r) atv[jt >> 1][(jt & 1) * 4 + r] = 0.f;
                }
            }
#pragma unroll
            for (int ks = 0; ks < 2; ++ks) { u32x4 o; o.x = pk2(atv[ks][0], atv[ks][1]); o.y = pk2(atv[ks][2], atv[ks][3]); o.z = pk2(atv[ks][4], atv[ks][5]); o.w = pk2(atv[ks][6], atv[ks][7]);
                *(u32x4*)(ATf + ((size_t)unit * 8 + it * 2 + ks) * 512 + lane * 8) = o; }
        }
        {
            const float gl = gc[63];
#pragma unroll
            for (int e = 0; e < 4; ++e) {
                const int f = w4 + 4 * e;
                { const int mt = f >> 2, ks = f & 3, tok = 16 * mt + c; const float sc = __expf(gc[tok]) * QSCALE;
                  const u32x2 lo = *(const LAS u32x2*)(q_l + tok * 136 + 32 * ks + 4 * q), hi = *(const LAS u32x2*)(q_l + tok * 136 + 32 * ks + 16 + 4 * q);
                  u32x4 o; o.x = pk2(bflo(lo.x) * sc, bfhi(lo.x) * sc); o.y = pk2(bflo(lo.y) * sc, bfhi(lo.y) * sc); o.z = pk2(bflo(hi.x) * sc, bfhi(hi.x) * sc); o.w = pk2(bflo(hi.y) * sc, bfhi(hi.y) * sc);
                  *(u32x4*)(FRB + FR_QG + (size_t)unit * 8192 + f * 512 + lane * 8) = o; }
                { const int mt = f >> 1, ks2 = f & 1; float kv[8];
#pragma unroll
                  for (int jj = 0; jj < 8; ++jj) { const int tok = 32 * ks2 + 16 * (jj >> 2) + 4 * q + (jj & 3); kv[jj] = bf2f(k_l[tok * 136 + 16 * mt + c]) * gc[192 + tok]; }
                  u32x4 o; o.x = pk2(kv[0], kv[1]); o.y = pk2(kv[2], kv[3]); o.z = pk2(kv[4], kv[5]); o.w = pk2(kv[6], kv[7]);
                  *(u32x4*)(FRB + FR_KG + (size_t)unit * 8192 + f * 512 + lane * 8) = o; }
            }
        }
        int t5 = t; asm volatile("" : "+v"(t5));
        const int col = t5 & 127, kind = __builtin_amdgcn_readfirstlane(t5 >> 7);
        typedef float f32x2s __attribute__((ext_vector_type(2)));
        f32x2s sp[32];
        {
            const LAS bf16* srcl = kind ? k_l : v_l;
#pragma unroll
            for (int i = 0; i < 64; ++i) { const float m = (kind ? gc + 128 : bt)[i]; sp[i >> 1][i & 1] = bf2f(srcl[i * 136 + col]) * m; }
        }
        __syncthreads();
        {
#pragma clang loop unroll(full)
            for (int j = 0; j < 63; ++j) {
                f32x4 avc[16];
#pragma unroll
                for (int v = (j + 1) >> 2; v < 16; ++v) avc[v] = *(const LAS f32x4*)(A_l + j * 68 + 4 * v);
                __builtin_amdgcn_sched_barrier(0);
                const float sj = sp[j >> 1][j & 1]; const f32x2s sj2 = (f32x2s){sj, sj};
#pragma unroll
                for (int v = (j + 1) >> 2; v < 16; ++v) { const f32x4 a = avc[v];
                    sp[2 * v] -= (f32x2s){a.x, a.y} * sj2; sp[2 * v + 1] -= (f32x2s){a.z, a.w} * sj2; }
                __builtin_amdgcn_sched_barrier(0);
            }
        }
        {
            LAS bf16* dstl = kind ? k_l : v_l;
#pragma unroll
            for (int i = 0; i < 64; ++i) dstl[i * 136 + col] = (bf16)f2bf(sp[i >> 1][i & 1]);
        }
        __syncthreads();
        { int l7 = tid; asm volatile("" : "+v"(l7)); const int c = l7 & 15, q = (l7 >> 4) & 3, lane = l7 & 63;
#pragma unroll
        for (int e = 0; e < 4; ++e) { const int f = w4 + 4 * e, mt = f >> 2, ks = f & 3, tok = 16 * mt + c;
            const u32x2 lo = *(const LAS u32x2*)(k_l + tok * 136 + 32 * ks + 4 * q), hi = *(const LAS u32x2*)(k_l + tok * 136 + 32 * ks + 16 + 4 * q);
            *(u32x4*)(FRB + FR_W + (size_t)unit * 8192 + f * 512 + lane * 8) = (u32x4){lo.x, lo.y, hi.x, hi.y}; }
#pragma unroll
        for (int e = 0; e < 8; ++e) { const int f = w4 + 4 * e, sl = f >> 2, mt = f & 3; const LAS bf16* s = v_l + (16 * mt + 4 * q) * 136 + 16 * sl + c;
            u32x2 o; o.x = (unsigned)s[0] | ((unsigned)s[136] << 16); o.y = (unsigned)s[272] | ((unsigned)s[408] << 16);
            *(u32x2*)(FRB + FR_U + ((size_t)unit * 32 + f) * 256 + lane * 4) = o; }
        }
        __syncthreads();
    }
}

__device__ __forceinline__ void sgu_prompt(const Params& P, LAS unsigned char* lds, int tid, int lane, int wave, int bid, int G) {
    asm volatile("" : "+v"(tid)); lane = tid & 63;
    unsigned char* ws = P.ws; const bf16* PROJ = (const bf16*)(ws + WS_PROJ); bf16* MIX = (bf16*)(ws + WS_MIX); const bf16* WSB = (const bf16*)(ws + WS_WSB);
    const float* lng = P.in[12]; const float* lnb = P.in[13]; const float* b_s = P.in[15];
    LAS bf16* vgT = (LAS bf16*)lds; const int c = lane & 15, q = lane >> 4;
    float lg[8], lb[8];
#pragma unroll
    for (int e = 0; e < 8; ++e) { lg[e] = lng[8 * lane + e]; lb[e] = lnb[8 * lane + e]; }
    for (int su = bid; su < 256; su += G) {
        const int b = su >> 5, n = (su >> 1) & 15, hp = su & 1; const int row0 = b * 2048 + n * 128;
        u32x4 rawv[16];
#pragma unroll
        for (int i = 0; i < 16; ++i) rawv[i] = *(const u32x4*)(PROJ + (size_t)(row0 + 16 * wave + i) * NIN + 2560 + 8 * lane);
        unsigned pkv[8][8];
#pragma unroll
        for (int i2 = 0; i2 < 8; ++i2) {
            float xa[8], xb2[8];
#pragma unroll
            for (int hh = 0; hh < 2; ++hh) {
                const u32x4 raw = rawv[2 * i2 + hh];
                float x[8] = {bflo(raw.x), bfhi(raw.x), bflo(raw.y), bfhi(raw.y), bflo(raw.z), bfhi(raw.z), bflo(raw.w), bfhi(raw.w)};
                float s = 0.f;
#pragma unroll
                for (int e = 0; e < 8; ++e) s += x[e];
                const float mean = wave_sum(s) * (1.f / 512.f); float s2 = 0.f;
#pragma unroll
                for (int e = 0; e < 8; ++e) { x[e] -= mean; s2 += x[e] * x[e]; }
                const float rstd = rsqrtf(wave_sum(s2) * (1.f / 512.f) + EPS);
#pragma unroll
                for (int e = 0; e < 8; ++e) { const float vn_ = x[e] * rstd * lg[e] + lb[e]; if (hh == 0) xa[e] = vn_; else xb2[e] = vn_; }
            }
#pragma unroll
            for (int e = 0; e < 8; ++e) pkv[e][i2] = pk2(xa[e], xb2[e]);
        }
        if ((q >> 1) == hp) {
#pragma unroll
            for (int e = 0; e < 8; ++e) {
                LAS bf16* rowp = vgT + (q & 1) * 17408 + (8 * c + e) * 136;
                *(LAS u32x4*)(rowp + 8 * ((2 * wave) ^ c)) = (u32x4){pkv[e][0], pkv[e][1], pkv[e][2], pkv[e][3]};
                *(LAS u32x4*)(rowp + 8 * ((2 * wave + 1) ^ c)) = (u32x4){pkv[e][4], pkv[e][5], pkv[e][6], pkv[e][7]};
            }
        }
        __syncthreads();
#pragma unroll 1
        for (int hh = 0; hh < 2; ++hh) { const int h = 2 * hp + hh; const LAS bf16* vgh = vgT + hh * 17408;
        f32x4 acc[8]; u32x2 upre[8]; const float bias_pre = b_s[h * 128 + 16 * wave + c];
#pragma unroll
        for (int nt = 0; nt < 8; ++nt) { acc[nt] = (f32x4){0.f, 0.f, 0.f, 0.f}; upre[nt] = *(const u32x2*)(PROJ + ((size_t)row0 + 16 * wave + c) * NIN + 2048 + h * 128 + 16 * nt + 4 * q); }
        for (int ks = 0; ks <= (wave >> 1); ++ks) {
            const bf16x8 bfr = *(const bf16x8*)(WSB + (size_t)(h * 128 + 16 * wave + c) * 128 + 32 * ks + 8 * q);
#pragma unroll
            for (int nt = 0; nt < 8; ++nt) { const int d = 16 * nt + c; const bf16x8 afr = *(const LAS bf16x8*)(vgh + d * 136 + 8 * ((4 * ks + q) ^ ((d >> 3) & 15))); acc[nt] = mfma16(afr, bfr, acc[nt]); }
        }
        { const int tt = 16 * wave + c; const size_t row = (size_t)row0 + tt; const float bias = bias_pre;
#pragma unroll
          for (int nt = 0; nt < 8; ++nt) { const int d0 = 16 * nt + 4 * q; const u32x2 ur = upre[nt];
              f32x4 o; o.x = bflo(ur.x) * (acc[nt].x + bias); o.y = bfhi(ur.x) * (acc[nt].y + bias); o.z = bflo(ur.y) * (acc[nt].z + bias); o.w = bfhi(ur.y) * (acc[nt].w + bias);
              st_bf4(MIX + row * DM + 512 + h * 128 + d0, o); } }
        }
        __syncthreads();
    }
}

__device__ __forceinline__ void sample_gdn(const Params& P, LAS unsigned char* lds, int tid, int lane, int wave, int bid, int G) {
    asm volatile("" : "+v"(tid)); lane = tid & 63;
    unsigned char* ws = P.ws; const bf16* PROJ = (const bf16*)(ws + WS_PROJ); bf16* MIX = (bf16*)(ws + WS_MIX); const float* BETA = (const float*)(ws + WS_BETA); const float* GG = (const float*)(ws + WS_G);
    const float* sconv = P.in[2]; const float* sgdn = P.in[3]; const float* wconv = P.in[8]; const float* gnorm = P.in[11];
    float* NCS = P.out + O_NCS; float* NGS = P.out + O_NGS;
    LAS float* sm = (LAS float*)lds; LAS float* scal = sm + 384; LAS f32x4* red = (LAS f32x4*)(sm + 512);
    const int dv4 = tid & 31, dkg = tid >> 5;
    for (int su = bid; su < 512; su += G) {
        const int bs = su >> 2, h = su & 3; const size_t srow = (size_t)MPR + bs;
        const float* S0 = sgdn + (size_t)(bs * 4 + h) * 16384 + (size_t)(8 * dkg) * 128 + 4 * dv4;
        f32x4 s0[8];
#pragma unroll
        for (int i = 0; i < 8; ++i) s0[i] = *(const f32x4*)(S0 + (size_t)i * 128);
        if (tid < 384) { const int g3 = tid >> 7, ch = tid & 127, col = g3 * 512 + h * 128 + ch;
            const float x = bf2f(PROJ[srow * NIN + col]); const float h0 = sconv[(size_t)(bs * 3 + 0) * 1536 + col], h1 = sconv[(size_t)(bs * 3 + 1) * 1536 + col], h2 = sconv[(size_t)(bs * 3 + 2) * 1536 + col];
            const float yv = siluf_(wconv[col] * h0 + wconv[1536 + col] * h1 + wconv[3072 + col] * h2 + wconv[4608 + col] * x);
            NCS[(size_t)(bs * 3 + 0) * 1536 + col] = h1; NCS[(size_t)(bs * 3 + 1) * 1536 + col] = h2; NCS[(size_t)(bs * 3 + 2) * 1536 + col] = x;
            sm[g3 * 128 + ch] = yv; }
        __syncthreads();
        if (wave < 2) { const float a = sm[wave * 128 + lane], b2 = sm[wave * 128 + 64 + lane]; const float s = wave_sum(a * a + b2 * b2); if (lane == 0) scal[wave] = rsqrtf(s + 1e-6f); }
        __syncthreads();
        const float qn = scal[0], kn = scal[1];
        const float beta = BETA[srow * 4 + h], eg = __expf(GG[srow * 4 + h]);
        float kk[8], qq[8]; f32x4 p = (f32x4){0.f, 0.f, 0.f, 0.f};
#pragma unroll
        for (int i = 0; i < 8; ++i) { kk[i] = sm[128 + 8 * dkg + i] * kn; qq[i] = sm[8 * dkg + i] * qn; p += s0[i] * kk[i]; }
        red[dkg * 32 + dv4] = p;
        __syncthreads();
        f32x4 kS = red[dv4];
#pragma unroll
        for (int g = 1; g < 16; ++g) kS += red[g * 32 + dv4];
        const f32x4 v4 = *(const LAS f32x4*)(sm + 256 + 4 * dv4); const f32x4 vnew = (v4 - kS * eg) * beta;
        __syncthreads();
        f32x4 po = (f32x4){0.f, 0.f, 0.f, 0.f}; float* S1 = NGS + (size_t)(bs * 4 + h) * 16384 + (size_t)(8 * dkg) * 128 + 4 * dv4;
#pragma unroll
        for (int i = 0; i < 8; ++i) { const f32x4 s1 = s0[i] * eg + vnew * kk[i]; *(f32x4*)(S1 + (size_t)i * 128) = s1; po += s1 * qq[i]; }
        red[dkg * 32 + dv4] = po;
        __syncthreads();
        if (tid < 32) { f32x4 o = red[dv4];
#pragma unroll
            for (int g = 1; g < 16; ++g) o += red[g * 32 + dv4];
            o = o * QSCALE; float s = dot4(o); s += __shfl_xor(s, 1); s += __shfl_xor(s, 2); s += __shfl_xor(s, 4); s += __shfl_xor(s, 8); s += __shfl_xor(s, 16);
            const float rs = rsqrtf(s * (1.f / 128.f) + EPS); const u32x2 zr = *(const u32x2*)(PROJ + srow * NIN + 1536 + h * 128 + 4 * dv4); const f32x4 gn = *(const f32x4*)(gnorm + 4 * dv4);
            f32x4 m; m.x = o.x * rs * gn.x * siluf_(bflo(zr.x)); m.y = o.y * rs * gn.y * siluf_(bfhi(zr.x)); m.z = o.z * rs * gn.z * siluf_(bflo(zr.y)); m.w = o.w * rs * gn.w * siluf_(bfhi(zr.y));
            st_bf4(MIX + srow * DM + h * 128 + 4 * dv4, m); }
        __syncthreads();
    }
}

__device__ __forceinline__ void phase2_misc(const Params& P, int tid, int lane, int wave, int bid, int G) {
    unsigned char* ws = P.ws; const bf16* PROJ = (const bf16*)(ws + WS_PROJ); bf16* MIX = (bf16*)(ws + WS_MIX);
    { float* NCP = P.out + O_NCP; for (int i = bid * 512 + tid; i < 36864; i += G * 512) { const int b = i / 4608, rem = i - b * 4608, j = rem / 1536, col = rem - j * 1536; NCP[i] = bf2f(PROJ[(size_t)(b * 2048 + 2045 + j) * NIN + col]); } }
    const int gw = bid * 8 + wave;
    if (gw < MSA) { const int bs = gw; const size_t srow = (size_t)MPR + bs; const float* lng = P.in[12]; const float* lnb = P.in[13]; float* NSV = P.out + O_NSV;
        const u32x4 raw = *(const u32x4*)(PROJ + srow * NIN + 2560 + 8 * lane); const u32x4 uraw = *(const u32x4*)(PROJ + srow * NIN + 2048 + 8 * lane);
        float x[8] = {bflo(raw.x), bfhi(raw.x), bflo(raw.y), bfhi(raw.y), bflo(raw.z), bfhi(raw.z), bflo(raw.w), bfhi(raw.w)};
        const float uu[8] = {bflo(uraw.x), bfhi(uraw.x), bflo(uraw.y), bfhi(uraw.y), bflo(uraw.z), bfhi(uraw.z), bflo(uraw.w), bfhi(uraw.w)};
        float s = 0.f;
#pragma unroll
        for (int e = 0; e < 8; ++e) s += x[e];
        const float mean = wave_sum(s) * (1.f / 512.f); float s2 = 0.f;
#pragma unroll
        for (int e = 0; e < 8; ++e) { x[e] -= mean; s2 += x[e] * x[e]; }
        const float rstd = rsqrtf(wave_sum(s2) * (1.f / 512.f) + EPS); const int h = lane >> 4; const float w00 = P.in[14][(size_t)h * 16384], b0 = P.in[15][h * 128];
        float vg[8], sg[8];
#pragma unroll
        for (int e = 0; e < 8; ++e) { vg[e] = x[e] * rstd * lng[8 * lane + e] + lnb[8 * lane + e]; sg[e] = uu[e] * (w00 * vg[e] + b0); }
        *(f32x4*)(NSV + (size_t)bs * 512 + 8 * lane) = (f32x4){vg[0], vg[1], vg[2], vg[3]}; *(f32x4*)(NSV + (size_t)bs * 512 + 8 * lane + 4) = (f32x4){vg[4], vg[5], vg[6], vg[7]};
        u32x4 o; o.x = pk2(sg[0], sg[1]); o.y = pk2(sg[2], sg[3]); o.z = pk2(sg[4], sg[5]); o.w = pk2(sg[6], sg[7]); *(u32x4*)(MIX + srow * DM + 512 + 8 * lane) = o; }
}

constexpr int ST_BYTES = 60416;
__device__ __forceinline__ void glds16(const void* g, LAS unsigned char* l) { __builtin_amdgcn_global_load_lds((const unsigned*)g, (LAS unsigned*)l, 16, 0, 0); }
__device__ __forceinline__ void scan_issue1(const bf16* FRB, const bf16* ATf, const float* DECF, int unit, int sl, LAS unsigned char* L, int lane) {
    const bf16* w = FRB + FR_W + (size_t)unit * 8192 + lane * 8; const bf16* at = ATf + (size_t)unit * 4096 + lane * 8; const bf16* uu = FRB + FR_U + ((size_t)unit * 8 + sl) * 1024 + lane * 8;
#pragma unroll
    for (int f = 0; f < 16; ++f) glds16(w + f * 512, L + f * 1024);
#pragma unroll
    for (int f = 0; f < 8; ++f) glds16(at + f * 512, L + 49152 + f * 1024);
    glds16(uu, L + 57344); glds16(uu + 512, L + 58368);
    glds16(DECF + (size_t)unit * 256 + lane * 4, L + 59392);
}
__device__ __forceinline__ void scan_issue2(const bf16* FRB, int unit, LAS unsigned char* L, int lane) {
    const bf16* qg = FRB + FR_QG + (size_t)unit * 8192 + lane * 8; const bf16* kg = FRB + FR_KG + (size_t)unit * 8192 + lane * 8;
#pragma unroll
    for (int f = 0; f < 16; ++f) glds16(qg + f * 512, L + 16384 + f * 1024);
#pragma unroll
    for (int f = 0; f < 16; ++f) glds16(kg + f * 512, L + 32768 + f * 1024);
}
__device__ __forceinline__ void gdn_scan(const Params& P, LAS unsigned char* lds, volatile LAS unsigned* flg, int lane, int wave, int bid, int G) {
    if (wave > 2) return;
    asm volatile("" : "+v"(lane));
    unsigned char* ws = P.ws; const bf16* FRB = (const bf16*)P.out; const bf16* ATf = (const bf16*)(ws + WS_AT); const float* DECF = (const float*)(ws + WS_DECF);
    bf16* O = (bf16*)(ws + WS_O); float* NGP = P.out + O_NGP; const int c = lane & 15, q = lane >> 4;
    int gs = 0;
    for (int job = bid; job < 256; job += G, gs += 32) {
        const int bh = (job & 7) + 8 * (job >> 6), sl = (job >> 3) & 7, b = bh >> 2, h = bh & 3;
        if (wave != 0) {
            for (int n = 0; n < 32; ++n) {
                const int s_ = gs + n; LAS unsigned char* L = lds + (s_ & 1) * ST_BYTES;
                while ((int)flg[0] < s_ - 1) __builtin_amdgcn_s_sleep(1);
                asm volatile("" ::: "memory");
                if (wave == 1) scan_issue1(FRB, ATf, DECF, (b * 32 + n) * 4 + h, sl, L, lane); else scan_issue2(FRB, (b * 32 + n) * 4 + h, L, lane);
                asm volatile("s_waitcnt vmcnt(0)" ::: "memory");
                if (lane == 0) flg[wave] = (unsigned)(s_ + 1);
                asm volatile("s_waitcnt lgkmcnt(0)" ::: "memory");
            }
            continue;
        }
        f32x4 S[8];
#pragma unroll
        for (int i = 0; i < 8; ++i) S[i] = (f32x4){0.f, 0.f, 0.f, 0.f};
        for (int n = 0; n < 32; ++n) {
            const int s_ = gs + n; LAS unsigned char* L = lds + (s_ & 1) * ST_BYTES;
            while ((int)flg[1] < s_ + 1 || (int)flg[2] < s_ + 1) __builtin_amdgcn_s_sleep(1);
            asm volatile("" ::: "memory");
            bf16x8 Wfr[16], QGfr[16]; u32x2 Ufr[4];
#pragma unroll
            for (int f = 0; f < 16; ++f) Wfr[f] = *(const LAS bf16x8*)(L + f * 1024 + lane * 16);
#pragma unroll
            for (int mt = 0; mt < 4; ++mt) Ufr[mt] = *(const LAS u32x2*)(L + 57344 + mt * 512 + lane * 8);
#pragma unroll
            for (int f = 0; f < 16; ++f) QGfr[f] = *(const LAS bf16x8*)(L + 16384 + f * 1024 + lane * 16);
            __builtin_amdgcn_sched_barrier(0);
            bf16x8 Sb[4];
#pragma unroll
            for (int ks = 0; ks < 4; ++ks) Sb[ks] = pack8(S[2 * ks], S[2 * ks + 1]);
            f32x4 va[4], oa[4];
#pragma unroll
            for (int mt = 0; mt < 4; ++mt) { va[mt] = (f32x4){0.f, 0.f, 0.f, 0.f}; oa[mt] = va[mt]; }
#pragma unroll
            for (int ks = 0; ks < 4; ++ks)
#pragma unroll
                for (int mt = 0; mt < 4; ++mt) va[mt] = mfma16(Wfr[mt * 4 + ks], Sb[ks], va[mt]);
            __builtin_amdgcn_sched_barrier(0);
            bf16x8 ATfr[8];
#pragma unroll
            for (int f = 0; f < 8; ++f) ATfr[f] = *(const LAS bf16x8*)(L + 49152 + f * 1024 + lane * 16);
            const float dec = *(const LAS float*)(L + 59392 + lane * 4);
            __builtin_amdgcn_sched_barrier(0);
#pragma unroll
            for (int ks = 0; ks < 4; ++ks)
#pragma unroll
                for (int mt = 0; mt < 4; ++mt) oa[mt] = mfma16(QGfr[mt * 4 + ks], Sb[ks], oa[mt]);
            __builtin_amdgcn_sched_barrier(0);
            bf16x8 KGfr[16];
#pragma unroll
            for (int f = 0; f < 16; ++f) KGfr[f] = *(const LAS bf16x8*)(L + 32768 + f * 1024 + lane * 16);
            __builtin_amdgcn_sched_barrier(0);
            f32x4 vn[4];
#pragma unroll
            for (int mt = 0; mt < 4; ++mt) vn[mt] = (f32x4){bflo(Ufr[mt].x) - va[mt].x, bfhi(Ufr[mt].x) - va[mt].y, bflo(Ufr[mt].y) - va[mt].z, bfhi(Ufr[mt].y) - va[mt].w};
            bf16x8 vb[2];
#pragma unroll
            for (int k2 = 0; k2 < 2; ++k2) vb[k2] = pack8(vn[2 * k2], vn[2 * k2 + 1]);
#pragma unroll
            for (int mt = 0; mt < 8; ++mt) S[mt] = S[mt] * dec;
#pragma unroll
            for (int k2 = 0; k2 < 2; ++k2) {
#pragma unroll
                for (int mt = 0; mt < 8; ++mt) S[mt] = mfma16(KGfr[mt * 2 + k2], vb[k2], S[mt]);
#pragma unroll
                for (int mt = 0; mt < 4; ++mt) oa[mt] = mfma16(ATfr[mt * 2 + k2], vb[k2], oa[mt]);
            }
#pragma unroll
            for (int mt = 0; mt < 4; ++mt) {
                const bool od = lane & 1; const float t0 = dpp_get<0xB1, 0xF>(od ? oa[mt].x : oa[mt].z), t1 = dpp_get<0xB1, 0xF>(od ? oa[mt].y : oa[mt].w);
                unsigned* op = (unsigned*)(O + ((size_t)(b * 2048 + n * 64 + 16 * mt + 4 * q + (od ? 2 : 0))) * 512 + h * 128 + 16 * sl + (c & ~1));
                op[0] = od ? pk2(t0, oa[mt].z) : pk2(oa[mt].x, t0); op[256] = od ? pk2(t1, oa[mt].w) : pk2(oa[mt].y, t1); }
            asm volatile("s_waitcnt lgkmcnt(0)" ::: "memory");
            if (lane == 0) flg[0] = (unsigned)(s_ + 1);
            asm volatile("" ::: "memory");
        }
#pragma unroll
        for (int mt = 0; mt < 8; ++mt) { float* sp = NGP + ((size_t)(b * 4 + h) * 128 + 16 * mt + 4 * q) * 128 + 16 * sl + c; sp[0] = S[mt].x; sp[128] = S[mt].y; sp[256] = S[mt].z; sp[384] = S[mt].w; }
        asm volatile("s_waitcnt vmcnt(0)" ::: "memory");
    }
}

__device__ __forceinline__ void gdn_gate(const Params& P, int lane, int wave, int bid, int G) {
    unsigned char* ws = P.ws; const bf16* PROJ = (const bf16*)(ws + WS_PROJ); bf16* MIX = (bf16*)(ws + WS_MIX); const bf16* O = (const bf16*)(ws + WS_O); const float* gnorm = P.in[11];
    float gn[8];
#pragma unroll
    for (int e = 0; e < 8; ++e) gn[e] = gnorm[8 * (lane & 15) + e];
    for (int row0 = bid * 8 + wave; row0 < MPR; row0 += G * 32) {
        f32x4 a[4], b[4]; u32x4 zr[4];
#pragma unroll
        for (int u = 0; u < 4; ++u) { const int row = min(row0 + u * G * 8, MPR - 1); const u32x4 orw = *(const u32x4*)(O + (size_t)row * 512 + 8 * lane);
            a[u] = (f32x4){bflo(orw.x), bfhi(orw.x), bflo(orw.y), bfhi(orw.y)}; b[u] = (f32x4){bflo(orw.z), bfhi(orw.z), bflo(orw.w), bfhi(orw.w)};
            zr[u] = *(const u32x4*)(PROJ + (size_t)row * NIN + 1536 + 8 * lane); }
#pragma unroll
        for (int u = 0; u < 4; ++u) { const int row = row0 + u * G * 8;
            float s = dot4(a[u]) + dot4(b[u]); s += dpp_get<0xB1, 0xF>(s); s += dpp_get<0x4E, 0xF>(s); s += dpp_get<0x141, 0xF>(s); s += dpp_get<0x140, 0xF>(s);
            const float rs = rsqrtf(s * (1.f / 128.f) + EPS);
            u32x4 o; o.x = pk2(a[u].x * rs * gn[0] * siluf_(bflo(zr[u].x)), a[u].y * rs * gn[1] * siluf_(bfhi(zr[u].x))); o.y = pk2(a[u].z * rs * gn[2] * siluf_(bflo(zr[u].y)), a[u].w * rs * gn[3] * siluf_(bfhi(zr[u].y)));
            o.z = pk2(b[u].x * rs * gn[4] * siluf_(bflo(zr[u].z)), b[u].y * rs * gn[5] * siluf_(bfhi(zr[u].z))); o.w = pk2(b[u].z * rs * gn[6] * siluf_(bflo(zr[u].w)), b[u].w * rs * gn[7] * siluf_(bfhi(zr[u].w)));
            if (row < MPR) *(u32x4*)(MIX + (size_t)row * DM + 8 * lane) = o; }
    }
}
__device__ __forceinline__ void final_norm(const Params& P, int lane, int wave, int bid, int G) {
    const float* SS3 = (const float*)(P.ws + WS_SS3); const float* gf = P.in[23]; float* out = P.out; const bf16* X3 = (const bf16*)(P.ws + WS_HID);
    f32x4 g4[4];
#pragma unroll
    for (int j = 0; j < 2; ++j) { g4[2 * j] = *(const f32x4*)(gf + 512 * j + 8 * lane); g4[2 * j + 1] = *(const f32x4*)(gf + 512 * j + 8 * lane + 4); }
    for (int row0 = MPR + bid * 8 + wave; row0 < MT; row0 += G * 32) {
        u32x4 v[4][2]; float rs[4];
#pragma unroll
        for (int u = 0; u < 4; ++u) { const int row = min(row0 + u * G * 8, MT - 1); rs[u] = sum16(SS3 + (size_t)row * 16);
#pragma unroll
            for (int j = 0; j < 2; ++j) v[u][j] = *(const u32x4*)(X3 + (size_t)row * DM + 512 * j + 8 * lane); }
#pragma unroll
        for (int u = 0; u < 4; ++u) { const int row = row0 + u * G * 8; const float r = rsqrtf(rs[u] * (1.f / DM) + EPS);
            if (row < MT) {
#pragma unroll
                for (int j = 0; j < 2; ++j) { const u32x4 w = v[u][j]; float* o = out + (size_t)row * DM + 512 * j + 8 * lane;
                    *(f32x4*)o = (f32x4){bflo(w.x), bfhi(w.x), bflo(w.y), bfhi(w.y)} * r * g4[2 * j];
                    *(f32x4*)(o + 4) = (f32x4){bflo(w.z), bfhi(w.z), bflo(w.w), bfhi(w.w)} * r * g4[2 * j + 1]; } } }
    }
}
#define XB_TMO      128
#define XB_XCNT(j)  (256  + 64 * (j))
#define XB_XSUB(j)  (1280 + 64 * (j))
#define XB_XGEN(j)  (2304 + 64 * (j))
#define XB_TOP      3328
#define XB_TOPGEN   3392
#define XCD_BAR_WORDS 3456
#define XB_SPIN_CAP (1u << 18)

__device__ __forceinline__ unsigned xb_ld(unsigned* p)              { return __hip_atomic_load(p, __ATOMIC_RELAXED, __HIP_MEMORY_SCOPE_AGENT); }
__device__ __forceinline__ unsigned xb_add(unsigned* p, unsigned v) { return __hip_atomic_fetch_add(p, v, __ATOMIC_RELAXED, __HIP_MEMORY_SCOPE_AGENT); }
__device__ __forceinline__ unsigned xb_xcc_id() { return (unsigned)__builtin_amdgcn_s_getreg((3 << 11) | 20) & 0xFu; }
#define XB_SPIN(cond, bar) do { unsigned _sp = 0; while (cond) { __builtin_amdgcn_s_sleep(1); \
    if ((++_sp & 255u) == 0u) { if (xb_ld(&(bar)[XB_TMO])) break; if (_sp > XB_SPIN_CAP) { atomicAdd(&(bar)[XB_TMO], 1u); break; } } } } while (0)

struct XcdBarrier {
    unsigned* bar; unsigned x;
    volatile LAS unsigned* st;
};

__device__ __forceinline__ XcdBarrier xcd_barrier_post(unsigned* bar, volatile LAS unsigned* st) {
    XcdBarrier b; b.bar = bar; b.x = xb_xcc_id(); b.st = st;
    if (threadIdx.x == 0) (void)xb_add(&bar[XB_XCNT(b.x)], 1u);
    return b;
}
__device__ __forceinline__ void xcd_barrier_complete(unsigned* bar, unsigned x, unsigned& nloc, unsigned& nx) {
    const unsigned G = gridDim.x * gridDim.y * gridDim.z;
    unsigned sum, cnt, mine, sp = 0u;
    for (;;) {
        sum = 0u; cnt = 0u; mine = 0u;
#pragma unroll
        for (unsigned j = 0; j < 16; ++j) { const unsigned c = xb_ld(&bar[XB_XCNT(j)]); sum += c; cnt += (c > 0u) ? 1u : 0u; mine = (j == x) ? c : mine; }
        if (sum == G) break;
        __builtin_amdgcn_s_sleep(1);
        if ((++sp & 255u) == 0u) { if (xb_ld(&bar[XB_TMO])) break; if (sp > XB_SPIN_CAP) { atomicAdd(&bar[XB_TMO], 1u); break; } }
    }
    nloc = mine > 0u ? mine : 1u; nx = cnt > 0u ? cnt : 1u;
}

__device__ __forceinline__ void xcd_barrier(const XcdBarrier& b) {
    asm volatile("s_waitcnt vmcnt(0)" ::: "memory");
    __syncthreads();
    if (threadIdx.x == 0) {
        unsigned* bar = b.bar;
        __builtin_amdgcn_s_waitcnt(0);
        unsigned nloc = b.st[0], nx = b.st[1];
        if (nloc == 0u) { xcd_barrier_complete(bar, b.x, nloc, nx); b.st[0] = nloc; b.st[1] = nx; }
        const unsigned old = xb_add(&bar[XB_XSUB(b.x)], 1u);
        const unsigned gen = old / nloc;
        if (old + 1u == (gen + 1u) * nloc) {
            __builtin_amdgcn_fence(__ATOMIC_RELEASE, "agent");
            asm volatile("s_waitcnt vmcnt(0)" ::: "memory");
            const unsigned og = xb_add(&bar[XB_TOP], 1u);
            const unsigned tg = og / nx;
            if (og + 1u == (tg + 1u) * nx) xb_add(&bar[XB_TOPGEN], 1u);
            else XB_SPIN(xb_ld(&bar[XB_TOPGEN]) == tg, bar);
            __builtin_amdgcn_fence(__ATOMIC_ACQUIRE, "agent");
            xb_add(&bar[XB_XGEN(b.x)], 1u);
            asm volatile("s_waitcnt vmcnt(0)" ::: "memory");
        } else {
            XB_SPIN(xb_ld(&bar[XB_XGEN(b.x)]) == gen, bar);
            __builtin_amdgcn_fence(__ATOMIC_ACQUIRE, "agent");
            asm volatile("s_waitcnt vmcnt(0)" ::: "memory");
        }
    }
    __syncthreads();
}

__global__ void __launch_bounds__(512, 2) mega_fwd(Params P) {
    extern __shared__ __attribute__((aligned(16))) unsigned char lds_raw[];
    LAS unsigned char* lds = (LAS unsigned char*)lds_raw;
    const int bid = blockIdx.x, G = gridDim.x;
#define FRESH() int tid = threadIdx.x; asm volatile("" : "+v"(tid)); const int lane = tid & 63, wave = __builtin_amdgcn_readfirstlane(tid >> 6), gw = bid * 8 + wave, NGW = G * 8; (void)gw; (void)NGW; (void)lane

    volatile LAS unsigned* st = (volatile LAS unsigned*)(lds + LDS_BYTES - 64);
    if (threadIdx.x < 16) st[threadIdx.x] = 0u;
    __syncthreads();
    unsigned char* ws = P.ws;
    XcdBarrier bar = xcd_barrier_post((unsigned*)(ws + WS_CTL), st);
#define GRID_BAR() xcd_barrier(bar)
    bf16* XB = (bf16*)(ws + WS_XB); bf16* MIX = (bf16*)(ws + WS_MIX); bf16* PROJ = (bf16*)(ws + WS_PROJ); bf16* HID = (bf16*)(ws + WS_HID); bf16* PB = (bf16*)(ws + WS_PB);
    float* SS1 = (float*)(ws + WS_SS1); float* SS2 = (float*)(ws + WS_SS2); float* SS3 = (float*)(ws + WS_SS3);

    { FRESH(); phase0(P, lds, tid, lane, wave, bid, G); }
    GRID_BAR();
    {   FRESH();
        pg8::Gemm g{XB, (const bf16*)(ws + WS_WIN), MPR, NIN, DM}; pg8::StaticOrder S; S.init(MPR, NIN, G, bid);
        EpiGen<F1> E{F1{nullptr, (const float*)(ws + WS_RS0), PROJ}}; EpiGen8<F1> E8{E.f};
        pg8::gemm_phase<EpiGen8<F1>, pg8::StaticOrder, true, true>(lds, g, S, E8);
        small_gemm<2, 4>(XB + (size_t)MPR * DM, (const bf16*)(ws + WS_WIN), NIN, DM, E.f, lds, bid, G, wave, lane);
    }
    GRID_BAR();
    if ((bid & 3) == 1) { FRESH(); sample_gdn(P, lds, tid, lane, wave, bid, G); }
    if ((bid & 3) == 2) { FRESH(); sgu_prompt(P, lds, tid, lane, wave, bid, G); }
    { FRESH(); gdn_prep(P, lds, tid, lane, wave, bid, G); }
    if ((bid & 3) != 2) { FRESH(); sgu_prompt(P, lds, tid, lane, wave, bid, G); }
    if ((bid & 3) != 1) { FRESH(); sample_gdn(P, lds, tid, lane, wave, bid, G); }
    { FRESH(); phase2_misc(P, tid, lane, wave, bid, G); }
    GRID_BAR();
    { FRESH(); gdn_scan(P, lds, st + 4, lane, wave, bid, G);
      if (wave >= 3 && wave <= 5) weight_items(P, (LAS float*)(lds + 2 * ST_BYTES + (wave - 3) * 8448), lane, 1536, 6784, bid * 3 + (wave - 3), G * 3); }
    GRID_BAR();
    { FRESH(); gdn_gate(P, lane, wave, bid, G); }
    GRID_BAR();
    {   FRESH();
        pg8::Gemm g{MIX, (const bf16*)(ws + WS_WOUT), MPR, DM, DM}; pg8::StaticOrder S; S.init(MPR, DM, G, bid);
        EpiGen<F2> E{F2{SS1, XB}}; EpiGen8<F2> E8{E.f};
        pg8::gemm_phase<EpiGen8<F2>, pg8::StaticOrder, false, true>(lds, g, S, E8);
        small_gemm<2, 4>(MIX + (size_t)MPR * DM, (const bf16*)(ws + WS_WOUT), DM, DM, E.f, lds, bid, G, wave, lane);
    }
    GRID_BAR();
    {   FRESH();
        pg8::Gemm g{XB, (const bf16*)(ws + WS_WUP), MPR, FF, DM}; pg8::StaticOrder S; S.init(MPR, FF, G, bid);
        EpiGen<F3> E{F3{nullptr, SS1, HID}}; EpiGen8<F3> E8{E.f};
        pg8::gemm_phase<EpiGen8<F3>, pg8::StaticOrder, true, true>(lds, g, S, E8);
        small_gemm<2, 4>(XB + (size_t)MPR * DM, (const bf16*)(ws + WS_WUP), FF, DM, E.f, lds, bid, G, wave, lane);
    }
    GRID_BAR();
    {   FRESH();
        pg8::Gemm g{HID, (const bf16*)(ws + WS_WDN), MPR, DM, FF}; pg8::StaticOrder S; S.init(MPR, DM, G, bid);
        EpiGen<F4> E{F4{SS2, XB}}; EpiGen8<F4> E8{E.f};
        pg8::gemm_phase<EpiGen8<F4>, pg8::StaticOrder, false, true>(lds, g, S, E8);
        small_gemm<1, 8>(HID + (size_t)MPR * FF, (const bf16*)(ws + WS_WDN), DM, FF, E.f, lds, bid, G, wave, lane);
    }
    GRID_BAR();
    {   FRESH();
        bf16* PP = MIX;
        { pg8::Gemm g{PB, (const bf16*)(ws + WS_WPLE), MPR, DM, DPLE}; pg8::StaticOrder S; S.init(MPR, DM, G, bid);
          EpiGen<F5a> E{F5a{nullptr, PP}}; EpiGen8<F5a> E8{E.f};
          pg8::gemm_phase<EpiGen8<F5a>, pg8::StaticOrder, false, true>(lds, g, S, E8);
          small_gemm<2, 4>(PB + (size_t)MPR * DPLE, (const bf16*)(ws + WS_WPLE), DM, DPLE, E.f, lds, bid, G, wave, lane); }
        { pg8::Gemm g{XB, (const bf16*)(ws + WS_WG), MPR, DM, DM}; pg8::StaticOrder S; S.init(MPR, DM, G, bid);
          EpiGen<F5b> E{F5b{SS3, SS2, XB, PP, HID}};
          EpiFinal EF{SS2, XB, PP, P.out, P.in[23], (unsigned*)(ws + WS_XBUF), (unsigned*)(ws + WS_CTL + 16384)};
          pg8::gemm_phase<EpiFinal, pg8::StaticOrder, false, true>(lds, g, S, EF);
          small_gemm<2, 4>(XB + (size_t)MPR * DM, (const bf16*)(ws + WS_WG), DM, DM, E.f, lds, bid, G, wave, lane); }
    }
    GRID_BAR();
    { FRESH(); final_norm(P, lane, wave, bid, G); }
}

extern "C" void kernel_launch(void* const* d_in, const int* in_sizes, int n_in, void* d_out, int out_size, void* d_ws, size_t ws_size, hipStream_t stream) {
    static int grid = 0;
    if (grid == 0) {
        int dev = 0, cus = 0;
        if (hipGetDevice(&dev) != hipSuccess || hipDeviceGetAttribute(&cus, hipDeviceAttributeMultiprocessorCount, dev) != hipSuccess) { fprintf(stderr, "kernel_launch: device query failed\n"); grid = -1; return; }
        if (hipFuncSetAttribute((const void*)mega_fwd, hipFuncAttributeMaxDynamicSharedMemorySize, LDS_BYTES) != hipSuccess) { fprintf(stderr, "kernel_launch: hipFuncSetAttribute failed\n"); grid = -1; return; }
        int per_cu = 0;
        if (hipOccupancyMaxActiveBlocksPerMultiprocessor(&per_cu, (const void*)mega_fwd, 512, LDS_BYTES) != hipSuccess || per_cu < 1) fprintf(stderr, "kernel_launch: occupancy query reports %d\n", per_cu);
        (void)hipGetLastError();
        grid = cus < 256 ? cus : 256;
        if (n_in != 24 || ws_size < 256 * MiB) fprintf(stderr, "kernel_launch: unexpected n_in %d / ws %zu\n", n_in, ws_size);
    }
    if (grid < 0) return;
    (void)hipMemsetAsync((char*)d_ws + WS_CTL, 0, CTL_BYTES, stream);
    Params p{};
    for (int i = 0; i < 24; ++i) p.in[i] = (const float*)d_in[i];
    p.out = (float*)d_out; p.ws = (unsigned char*)d_ws;
    hipLaunchKernelGGL(mega_fwd, dim3(grid), dim3(512), LDS_BYTES, stream, p);
}
```

```cpp
#include <hip/hip_runtime.h>
#include <cstdio>
#include <cstdint>
namespace pg8 {
#define PG8_LAS __attribute__((address_space(3)))
typedef unsigned short bf16_t;
typedef short bf16x8 __attribute__((ext_vector_type(8)));
typedef float f32x4 __attribute__((ext_vector_type(4)));
typedef unsigned u32x4 __attribute__((ext_vector_type(4)));
constexpr int BM = 256, BK = 64, HALF = 128, HTB = HALF * BK * 2  , STAGE_BYTES = 8 * HTB, NXCD = 8, WGM = 8;

__host__ __device__ __forceinline__ int lds_byte(int r, int c) { const int st = (r >> 4) * 2 + (c >> 5), rr = r & 15, cc = c & 31, ob = rr * 64 + cc * 2; return st * 1024 + (ob ^ (((ob >> 9) & 1) << 5)); }
__host__ __device__ __forceinline__ void stage_rc(int b, int& R, int& C) { const int st = b / 1024, sb = b % 1024, swz = sb ^ (((sb >> 9) & 1) << 5); R = (st >> 1) * 16 + swz / 64; C = (st & 1) * 32 + (swz % 64) / 2; }
__host__ __device__ __forceinline__ int perm32(int rho) { const int n = rho >> 4, i = rho & 15; return 8 * (i >> 2) + 4 * n + (i & 3); }

struct Unit { int pm, pn; };
struct Gemm { const bf16_t* A; const bf16_t* Bt; int M, N, K; };

struct StaticOrder {
    int nM, nN, nwg, G, c;
    __host__ __device__ void init(int M, int N, int G_, int c_) { nM = M / BM; nN = N / BM; nwg = nM * nN; G = G_; c = c_; }
    __host__ __device__ bool next(int i, Unit& u) const {
        const long L = (long)i * G + c; if (L >= nwg) return false;
        int wgid = (int)L; { const int q = nwg / NXCD, r = nwg % NXCD, xcd = wgid % NXCD, off = wgid / NXCD; wgid = (xcd < r ? xcd * (q + 1) : r * (q + 1) + (xcd - r) * q) + off; }
        const int nig = WGM * nN, gid = wgid / nig, fm = gid * WGM, gsz = (nM - fm) < WGM ? (nM - fm) : WGM;
        u.pm = fm + ((wgid % nig) % gsz); u.pn = (wgid % nig) / gsz; return true;
    }
    __device__ __forceinline__ void a_ready(const Unit&) const {}
    __device__ __forceinline__ void done(const Unit&) const {}
};

__device__ __forceinline__ unsigned cvt_pk_bf16(float lo, float hi) { unsigned r; asm volatile("v_cvt_pk_bf16_f32 %0, %1, %2" : "=v"(r) : "v"(lo), "v"(hi)); return r; }
template <class Epi, class Sched, bool ALIGN_EPI = false, bool SP2 = false>
__device__ __forceinline__ void gemm_phase(PG8_LAS unsigned char* lds, const Gemm g, const Sched& S, const Epi& E) {
    int tid_ = threadIdx.x; asm volatile("" : "+v"(tid_));
    const int tid = tid_, wid = __builtin_amdgcn_readfirstlane(tid >> 6), lane = tid & 63, wr = wid >> 2, wc = wid & 3, fr = lane & 15, fq = lane >> 4;
    const int K = g.K, nt = K / BK;
    unsigned voffA[2], voffB[2];
#pragma unroll
    for (int i = 0; i < 2; ++i) { int R, C; stage_rc(tid * 16 + i * 8192, R, C); const int Rb = Epi::PERM ? ((R & ~31) + perm32(R & 31)) : R;
        voffA[i] = (unsigned)(R * K + C) * 2u; voffB[i] = (unsigned)(Rb * K + C) * 2u; }
    const size_t kstep = (size_t)(BK * 2);
    const size_t hstep = (size_t)HALF * K * 2;
    const size_t tstep = 2 * hstep;
    const unsigned ldsw = (unsigned)wid * 1024u;
    const int aoff = lds_byte(wr * 64 + fr, fq * 8), boff = lds_byte(wc * 32 + fr, fq * 8);
#define PG8_SA(b, h) (((b) * 2 + (h)) * HTB)
#define PG8_SB(b, h) ((4 + (b) * 2 + (h)) * HTB)
#define PG8_STAGE(bufoff, gbase, voff) do { _Pragma("unroll") for (int _i = 0; _i < 2; ++_i) \
        __builtin_amdgcn_global_load_lds((const unsigned*)((const char*)(gbase) + (voff)[_i]), (PG8_LAS unsigned*)(lds + (bufoff) + ldsw + _i * 8192), 16, 0, 0); } while (0)
#define PG8_LDA(dst, b, h) do { _Pragma("unroll") for (int m = 0; m < 4; ++m) _Pragma("unroll") for (int k = 0; k < 2; ++k) dst[m][k] = *(const PG8_LAS bf16x8*)(lds + PG8_SA(b, h) + aoff + m * 2048 + k * 1024); } while (0)
#define PG8_LDB(dst, b, h) do { _Pragma("unroll") for (int n = 0; n < 2; ++n) _Pragma("unroll") for (int k = 0; k < 2; ++k) dst[n][k] = *(const PG8_LAS bf16x8*)(lds + PG8_SB(b, h) + boff + n * 2048 + k * 1024); } while (0)
#define PG8_MMA(ai, bj, At, Bt) do { __builtin_amdgcn_s_setprio(1); _Pragma("unroll") for (int m = 0; m < 4; ++m) _Pragma("unroll") for (int n = 0; n < 2; ++n) _Pragma("unroll") for (int k = 0; k < 2; ++k) \
        acc[ai][bj][m][n] = __builtin_amdgcn_mfma_f32_16x16x32_bf16(Bt[n][k], At[m][k], acc[ai][bj][m][n], 0, 0, 0); __builtin_amdgcn_s_setprio(0); } while (0)
#define PG8_WAIT_V(n) asm volatile("s_waitcnt vmcnt(" #n ")" ::: "memory")
#define PG8_WAIT_L(n) asm volatile("s_waitcnt lgkmcnt(" #n ")" ::: "memory")
#define PG8_BAR __builtin_amdgcn_s_barrier()
#define PG8_SCHED __builtin_amdgcn_sched_barrier(0)
    Unit cur, nxt; int ui = 0;
    if (!S.next(0, cur)) return;
    f32x4 acc[2][2][4][2];
#pragma unroll
    for (int a = 0; a < 2; ++a)
#pragma unroll
        for (int b = 0; b < 2; ++b)
#pragma unroll
            for (int m = 0; m < 4; ++m)
#pragma unroll
                for (int n = 0; n < 2; ++n) acc[a][b][m][n] = (f32x4){0.f, 0.f, 0.f, 0.f};
    bf16x8 At[4][2], B0[2][2], B1[2][2];
    const char* cA = (const char*)g.A + (size_t)cur.pm * tstep; const char* cB = (const char*)g.Bt + (size_t)cur.pn * tstep;
    S.a_ready(cur);
    if constexpr (SP2) {
        PG8_STAGE(PG8_SB(0, 0), cB, voffB); PG8_STAGE(PG8_SB(0, 1), cB + hstep, voffB); PG8_STAGE(PG8_SA(0, 0), cA, voffA); PG8_STAGE(PG8_SA(0, 1), cA + hstep, voffA);
        if (wr == 1) PG8_BAR;
        PG8_WAIT_V(2); PG8_BAR;
        PG8_STAGE(PG8_SB(1, 0), cB + kstep, voffB); PG8_STAGE(PG8_SA(1, 0), cA + kstep, voffA); PG8_STAGE(PG8_SB(1, 1), cB + hstep + kstep, voffB);
        PG8_WAIT_V(6); PG8_BAR;
    } else {
        PG8_STAGE(PG8_SB(0, 0), cB, voffB); PG8_STAGE(PG8_SA(0, 0), cA, voffA); PG8_STAGE(PG8_SB(0, 1), cB + hstep, voffB); PG8_STAGE(PG8_SA(0, 1), cA + hstep, voffA);
        if (wr == 1) PG8_BAR;
        PG8_WAIT_V(4); PG8_BAR;
        PG8_STAGE(PG8_SB(1, 0), cB + kstep, voffB); PG8_STAGE(PG8_SA(1, 0), cA + kstep, voffA); PG8_STAGE(PG8_SB(1, 1), cB + hstep + kstep, voffB);
        PG8_WAIT_V(6); PG8_BAR;
    }
    for (;;) {
        const bool has_next = S.next(ui + 1, nxt);
        const char* nA = has_next ? (const char*)g.A + (size_t)nxt.pm * tstep : cA; const char* nB = has_next ? (const char*)g.Bt + (size_t)nxt.pn * tstep : cB;
        for (int t = 0; t < nt; t += 2) {
            const bool last = (t == nt - 2);
            const char* a1 = cA + (size_t)(t + 1) * kstep;
            const char* a2 = last ? nA : cA + (size_t)(t + 2) * kstep; const char* b2 = last ? nB : cB + (size_t)(t + 2) * kstep;
            const char* a3 = a2 + kstep; const char* b3 = b2 + kstep;
            if (last && has_next) S.a_ready(nxt);
            if constexpr (SP2) {
            PG8_LDB(B0, 0, 0); PG8_LDB(B1, 0, 1); PG8_SCHED; PG8_LDA(At, 0, 0); PG8_STAGE(PG8_SA(1, 1), a1 + hstep, voffA);
            PG8_WAIT_V(8); PG8_WAIT_L(0); PG8_BAR; PG8_MMA(0, 0, At, B0); PG8_MMA(0, 1, At, B1); PG8_BAR; PG8_SCHED;
            PG8_LDA(At, 0, 1); PG8_STAGE(PG8_SB(0, 0), b2, voffB); PG8_STAGE(PG8_SB(0, 1), b2 + hstep, voffB); PG8_STAGE(PG8_SA(0, 0), a2, voffA);
            PG8_WAIT_V(8); PG8_WAIT_L(0); PG8_BAR; PG8_MMA(1, 0, At, B0); PG8_MMA(1, 1, At, B1); PG8_BAR; PG8_SCHED;
            PG8_LDB(B0, 1, 0); PG8_LDB(B1, 1, 1); PG8_SCHED; PG8_LDA(At, 1, 0); PG8_STAGE(PG8_SA(0, 1), a2 + hstep, voffA);
            PG8_WAIT_V(8); PG8_WAIT_L(0); PG8_BAR; PG8_MMA(0, 0, At, B0); PG8_MMA(0, 1, At, B1); PG8_BAR; PG8_SCHED;
            PG8_LDA(At, 1, 1); PG8_STAGE(PG8_SB(1, 0), b3, voffB); PG8_STAGE(PG8_SB(1, 1), b3 + hstep, voffB); PG8_STAGE(PG8_SA(1, 0), a3, voffA);
            PG8_WAIT_V(8); PG8_WAIT_L(0); PG8_BAR; PG8_MMA(1, 0, At, B0); PG8_MMA(1, 1, At, B1); PG8_BAR; PG8_SCHED;
            } else {
            PG8_LDB(B0, 0, 0); PG8_SCHED; PG8_LDA(At, 0, 0); PG8_STAGE(PG8_SA(1, 1), a1 + hstep, voffA);
            PG8_WAIT_L(8); PG8_BAR; PG8_WAIT_L(0); PG8_MMA(0, 0, At, B0); PG8_BAR; PG8_SCHED;
            PG8_LDB(B1, 0, 1); PG8_STAGE(PG8_SB(0, 0), b2, voffB);
            PG8_BAR; PG8_WAIT_L(0); PG8_MMA(0, 1, At, B1); PG8_BAR;
            PG8_LDA(At, 0, 1); PG8_STAGE(PG8_SA(0, 0), a2, voffA);
            PG8_BAR; PG8_WAIT_L(0); PG8_MMA(1, 0, At, B0); PG8_BAR; PG8_SCHED;
            PG8_STAGE(PG8_SB(0, 1), b2 + hstep, voffB);
            PG8_WAIT_V(6); PG8_BAR; PG8_MMA(1, 1, At, B1); PG8_BAR;
            PG8_LDB(B0, 1, 0); PG8_SCHED; PG8_LDA(At, 1, 0); PG8_STAGE(PG8_SA(0, 1), a2 + hstep, voffA);
            PG8_WAIT_L(8); PG8_BAR; PG8_WAIT_L(0); PG8_MMA(0, 0, At, B0); PG8_BAR; PG8_SCHED;
            PG8_LDB(B1, 1, 1); PG8_STAGE(PG8_SB(1, 0), b3, voffB);
            PG8_BAR; PG8_WAIT_L(0); PG8_MMA(0, 1, At, B1); PG8_BAR;
            PG8_LDA(At, 1, 1); PG8_STAGE(PG8_SA(1, 0), a3, voffA);
            PG8_BAR; PG8_WAIT_L(0); PG8_MMA(1, 0, At, B0); PG8_BAR; PG8_SCHED;
            PG8_STAGE(PG8_SB(1, 1), b3 + hstep, voffB);
            PG8_WAIT_V(6); PG8_BAR; PG8_MMA(1, 1, At, B1); PG8_BAR;
            }
        }
        if constexpr (ALIGN_EPI) { if (wr == 0) PG8_BAR; }
        if constexpr (!Epi::AFTER_DRAIN) { E(acc, cur, wr, wc, fr, fq); S.done(cur); }
        if (!has_next) break;
#pragma unroll
        for (int a = 0; a < 2; ++a)
#pragma unroll
            for (int b = 0; b < 2; ++b)
#pragma unroll
                for (int m = 0; m < 4; ++m)
#pragma unroll
                    for (int n = 0; n < 2; ++n) acc[a][b][m][n] = (f32x4){0.f, 0.f, 0.f, 0.f};
        cur = nxt; cA = nA; cB = nB; ++ui;
        if constexpr (ALIGN_EPI) { if (wr == 1) PG8_BAR; }
    }
    PG8_WAIT_V(0);
    if constexpr (!ALIGN_EPI) { if (wr == 0) PG8_BAR; }
    PG8_BAR;
    if constexpr (Epi::AFTER_DRAIN) { E.fused(acc, cur, wr, wc, fr, fq, lds, wid, lane); S.done(cur); }
#undef PG8_SA
#undef PG8_SB
#undef PG8_STAGE
#undef PG8_LDA
#undef PG8_LDB
#undef PG8_MMA
#undef PG8_WAIT_V
#undef PG8_WAIT_L
#undef PG8_BAR
#undef PG8_SCHED
}
}

#define LAS __attribute__((address_space(3)))
typedef unsigned short bf16;
typedef float f32x4 __attribute__((ext_vector_type(4)));
typedef short bf16x8 __attribute__((ext_vector_type(8)));
typedef unsigned u32x4 __attribute__((ext_vector_type(4)));
typedef unsigned u32x2 __attribute__((ext_vector_type(2)));
#define LDS_WAIT() asm volatile("s_waitcnt lgkmcnt(0)" ::: "memory")
#define VM_WAIT() asm volatile("s_waitcnt vmcnt(0)" ::: "memory")

constexpr int MPR = 16384, MSA = 128, MT = MPR + MSA, DM = 1024, NIN = 3072, FF = 4096, DPLE = 256, SRCN = 3080;
constexpr float EPS = 1e-6f, QSCALE = 0.08838834764831845f;
constexpr int LDS_BYTES = 147456;
constexpr size_t MiB = 1u << 20;
constexpr size_t WS_RS0 = 0, WS_BETA = 128 * 1024, WS_G = 448 * 1024, WS_WSB = 1 * MiB, WS_SS1 = 2 * MiB, WS_SS2 = 3 * MiB + 256 * 1024, WS_SS3 = 4 * MiB + 512 * 1024;
constexpr size_t WS_WIN = 6 * MiB, WS_WOUT = 12 * MiB, WS_WUP = 14 * MiB, WS_WDN = 22 * MiB, WS_WG = 30 * MiB, WS_WPLE = 32 * MiB;
constexpr size_t WS_PB = 33 * MiB, WS_XB = 42 * MiB, WS_MIX = 75 * MiB, WS_PROJ = 108 * MiB, WS_HID = 108 * MiB, WS_AT = 205 * MiB, WS_O = 213 * MiB, WS_DECF = 246 * MiB, WS_XBUF = 247 * MiB, WS_CTL = 255 * MiB;
constexpr size_t CTL_BYTES = 32768;
constexpr size_t O_Y = 0, O_NCP = 16908288, O_NGP = 16945152, O_NCS = 17469440, O_NGS = 18059264, O_NSV = 26447872;
constexpr size_t FR_W = 0, FR_QG = 8 * MiB, FR_KG = 16 * MiB, FR_U = 24 * MiB;

__device__ __forceinline__ unsigned f2bf(float f) { unsigned u = __builtin_bit_cast(unsigned, f); return (u + 0x7fffu + ((u >> 16) & 1u)) >> 16; }
typedef float f32x2_t_ __attribute__((ext_vector_type(2))); typedef __bf16 bf16x2_t_ __attribute__((ext_vector_type(2)));
__device__ __forceinline__ unsigned pk2(float lo, float hi) { const f32x2_t_ v = {lo, hi}; const bf16x2_t_ b = __builtin_convertvector(v, bf16x2_t_); return __builtin_bit_cast(unsigned, b); }
__device__ __forceinline__ float bflo(unsigned u) { return __builtin_bit_cast(float, u << 16); }
__device__ __forceinline__ float bfhi(unsigned u) { return __builtin_bit_cast(float, u & 0xffff0000u); }
__device__ __forceinline__ float bf2f(bf16 v) { return __builtin_bit_cast(float, (unsigned)v << 16); }
__device__ __forceinline__ float sigmoidf_(float x) { return __builtin_amdgcn_rcpf(1.f + __expf(-x)); }
__device__ __forceinline__ float siluf_(float x) { return x * __builtin_amdgcn_rcpf(1.f + __expf(-x)); }
__device__ __forceinline__ float geluf_(float x) { const float u = 1.5957691216057308f * (x + 0.044715f * x * x * x); return x * __builtin_amdgcn_rcpf(1.f + __expf(-u)); }
template <int CTRL, int ROWMASK> __device__ __forceinline__ float dpp_get(float v) { return __builtin_bit_cast(float, __builtin_amdgcn_update_dpp(0, __builtin_bit_cast(int, v), CTRL, ROWMASK, 0xF, false)); }
__device__ __forceinline__ float wave_sum(float v) {
    v += dpp_get<0xB1, 0xF>(v); v += dpp_get<0x4E, 0xF>(v); v += dpp_get<0x141, 0xF>(v); v += dpp_get<0x140, 0xF>(v);
    v += dpp_get<0x142, 0xA>(v); v += dpp_get<0x143, 0xC>(v);
    return __builtin_bit_cast(float, __builtin_amdgcn_readlane(__builtin_bit_cast(int, v), 63));
}
__device__ __forceinline__ f32x4 mfma16(bf16x8 a, bf16x8 b, f32x4 c) { return __builtin_amdgcn_mfma_f32_16x16x32_bf16(a, b, c, 0, 0, 0); }
__device__ __forceinline__ bf16x8 pack8(f32x4 a, f32x4 b) { u32x4 w; w.x = pk2(a.x, a.y); w.y = pk2(a.z, a.w); w.z = pk2(b.x, b.y); w.w = pk2(b.z, b.w); return __builtin_bit_cast(bf16x8, w); }

struct Params { const float* in[24]; float* out; unsigned char* ws; };

template <class F> struct EpiGen {
    static constexpr bool PERM = false, AFTER_DRAIN = false;
    F f;
    __device__ __forceinline__ void operator()(const pg8::f32x4 (&acc)[2][2][4][2], const pg8::Unit& u, int wr, int wc, int fr, int fq) const {
#pragma unroll
        for (int ai = 0; ai < 2; ++ai)
#pragma unroll
            for (int m = 0; m < 4; ++m) {
                const int row = u.pm * 256 + ai * 128 + wr * 64 + m * 16 + fr;
                const float ctx = f.rowctx(row); float ss = 0.f;
#pragma unroll
                for (int bj = 0; bj < 2; ++bj)
#pragma unroll
                    for (int n = 0; n < 2; ++n) ss += f(row, u.pn * 256 + bj * 128 + wc * 32 + n * 16 + 4 * fq, acc[ai][bj][m][n], ctx);
                if (F::STATS) { ss += __shfl_xor(ss, 16); ss += __shfl_xor(ss, 32); if (fq == 0) f.ss[(size_t)row * 16 + u.pn * 4 + wc] = ss; }
            }
    }
};
template <class F> struct EpiGen8 {
    static constexpr bool PERM = true, AFTER_DRAIN = false;
    F f;
    __device__ __forceinline__ void operator()(const pg8::f32x4 (&acc)[2][2][4][2], const pg8::Unit& u, int wr, int wc, int fr, int fq) const {
#pragma unroll
        for (int ai = 0; ai < 2; ++ai)
#pragma unroll
            for (int m = 0; m < 4; ++m) {
                const int row = u.pm * 256 + ai * 128 + wr * 64 + m * 16 + fr; const float ctx = f.rowctx(row); float ss = 0.f;
#pragma unroll
                for (int bj = 0; bj < 2; ++bj) ss += f.op8(row, u.pn * 256 + bj * 128 + wc * 32 + 8 * fq, acc[ai][bj][m][0], acc[ai][bj][m][1], ctx);
                if (F::STATS) { ss += __shfl_xor(ss, 16); ss += __shfl_xor(ss, 32); if (fq == 0) f.ss[(size_t)row * 16 + u.pn * 4 + wc] = ss; }
            }
    }
};
__device__ __forceinline__ float sum16(const float* p) { const f32x4 a = *(const f32x4*)p, b = *(const f32x4*)(p + 4), c = *(const f32x4*)(p + 8), d = *(const f32x4*)(p + 12);
    return ((a.x + a.y) + (a.z + a.w)) + ((b.x + b.y) + (b.z + b.w)) + ((c.x + c.y) + (c.z + c.w)) + ((d.x + d.y) + (d.z + d.w)); }
__device__ __forceinline__ void st_bf4(bf16* p, f32x4 v) { u32x2 w; w.x = pk2(v.x, v.y); w.y = pk2(v.z, v.w); *(u32x2*)p = w; }
__device__ __forceinline__ float dot4(f32x4 v) { return (v.x * v.x + v.y * v.y) + (v.z * v.z + v.w * v.w); }

struct F1 { static constexpr bool STATS = false; float* ss; const float* rs0; bf16* proj;
    __device__ __forceinline__ float rowctx(int row) const { return rs0[row]; }
    __device__ __forceinline__ float operator()(int row, int col, f32x4 a, float rs) const { f32x4 v = a * rs;
        if (col >= 2048) { v.x = geluf_(v.x); v.y = geluf_(v.y); v.z = geluf_(v.z); v.w = geluf_(v.w); }
        st_bf4(proj + (size_t)row * NIN + col, v); return 0.f; }
    __device__ __forceinline__ float op8(int row, int col, f32x4 a0, f32x4 a1, float rs) const { f32x4 v0 = a0 * rs, v1 = a1 * rs;
        if (col >= 2048) { v0.x = geluf_(v0.x); v0.y = geluf_(v0.y); v0.z = geluf_(v0.z); v0.w = geluf_(v0.w); v1.x = geluf_(v1.x); v1.y = geluf_(v1.y); v1.z = geluf_(v1.z); v1.w = geluf_(v1.w); }
        u32x4 w; w.x = pk2(v0.x, v0.y); w.y = pk2(v0.z, v0.w); w.z = pk2(v1.x, v1.y); w.w = pk2(v1.z, v1.w); *(u32x4*)(proj + (size_t)row * NIN + col) = w; return 0.f; } };
struct F2 { static constexpr bool STATS = true; float* ss; bf16* xb;
    __device__ __forceinline__ float rowctx(int) const { return 0.f; }
    __device__ __forceinline__ float operator()(int row, int col, f32x4 a, float) const { bf16* p = xb + (size_t)row * DM + col; const u32x2 r = *(const u32x2*)p;
        const f32x4 x = (f32x4){bflo(r.x) + a.x, bfhi(r.x) + a.y, bflo(r.y) + a.z, bfhi(r.y) + a.w}; st_bf4(p, x); return dot4(x); }
    __device__ __forceinline__ float op8(int row, int col, f32x4 a0, f32x4 a1, float) const { bf16* p = xb + (size_t)row * DM + col; const u32x4 r = *(const u32x4*)p;
        const f32x4 x0 = (f32x4){bflo(r.x) + a0.x, bfhi(r.x) + a0.y, bflo(r.y) + a0.z, bfhi(r.y) + a0.w}, x1 = (f32x4){bflo(r.z) + a1.x, bfhi(r.z) + a1.y, bflo(r.w) + a1.z, bfhi(r.w) + a1.w};
        u32x4 w; w.x = pk2(x0.x, x0.y); w.y = pk2(x0.z, x0.w); w.z = pk2(x1.x, x1.y); w.w = pk2(x1.z, x1.w); *(u32x4*)p = w; return dot4(x0) + dot4(x1); } };
struct F3 { static constexpr bool STATS = false; float* ss; const float* ss1; bf16* hid;
    __device__ __forceinline__ float rowctx(int row) const { return rsqrtf(sum16(ss1 + (size_t)row * 16) * (1.f / DM) + EPS); }
    __device__ __forceinline__ float operator()(int row, int col, f32x4 a, float rs) const { f32x4 v = a * rs; v.x = fmaxf(v.x, 0.f); v.y = fmaxf(v.y, 0.f); v.z = fmaxf(v.z, 0.f); v.w = fmaxf(v.w, 0.f);
        st_bf4(hid + (size_t)row * FF + col, v * v); return 0.f; }
    __device__ __forceinline__ float op8(int row, int col, f32x4 a0, f32x4 a1, float rs) const { f32x4 v0 = a0 * rs, v1 = a1 * rs;
        v0.x = fmaxf(v0.x, 0.f); v0.y = fmaxf(v0.y, 0.f); v0.z = fmaxf(v0.z, 0.f); v0.w = fmaxf(v0.w, 0.f); v1.x = fmaxf(v1.x, 0.f); v1.y = fmaxf(v1.y, 0.f); v1.z = fmaxf(v1.z, 0.f); v1.w = fmaxf(v1.w, 0.f);
        v0 = v0 * v0; v1 = v1 * v1; u32x4 w; w.x = pk2(v0.x, v0.y); w.y = pk2(v0.z, v0.w); w.z = pk2(v1.x, v1.y); w.w = pk2(v1.z, v1.w); *(u32x4*)(hid + (size_t)row * FF + col) = w; return 0.f; } };
struct F4 { static constexpr bool STATS = true; float* ss; bf16* xb;
    __device__ __forceinline__ float rowctx(int) const { return 0.f; }
    __device__ __forceinline__ float operator()(int row, int col, f32x4 a, float) const { bf16* p = xb + (size_t)row * DM + col; const u32x2 r = *(const u32x2*)p;
        const f32x4 x = (f32x4){bflo(r.x) + a.x, bfhi(r.x) + a.y, bflo(r.y) + a.z, bfhi(r.y) + a.w}; st_bf4(p, x); return dot4(x); }
    __device__ __forceinline__ float op8(int row, int col, f32x4 a0, f32x4 a1, float) const { bf16* p = xb + (size_t)row * DM + col; const u32x4 r = *(const u32x4*)p;
        const f32x4 x0 = (f32x4){bflo(r.x) + a0.x, bfhi(r.x) + a0.y, bflo(r.y) + a0.z, bfhi(r.y) + a0.w}, x1 = (f32x4){bflo(r.z) + a1.x, bfhi(r.z) + a1.y, bflo(r.w) + a1.z, bfhi(r.w) + a1.w};
        u32x4 w; w.x = pk2(x0.x, x0.y); w.y = pk2(x0.z, x0.w); w.z = pk2(x1.x, x1.y); w.w = pk2(x1.z, x1.w); *(u32x4*)p = w; return dot4(x0) + dot4(x1); } };
struct F5a { static constexpr bool STATS = false; float* ss; bf16* pp;
    __device__ __forceinline__ float rowctx(int) const { return 0.f; }
    __device__ __forceinline__ float operator()(int row, int col, f32x4 a, float) const { st_bf4(pp + (size_t)row * DM + col, a); return 0.f; }
    __device__ __forceinline__ float op8(int row, int col, f32x4 a0, f32x4 a1, float) const { u32x4 w; w.x = pk2(a0.x, a0.y); w.y = pk2(a0.z, a0.w); w.z = pk2(a1.x, a1.y); w.w = pk2(a1.z, a1.w);
        *(u32x4*)(pp + (size_t)row * DM + col) = w; return 0.f; } };
struct F5b { static constexpr bool STATS = true; float* ss; const float* ss2; const bf16* xb; const bf16* pp; bf16* x3;
    __device__ __forceinline__ float rowctx(int row) const { return rsqrtf(sum16(ss2 + (size_t)row * 16) * (1.f / DM) + EPS); }
    __device__ __forceinline__ float operator()(int row, int col, f32x4 a, float rs) const { const size_t o = (size_t)row * DM + col; const u32x2 pr = *(const u32x2*)(pp + o), xr = *(const u32x2*)(xb + o);
        f32x4 x; x.x = bflo(xr.x) + bflo(pr.x) * sigmoidf_(a.x * rs); x.y = bfhi(xr.x) + bfhi(pr.x) * sigmoidf_(a.y * rs); x.z = bflo(xr.y) + bflo(pr.y) * sigmoidf_(a.z * rs); x.w = bfhi(xr.y) + bfhi(pr.y) * sigmoidf_(a.w * rs);
        st_bf4(x3 + o, x); return dot4(x); } };

struct EpiFinal {
    static constexpr bool PERM = true, AFTER_DRAIN = true;
    const float* ss2; const bf16* xb; const bf16* pp; float* out; const float* gfin; unsigned* xbuf; unsigned* cnt;
    __device__ __forceinline__ void fused(pg8::f32x4 (&acc)[2][2][4][2], const pg8::Unit& u, int wr, int wc, int fr, int fq, LAS unsigned char* lds, int wid, int lane) const {
        LAS float* Pt = (LAS float*)lds; LAS float* St = (LAS float*)(lds + 4096);
#pragma unroll
        for (int ai = 0; ai < 2; ++ai)
#pragma unroll
            for (int m = 0; m < 4; ++m) {
                const int row_l = ai * 128 + wr * 64 + m * 16 + fr; const size_t row = (size_t)u.pm * 256 + row_l;
                const float rs = rsqrtf(sum16(ss2 + row * 16) * (1.f / DM) + EPS); float ss = 0.f;
#pragma unroll
                for (int bj = 0; bj < 2; ++bj) { const size_t o = row * DM + u.pn * 256 + bj * 128 + wc * 32 + 8 * fq; const u32x4 pr = *(const u32x4*)(pp + o), xr = *(const u32x4*)(xb + o);
                    const f32x4 a0 = acc[ai][bj][m][0], a1 = acc[ai][bj][m][1]; f32x4 x0, x1;
                    x0.x = bflo(xr.x) + bflo(pr.x) * sigmoidf_(a0.x * rs); x0.y = bfhi(xr.x) + bfhi(pr.x) * sigmoidf_(a0.y * rs); x0.z = bflo(xr.y) + bflo(pr.y) * sigmoidf_(a0.z * rs); x0.w = bfhi(xr.y) + bfhi(pr.y) * sigmoidf_(a0.w * rs);
                    x1.x = bflo(xr.z) + bflo(pr.z) * sigmoidf_(a1.x * rs); x1.y = bfhi(xr.z) + bfhi(pr.z) * sigmoidf_(a1.y * rs); x1.z = bflo(xr.w) + bflo(pr.w) * sigmoidf_(a1.z * rs); x1.w = bfhi(xr.w) + bfhi(pr.w) * sigmoidf_(a1.w * rs);
                    acc[ai][bj][m][0] = x0; acc[ai][bj][m][1] = x1; ss += dot4(x0) + dot4(x1); }
                ss += __shfl_xor(ss, 16); ss += __shfl_xor(ss, 32);
                if (fq == 0) Pt[row_l * 4 + wc] = ss;
            }
        asm volatile("s_waitcnt lgkmcnt(0)" ::: "memory"); __builtin_amdgcn_s_barrier(); asm volatile("" ::: "memory");
        const int rl = wid * 32 + (lane & 31);
        if (lane < 32) { const f32x4 p4 = *(const LAS f32x4*)(Pt + rl * 4); const float tot = (p4.x + p4.y) + (p4.z + p4.w);
            __hip_atomic_store(xbuf + ((size_t)u.pm * 256 + rl) * 4 + u.pn, __builtin_bit_cast(unsigned, tot), __ATOMIC_RELAXED, __HIP_MEMORY_SCOPE_AGENT); }
        asm volatile("s_waitcnt vmcnt(0)" ::: "memory");
        if (lane == 0) __hip_atomic_fetch_add(cnt + 64 * u.pm, 1u, __ATOMIC_RELAXED, __HIP_MEMORY_SCOPE_AGENT);
        if (wid == 0) {
            unsigned sp = 0;
            while ((unsigned)__builtin_amdgcn_readfirstlane(__hip_atomic_load(cnt + 64 * u.pm, __ATOMIC_RELAXED, __HIP_MEMORY_SCOPE_AGENT)) < 32u) { __builtin_amdgcn_s_sleep(2); if (++sp > (1u << 22)) break; }
            __builtin_amdgcn_fence(__ATOMIC_ACQUIRE, "agent");
        }
        asm volatile("s_waitcnt vmcnt(0) lgkmcnt(0)" ::: "memory"); __builtin_amdgcn_s_barrier(); asm volatile("" ::: "memory");
        if (lane < 32) { float t = 0.f;
#pragma unroll
            for (int k = 0; k < 4; ++k) t += __builtin_bit_cast(float, __hip_atomic_load(xbuf + ((size_t)u.pm * 256 + rl) * 4 + k, __ATOMIC_RELAXED, __HIP_MEMORY_SCOPE_AGENT));
            St[rl] = rsqrtf(t * (1.f / DM) + EPS); }
        asm volatile("s_waitcnt lgkmcnt(0)" ::: "memory"); __builtin_amdgcn_s_barrier(); asm volatile("" ::: "memory");
#pragma unroll
        for (int ai = 0; ai < 2; ++ai)
#pragma unroll
            for (int m = 0; m < 4; ++m) {
                const int row_l = ai * 128 + wr * 64 + m * 16 + fr; const size_t row = (size_t)u.pm * 256 + row_l; const float r = St[row_l];
#pragma unroll
                for (int bj = 0; bj < 2; ++bj)
#pragma unroll
                    for (int n = 0; n < 2; ++n) { const int col = u.pn * 256 + bj * 128 + wc * 32 + 8 * fq + 4 * n;
                        *(f32x4*)(out + row * DM + col) = acc[ai][bj][m][n] * r * *(const f32x4*)(gfin + col); }
            }
    }
};

template <int RT, int UNR, class F> __device__ __forceinline__ void small_gemm(const bf16* A, const bf16* Bt, int N, int K, const F& f, LAS unsigned char* lds, int bid, int G, int wave, int lane) {
    const int c = lane & 15, q = lane >> 4; constexpr int NMH = 8 / RT; const int ntask = NMH * (N >> 6); const int kw = K >> 3;
    LAS f32x4* red = (LAS f32x4*)lds;
    for (int t = bid; t < ntask; t += G) {
        const int mh = t % NMH, ns = t / NMH;
        const bf16* ap = A + (size_t)(mh * RT * 16 + c) * K + wave * kw + 8 * q;
        const bf16* bp = Bt + (size_t)(ns * 64 + c) * K + wave * kw + 8 * q;
        f32x4 acc[RT][4];
#pragma unroll
        for (int i = 0; i < RT; ++i)
#pragma unroll
            for (int j = 0; j < 4; ++j) acc[i][j] = (f32x4){0.f, 0.f, 0.f, 0.f};
#pragma unroll UNR
        for (int k = 0; k < kw; k += 32) {
            bf16x8 a[RT], b[4];
#pragma unroll
            for (int i = 0; i < RT; ++i) a[i] = *(const bf16x8*)(ap + (size_t)i * 16 * K + k);
#pragma unroll
            for (int j = 0; j < 4; ++j) b[j] = *(const bf16x8*)(bp + (size_t)j * 16 * K + k);
#pragma unroll
            for (int i = 0; i < RT; ++i)
#pragma unroll
                for (int j = 0; j < 4; ++j) acc[i][j] = mfma16(b[j], a[i], acc[i][j]);
        }
#pragma unroll
        for (int i = 0; i < RT; ++i)
#pragma unroll
            for (int j = 0; j < 4; ++j) red[(wave * (RT * 4) + i * 4 + j) * 64 + lane] = acc[i][j];
        __syncthreads();
        if (wave < RT) {
            const int i = wave; const int row = MPR + mh * RT * 16 + i * 16 + c; const float ctx = f.rowctx(row); float ss = 0.f;
#pragma unroll
            for (int j = 0; j < 4; ++j) { f32x4 s = red[(i * 4 + j) * 64 + lane];
#pragma unroll
                for (int w = 1; w < 8; ++w) s += red[(w * (RT * 4) + i * 4 + j) * 64 + lane];
                ss += f(row, ns * 64 + j * 16 + 4 * q, s, ctx); }
            if (F::STATS) { ss += __shfl_xor(ss, 16); ss += __shfl_xor(ss, 32); if (q == 0) f.ss[(size_t)row * 16 + ns] = ss; }
        }
        __syncthreads();
    }
}

__device__ __forceinline__ void tr_item(const float* __restrict__ W, int N, int src_c0, bf16* WT, int K, int dst_r0, const float* __restrict__ gain, LAS float* scr, int k0, int lane) {
    const float gv = gain ? gain[k0 + lane] : 1.f;
    f32x4 wv[8];
#pragma unroll
    for (int i = 0; i < 8; ++i) wv[i] = *(const f32x4*)(W + (size_t)(k0 + 8 * i + (lane >> 3)) * N + src_c0 + 4 * (lane & 7));
#pragma unroll
    for (int i = 0; i < 8; ++i) {
        float g = 0.f;
#pragma unroll
        for (int r = 0; r < 8; ++r) { const float gr = __builtin_bit_cast(float, __builtin_amdgcn_readlane(__builtin_bit_cast(int, gv), 8 * i + r)); g = ((lane >> 3) == r) ? gr : g; }
        LAS float* d = scr + (8 * i + (lane >> 3)) * 33 + 4 * (lane & 7);
        d[0] = wv[i].x * g; d[1] = wv[i].y * g; d[2] = wv[i].z * g; d[3] = wv[i].w * g;
    }
    LDS_WAIT();
    const int c = lane & 7;
#pragma unroll
    for (int j = 0; j < 4; ++j) { const int n = (lane >> 3) + 8 * j; const LAS float* s = scr + (8 * c) * 33 + n;
        u32x4 o; o.x = pk2(s[0], s[33]); o.y = pk2(s[66], s[99]); o.z = pk2(s[132], s[165]); o.w = pk2(s[198], s[231]);
        *(u32x4*)(WT + (size_t)(dst_r0 + n) * K + k0 + 8 * c) = o; }
    LDS_WAIT();
}

__device__ __forceinline__ void weight_items(const Params& P, LAS float* scr, int lane, int first, int last, int start, int stride) {
    unsigned char* ws = P.ws; const float* w_in = P.in[7]; const float* g_mix = P.in[6];
    for (int it = first + start; it < last; it += stride) {
        int r = it;
        if (r < 1536) { const int nb = r >> 4, kb = r & 15; tr_item(w_in, SRCN, nb * 32 + (nb >= 64 ? 8 : 0), (bf16*)(ws + WS_WIN), 1024, nb * 32, g_mix, scr, kb * 64, lane); continue; } r -= 1536;
        if (r < 512) { const int nb = r >> 4, kb = r & 15; tr_item(P.in[16], 1024, nb * 32, (bf16*)(ws + WS_WOUT), 1024, nb * 32, nullptr, scr, kb * 64, lane); continue; } r -= 512;
        if (r < 2048) { const int nb = r >> 4, kb = r & 15; tr_item(P.in[18], 4096, nb * 32, (bf16*)(ws + WS_WUP), 1024, nb * 32, P.in[17], scr, kb * 64, lane); continue; } r -= 2048;
        if (r < 2048) { const int nb = r >> 6, kb = r & 63; tr_item(P.in[19], 1024, nb * 32, (bf16*)(ws + WS_WDN), 4096, nb * 32, nullptr, scr, kb * 64, lane); continue; } r -= 2048;
        if (r < 512) { const int nb = r >> 4, kb = r & 15; tr_item(P.in[22], 1024, nb * 32, (bf16*)(ws + WS_WG), 1024, nb * 32, P.in[20], scr, kb * 64, lane); continue; } r -= 512;
        { const int nb = r >> 2, kb = r & 3; tr_item(P.in[21], 1024, nb * 32, (bf16*)(ws + WS_WPLE), 256, nb * 32, nullptr, scr, kb * 64, lane); }
    }
}

__device__ __forceinline__ void phase0(const Params& P, LAS unsigned char* lds, int tid, int lane, int wave, int bid, int G) {
    unsigned char* ws = P.ws; const int gw = bid * 8 + wave, NGW = G * 8, gt = bid * 512 + tid, NGT = G * 512;
    const float* w_in = P.in[7]; const float* g_mix = P.in[6];
    LAS f32x4* W8 = (LAS f32x4*)(lds + 67584);
    for (int idx = tid; idx < 2048; idx += 512) {
        const int l = idx & 63, half = (idx >> 6) & 1, je = idx >> 7; const int k = 256 * (je >> 2) + 4 * l + (je & 3);
        const float g = g_mix[k]; const float* s = w_in + (size_t)k * SRCN + 2048 + 4 * half;
        W8[idx] = (f32x4){s[0] * g, s[1] * g, s[2] * g, s[3] * g};
    }
    { const float* w_s = P.in[14]; bf16* WSB = (bf16*)(ws + WS_WSB);
      for (int i = gt; i < 65536; i += NGT) { const int t = (i >> 7) & 127, s = i & 127; WSB[i] = (bf16)f2bf(s <= t ? w_s[i] : 0.f); } }
    { bf16* PB = (bf16*)(ws + WS_PB); const float* pp = P.in[4]; const float* ps = P.in[5];
      for (int i = gt; i < MT * 32; i += NGT) { const int row = i >> 5, c8 = i & 31; const float* src = row < MPR ? pp + (size_t)row * DPLE + c8 * 8 : ps + (size_t)(row - MPR) * DPLE + c8 * 8;
          const f32x4 a = *(const f32x4*)src, b = *(const f32x4*)(src + 4); u32x4 o; o.x = pk2(a.x, a.y); o.y = pk2(a.z, a.w); o.z = pk2(b.x, b.y); o.w = pk2(b.z, b.w); *(u32x4*)(PB + (size_t)i * 8) = o; } }
    weight_items(P, (LAS float*)(lds + wave * 8448), lane, 0, 1536, gw, NGW);
    __syncthreads();
    float* RS0 = (float*)(ws + WS_RS0); float* BETA = (float*)(ws + WS_BETA); float* GG = (float*)(ws + WS_G); bf16* XB = (bf16*)(ws + WS_XB);
    const float* a_log = P.in[9]; const float* dt_bias = P.in[10];
    f32x4 vnx[4];
    { const int row = gw < MT ? gw : MT - 1; const float* xr = row < MPR ? P.in[0] + (size_t)row * DM : P.in[1] + (size_t)(row - MPR) * DM;
#pragma unroll
      for (int j = 0; j < 4; ++j) vnx[j] = *(const f32x4*)(xr + 256 * j + 4 * lane); }
    for (int row = gw; row < MT; row += NGW) {
        f32x4 v[4]; float ss = 0.f;
#pragma unroll
        for (int j = 0; j < 4; ++j) { v[j] = vnx[j]; ss += dot4(v[j]); }
        { const int rn = (row + NGW < MT) ? row + NGW : row; const float* xr = rn < MPR ? P.in[0] + (size_t)rn * DM : P.in[1] + (size_t)(rn - MPR) * DM;
#pragma unroll
          for (int j = 0; j < 4; ++j) vnx[j] = *(const f32x4*)(xr + 256 * j + 4 * lane); }
#pragma unroll
        for (int j = 0; j < 4; ++j) st_bf4(XB + (size_t)row * DM + 256 * j + 4 * lane, v[j]);
        f32x4 d0 = (f32x4){0.f, 0.f, 0.f, 0.f}, d1 = d0;
#pragma unroll
        for (int j = 0; j < 4; ++j)
#pragma unroll
            for (int e = 0; e < 4; ++e) { const float xv = v[j][e]; d0 += W8[((j * 4 + e) * 2 + 0) * 64 + lane] * xv; d1 += W8[((j * 4 + e) * 2 + 1) * 64 + lane] * xv; }
        const bool b0 = lane & 1, b1 = lane & 2, b2 = lane & 4;
        float t0 = (b0 ? d1.x : d0.x) + __shfl_xor(b0 ? d0.x : d1.x, 1), t1 = (b0 ? d1.y : d0.y) + __shfl_xor(b0 ? d0.y : d1.y, 1);
        float t2 = (b0 ? d1.z : d0.z) + __shfl_xor(b0 ? d0.z : d1.z, 1), t3 = (b0 ? d1.w : d0.w) + __shfl_xor(b0 ? d0.w : d1.w, 1);
        float u0 = (b1 ? t2 : t0) + __shfl_xor(b1 ? t0 : t2, 2), u1 = (b1 ? t3 : t1) + __shfl_xor(b1 ? t1 : t3, 2);
        float w = (b2 ? u1 : u0) + __shfl_xor(b2 ? u0 : u1, 4);
        w += __shfl_xor(w, 8); w += __shfl_xor(w, 16); w += __shfl_xor(w, 32);
        ss = wave_sum(ss); const float rs = rsqrtf(ss * (1.f / DM) + EPS);
        if (lane < 8) { const int hh = 2 * ((lane >> 1) & 1) + ((lane >> 2) & 1);
            if (!(lane & 1)) BETA[(size_t)row * 4 + hh] = sigmoidf_(w * rs);
            else { const float xa = w * rs + dt_bias[hh]; const float sp = fmaxf(xa, 0.f) + log1pf(expf(-fabsf(xa))); GG[(size_t)row * 4 + hh] = -expf(a_log[hh]) * sp; } }
        if (lane == 0) RS0[row] = rs;
    }
}

__device__ __forceinline__ void gdn_prep(const Params& P, LAS unsigned char* lds, int tid, int lane, int wave, int bid, int G) {
    unsigned char* ws = P.ws; const bf16* PROJ = (const bf16*)(ws + WS_PROJ); const float* BETA = (const float*)(ws + WS_BETA); const float* GG = (const float*)(ws + WS_G);
    bf16* FRB = (bf16*)P.out; bf16* ATf = (bf16*)(ws + WS_AT); float* DECF = (float*)(ws + WS_DECF); const float* wconv = P.in[8];
    const int tid0 = tid;
    for (int u0 = bid * 2; u0 < 1024; u0 += G * 2) {
        int tid = tid0; asm volatile("" : "+v"(tid));
        const int lane = tid & 63, wv = __builtin_amdgcn_readfirstlane(tid >> 6), hb = wv >> 2, t = tid & 255, w4 = wv & 3, c = lane & 15, q = lane >> 4;
        LAS unsigned char* base = lds + hb * 70656;
        LAS bf16* q_l = (LAS bf16*)base; LAS bf16* k_l = (LAS bf16*)(base + 17408); LAS bf16* v_l = (LAS bf16*)(base + 34816);
        LAS float* A_l = (LAS float*)(base + 52224); LAS float* gc = (LAS float*)(base + 69632); LAS float* bt = gc + 64;
        const int unit = u0 + hb, cg = unit >> 2, h = unit & 3, n = cg & 31; const int row0 = cg * 64, tokb = 16 * w4;
        float y[3][16][2];
#pragma unroll
        for (int g3 = 0; g3 < 3; ++g3) {
            const int col = g3 * 512 + h * 128 + 2 * lane;
            const float w0a = wconv[col], w0b = wconv[col + 1], w1a = wconv[1536 + col], w1b = wconv[1536 + col + 1], w2a = wconv[3072 + col], w2b = wconv[3072 + col + 1], w3a = wconv[4608 + col], w3b = wconv[4608 + col + 1];
            const bf16* src = PROJ + (size_t)(row0 + tokb) * NIN + col;
            unsigned raw[19];
            const bool nohist = (n == 0 && w4 == 0);
#pragma unroll
            for (int i = 0; i < 19; ++i) raw[i] = (i < 3 && nohist) ? 0u : *(const unsigned*)(src + (ptrdiff_t)(i - 3) * NIN);
            typedef float f32x2c __attribute__((ext_vector_type(2)));
            const f32x2c w0 = (f32x2c){w0a, w0b}, w1 = (f32x2c){w1a, w1b}, w2 = (f32x2c){w2a, w2b}, w3 = (f32x2c){w3a, w3b};
            f32x2c xr2[19];
#pragma unroll
            for (int i = 0; i < 19; ++i) xr2[i] = (f32x2c){bflo(raw[i]), bfhi(raw[i])};
#pragma unroll
            for (int i = 0; i < 16; ++i) { const f32x2c yy = w0 * xr2[i] + w1 * xr2[i + 1] + w2 * xr2[i + 2] + w3 * xr2[i + 3];
                y[g3][i][0] = siluf_(yy.x); y[g3][i][1] = siluf_(yy.y); }
        }
#pragma unroll
        for (int g3 = 0; g3 < 2; ++g3)
#pragma unroll
            for (int i = 0; i < 16; ++i) { const float s = wave_sum(y[g3][i][0] * y[g3][i][0] + y[g3][i][1] * y[g3][i][1]); const float r = rsqrtf(s + 1e-6f); y[g3][i][0] *= r; y[g3][i][1] *= r; }
#pragma unroll
        for (int i = 0; i < 16; ++i) {
            *(LAS unsigned*)(q_l + (tokb + i) * 136 + 2 * lane) = pk2(y[0][i][0], y[0][i][1]);
            *(LAS unsigned*)(k_l + (tokb + i) * 136 + 2 * lane) = pk2(y[1][i][0], y[1][i][1]);
            *(LAS unsigned*)(v_l + (tokb + i) * 136 + 2 * lane) = pk2(y[2][i][0], y[2][i][1]);
        }
        if (w4 == 0) {
            int lane = tid; asm volatile("" : "+v"(lane)); lane &= 63;
            float g = GG[(size_t)(row0 + lane) * 4 + h];
#pragma unroll
            for (int o = 1; o < 64; o <<= 1) { const float tt = __shfl_up(g, o); if (lane >= o) g += tt; }
            const float btv = BETA[(size_t)(row0 + lane) * 4 + h]; gc[lane] = g; bt[lane] = btv; gc[128 + lane] = btv * __expf(g); gc[192 + lane] = __expf(__shfl(g, 63) - g);
            const float dl = __expf(__shfl(g, 63));
            *(f32x4*)(DECF + (size_t)unit * 256 + lane * 4) = (f32x4){dl, dl, dl, dl};
        }
        __syncthreads();
        {
            const int it = w4; bf16x8 qf[4], kif[4];
#pragma unroll
            for (int kd = 0; kd < 4; ++kd) { qf[kd] = *(const LAS bf16x8*)(q_l + (16 * it + c) * 136 + 32 * kd + 8 * q); kif[kd] = *(const LAS bf16x8*)(k_l + (16 * it + c) * 136 + 32 * kd + 8 * q); }
            const int ii = 16 * it + c; const float gci = gc[ii];
            float atv[2][8];
#pragma unroll
            for (int jt = 0; jt < 4; ++jt) {
                if (jt <= it) {
                    f32x4 aq = (f32x4){0.f, 0.f, 0.f, 0.f}, ak = aq;
#pragma unroll
                    for (int kd = 0; kd < 4; ++kd) { const bf16x8 kjf = *(const LAS bf16x8*)(k_l + (16 * jt + c) * 136 + 32 * kd + 8 * q); aq = mfma16(kjf, qf[kd], aq); ak = mfma16(kif[kd], kjf, ak); }
                    const f32x4 gj = *(const LAS f32x4*)(gc + 16 * jt + 4 * q); f32x4 av;
                    const f32x4 gi4 = *(const LAS f32x4*)(gc + 16 * it + 4 * q), bi4 = *(const LAS f32x4*)(bt + 16 * it + 4 * q); const float gcj = gc[16 * jt + c];
#pragma unroll
                    for (int r = 0; r < 4; ++r) { const int j = 16 * jt + 4 * q + r; const float dec = (j <= ii) ? __expf(gci - gj[r]) : 0.f;
                        atv[jt >> 1][(jt & 1) * 4 + r] = aq[r] * dec * QSCALE;
                        const int i2 = 16 * it + 4 * q + r, j2 = 16 * jt + c; av[r] = (j2 < i2) ? ak[r] * bi4[r] * __expf(gi4[r] - gcj) : 0.f; }
                    *(LAS f32x4*)(A_l + (16 * jt + c) * 68 + 16 * it + 4 * q) = av;
                } else {
#pragma unroll
                    for (int r = 0; r < 4; ++r) atv[jt >> 1][(jt & 1) * 4 + r] = 0.f;
                }
            }
#pragma unroll
            for (int ks = 0; ks < 2; ++ks) { u32x4 o; o.x = pk2(atv[ks][0], atv[ks][1]); o.y = pk2(atv[ks][2], atv[ks][3]); o.z = pk2(atv[ks][4], atv[ks][5]); o.w = pk2(atv[ks][6], atv[ks][7]);
                *(u32x4*)(ATf + ((size_t)unit * 8 + it * 2 + ks) * 512 + lane * 8) = o; }
        }
        {
            const float gl = gc[63];
#pragma unroll
            for (int e = 0; e < 4; ++e) {
                const int f = w4 + 4 * e;
                { const int mt = f >> 2, ks = f & 3, tok = 16 * mt + c; const float sc = __expf(gc[tok]) * QSCALE;
                  const u32x2 lo = *(const LAS u32x2*)(q_l + tok * 136 + 32 * ks + 4 * q), hi = *(const LAS u32x2*)(q_l + tok * 136 + 32 * ks + 16 + 4 * q);
                  u32x4 o; o.x = pk2(bflo(lo.x) * sc, bfhi(lo.x) * sc); o.y = pk2(bflo(lo.y) * sc, bfhi(lo.y) * sc); o.z = pk2(bflo(hi.x) * sc, bfhi(hi.x) * sc); o.w = pk2(bflo(hi.y) * sc, bfhi(hi.y) * sc);
                  *(u32x4*)(FRB + FR_QG + (size_t)unit * 8192 + f * 512 + lane * 8) = o; }
                { const int mt = f >> 1, ks2 = f & 1; float kv[8];
#pragma unroll
                  for (int jj = 0; jj < 8; ++jj) { const int tok = 32 * ks2 + 16 * (jj >> 2) + 4 * q + (jj & 3); kv[jj] = bf2f(k_l[tok * 136 + 16 * mt + c]) * gc[192 + tok]; }
                  u32x4 o; o.x = pk2(kv[0], kv[1]); o.y = pk2(kv[2], kv[3]); o.z = pk2(kv[4], kv[5]); o.w = pk2(kv[6], kv[7]);
                  *(u32x4*)(FRB + FR_KG + (size_t)unit * 8192 + f * 512 + lane * 8) = o; }
            }
        }
        int t5 = t; asm volatile("" : "+v"(t5));
        const int col = t5 & 127, kind = __builtin_amdgcn_readfirstlane(t5 >> 7);
        typedef float f32x2s __attribute__((ext_vector_type(2)));
        f32x2s sp[32];
        {
            const LAS bf16* srcl = kind ? k_l : v_l;
#pragma unroll
            for (int i = 0; i < 64; ++i) { const float m = (kind ? gc + 128 : bt)[i]; sp[i >> 1][i & 1] = bf2f(srcl[i * 136 + col]) * m; }
        }
        __syncthreads();
        {
#pragma clang loop unroll(full)
            for (int j = 0; j < 63; ++j) {
                f32x4 avc[16];
#pragma unroll
                for (int v = (j + 1) >> 2; v < 16; ++v) avc[v] = *(const LAS f32x4*)(A_l + j * 68 + 4 * v);
                __builtin_amdgcn_sched_barrier(0);
                const float sj = sp[j >> 1][j & 1]; const f32x2s sj2 = (f32x2s){sj, sj};
#pragma unroll
                for (int v = (j + 1) >> 2; v < 16; ++v) { const f32x4 a = avc[v];
                    sp[2 * v] -= (f32x2s){a.x, a.y} * sj2; sp[2 * v + 1] -= (f32x2s){a.z, a.w} * sj2; }
                __builtin_amdgcn_sched_barrier(0);
            }
        }
        {
            LAS bf16* dstl = kind ? k_l : v_l;
#pragma unroll
            for (int i = 0; i < 64; ++i) dstl[i * 136 + col] = (bf16)f2bf(sp[i >> 1][i & 1]);
        }
        __syncthreads();
        { int l7 = tid; asm volatile("" : "+v"(l7)); const int c = l7 & 15, q = (l7 >> 4) & 3, lane = l7 & 63;
#pragma unroll
        for (int e = 0; e < 4; ++e) { const int f = w4 + 4 * e, mt = f >> 2, ks = f & 3, tok = 16 * mt + c;
            const u32x2 lo = *(const LAS u32x2*)(k_l + tok * 136 + 32 * ks + 4 * q), hi = *(const LAS u32x2*)(k_l + tok * 136 + 32 * ks + 16 + 4 * q);
            *(u32x4*)(FRB + FR_W + (size_t)unit * 8192 + f * 512 + lane * 8) = (u32x4){lo.x, lo.y, hi.x, hi.y}; }
#pragma unroll
        for (int e = 0; e < 8; ++e) { const int f = w4 + 4 * e, sl = f >> 2, mt = f & 3; const LAS bf16* s = v_l + (16 * mt + 4 * q) * 136 + 16 * sl + c;
            u32x2 o; o.x = (unsigned)s[0] | ((unsigned)s[136] << 16); o.y = (unsigned)s[272] | ((unsigned)s[408] << 16);
            *(u32x2*)(FRB + FR_U + ((size_t)unit * 32 + f) * 256 + lane * 4) = o; }
        }
        __syncthreads();
    }
}

__device__ __forceinline__ void sgu_prompt(const Params& P, LAS unsigned char* lds, int tid, int lane, int wave, int bid, int G) {
    asm volatile("" : "+v"(tid)); lane = tid & 63;
    unsigned char* ws = P.ws; const bf16* PROJ = (const bf16*)(ws + WS_PROJ); bf16* MIX = (bf16*)(ws + WS_MIX); const bf16* WSB = (const bf16*)(ws + WS_WSB);
    const float* lng = P.in[12]; const float* lnb = P.in[13]; const float* b_s = P.in[15];
    LAS bf16* vgT = (LAS bf16*)lds; const int c = lane & 15, q = lane >> 4;
    float lg[8], lb[8];
#pragma unroll
    for (int e = 0; e < 8; ++e) { lg[e] = lng[8 * lane + e]; lb[e] = lnb[8 * lane + e]; }
    for (int su = bid; su < 256; su += G) {
        const int b = su >> 5, n = (su >> 1) & 15, hp = su & 1; const int row0 = b * 2048 + n * 128;
        u32x4 rawv[16];
#pragma unroll
        for (int i = 0; i < 16; ++i) rawv[i] = *(const u32x4*)(PROJ + (size_t)(row0 + 16 * wave + i) * NIN + 2560 + 8 * lane);
        unsigned pkv[8][8];
#pragma unroll
        for (int i2 = 0; i2 < 8; ++i2) {
            float xa[8], xb2[8];
#pragma unroll
            for (int hh = 0; hh < 2; ++hh) {
                const u32x4 raw = rawv[2 * i2 + hh];
                float x[8] = {bflo(raw.x), bfhi(raw.x), bflo(raw.y), bfhi(raw.y), bflo(raw.z), bfhi(raw.z), bflo(raw.w), bfhi(raw.w)};
                float s = 0.f;
#pragma unroll
                for (int e = 0; e < 8; ++e) s += x[e];
                const float mean = wave_sum(s) * (1.f / 512.f); float s2 = 0.f;
#pragma unroll
                for (int e = 0; e < 8; ++e) { x[e] -= mean; s2 += x[e] * x[e]; }
                const float rstd = rsqrtf(wave_sum(s2) * (1.f / 512.f) + EPS);
#pragma unroll
                for (int e = 0; e < 8; ++e) { const float vn_ = x[e] * rstd * lg[e] + lb[e]; if (hh == 0) xa[e] = vn_; else xb2[e] = vn_; }
            }
#pragma unroll
            for (int e = 0; e < 8; ++e) pkv[e][i2] = pk2(xa[e], xb2[e]);
        }
        if ((q >> 1) == hp) {
#pragma unroll
            for (int e = 0; e < 8; ++e) {
                LAS bf16* rowp = vgT + (q & 1) * 17408 + (8 * c + e) * 136;
                *(LAS u32x4*)(rowp + 8 * ((2 * wave) ^ c)) = (u32x4){pkv[e][0], pkv[e][1], pkv[e][2], pkv[e][3]};
                *(LAS u32x4*)(rowp + 8 * ((2 * wave + 1) ^ c)) = (u32x4){pkv[e][4], pkv[e][5], pkv[e][6], pkv[e][7]};
            }
        }
        __syncthreads();
#pragma unroll 1
        for (int hh = 0; hh < 2; ++hh) { const int h = 2 * hp + hh; const LAS bf16* vgh = vgT + hh * 17408;
        f32x4 acc[8]; u32x2 upre[8]; const float bias_pre = b_s[h * 128 + 16 * wave + c];
#pragma unroll
        for (int nt = 0; nt < 8; ++nt) { acc[nt] = (f32x4){0.f, 0.f, 0.f, 0.f}; upre[nt] = *(const u32x2*)(PROJ + ((size_t)row0 + 16 * wave + c) * NIN + 2048 + h * 128 + 16 * nt + 4 * q); }
        for (int ks = 0; ks <= (wave >> 1); ++ks) {
            const bf16x8 bfr = *(const bf16x8*)(WSB + (size_t)(h * 128 + 16 * wave + c) * 128 + 32 * ks + 8 * q);
#pragma unroll
            for (int nt = 0; nt < 8; ++nt) { const int d = 16 * nt + c; const bf16x8 afr = *(const LAS bf16x8*)(vgh + d * 136 + 8 * ((4 * ks + q) ^ ((d >> 3) & 15))); acc[nt] = mfma16(afr, bfr, acc[nt]); }
        }
        { const int tt = 16 * wave + c; const size_t row = (size_t)row0 + tt; const float bias = bias_pre;
#pragma unroll
          for (int nt = 0; nt < 8; ++nt) { const int d0 = 16 * nt + 4 * q; const u32x2 ur = upre[nt];
              f32x4 o; o.x = bflo(ur.x) * (acc[nt].x + bias); o.y = bfhi(ur.x) * (acc[nt].y + bias); o.z = bflo(ur.y) * (acc[nt].z + bias); o.w = bfhi(ur.y) * (acc[nt].w + bias);
              st_bf4(MIX + row * DM + 512 + h * 128 + d0, o); } }
        }
        __syncthreads();
    }
}

__device__ __forceinline__ void sample_gdn(const Params& P, LAS unsigned char* lds, int tid, int lane, int wave, int bid, int G) {
    asm volatile("" : "+v"(tid)); lane = tid & 63;
    unsigned char* ws = P.ws; const bf16* PROJ = (const bf16*)(ws + WS_PROJ); bf16* MIX = (bf16*)(ws + WS_MIX); const float* BETA = (const float*)(ws + WS_BETA); const float* GG = (const float*)(ws + WS_G);
    const float* sconv = P.in[2]; const float* sgdn = P.in[3]; const float* wconv = P.in[8]; const float* gnorm = P.in[11];
    float* NCS = P.out + O_NCS; float* NGS = P.out + O_NGS;
    LAS float* sm = (LAS float*)lds; LAS float* scal = sm + 384; LAS f32x4* red = (LAS f32x4*)(sm + 512);
    const int dv4 = tid & 31, dkg = tid >> 5;
    for (int su = bid; su < 512; su += G) {
        const int bs = su >> 2, h = su & 3; const size_t srow = (size_t)MPR + bs;
        const float* S0 = sgdn + (size_t)(bs * 4 + h) * 16384 + (size_t)(8 * dkg) * 128 + 4 * dv4;
        f32x4 s0[8];
#pragma unroll
        for (int i = 0; i < 8; ++i) s0[i] = *(const f32x4*)(S0 + (size_t)i * 128);
        if (tid < 384) { const int g3 = tid >> 7, ch = tid & 127, col = g3 * 512 + h * 128 + ch;
            const float x = bf2f(PROJ[srow * NIN + col]); const float h0 = sconv[(size_t)(bs * 3 + 0) * 1536 + col], h1 = sconv[(size_t)(bs * 3 + 1) * 1536 + col], h2 = sconv[(size_t)(bs * 3 + 2) * 1536 + col];
            const float yv = siluf_(wconv[col] * h0 + wconv[1536 + col] * h1 + wconv[3072 + col] * h2 + wconv[4608 + col] * x);
            NCS[(size_t)(bs * 3 + 0) * 1536 + col] = h1; NCS[(size_t)(bs * 3 + 1) * 1536 + col] = h2; NCS[(size_t)(bs * 3 + 2) * 1536 + col] = x;
            sm[g3 * 128 + ch] = yv; }
        __syncthreads();
        if (wave < 2) { const float a = sm[wave * 128 + lane], b2 = sm[wave * 128 + 64 + lane]; const float s = wave_sum(a * a + b2 * b2); if (lane == 0) scal[wave] = rsqrtf(s + 1e-6f); }
        __syncthreads();
        const float qn = scal[0], kn = scal[1];
        const float beta = BETA[srow * 4 + h], eg = __expf(GG[srow * 4 + h]);
        float kk[8], qq[8]; f32x4 p = (f32x4){0.f, 0.f, 0.f, 0.f};
#pragma unroll
        for (int i = 0; i < 8; ++i) { kk[i] = sm[128 + 8 * dkg + i] * kn; qq[i] = sm[8 * dkg + i] * qn; p += s0[i] * kk[i]; }
        red[dkg * 32 + dv4] = p;
        __syncthreads();
        f32x4 kS = red[dv4];
#pragma unroll
        for (int g = 1; g < 16; ++g) kS += red[g * 32 + dv4];
        const f32x4 v4 = *(const LAS f32x4*)(sm + 256 + 4 * dv4); const f32x4 vnew = (v4 - kS * eg) * beta;
        __syncthreads();
        f32x4 po = (f32x4){0.f, 0.f, 0.f, 0.f}; float* S1 = NGS + (size_t)(bs * 4 + h) * 16384 + (size_t)(8 * dkg) * 128 + 4 * dv4;
#pragma unroll
        for (int i = 0; i < 8; ++i) { const f32x4 s1 = s0[i] * eg + vnew * kk[i]; *(f32x4*)(S1 + (size_t)i * 128) = s1; po += s1 * qq[i]; }
        red[dkg * 32 + dv4] = po;
        __syncthreads();
        if (tid < 32) { f32x4 o = red[dv4];
#pragma unroll
            for (int g = 1; g < 16; ++g) o += red[g * 32 + dv4];
            o = o * QSCALE; float s = dot4(o); s += __shfl_xor(s, 1); s += __shfl_xor(s, 2); s += __shfl_xor(s, 4); s += __shfl_xor(s, 8); s += __shfl_xor(s, 16);
            const float rs = rsqrtf(s * (1.f / 128.f) + EPS); const u32x2 zr = *(const u32x2*)(PROJ + srow * NIN + 1536 + h * 128 + 4 * dv4); const f32x4 gn = *(const f32x4*)(gnorm + 4 * dv4);
            f32x4 m; m.x = o.x * rs * gn.x * siluf_(bflo(zr.x)); m.y = o.y * rs * gn.y * siluf_(bfhi(zr.x)); m.z = o.z * rs * gn.z * siluf_(bflo(zr.y)); m.w = o.w * rs * gn.w * siluf_(bfhi(zr.y));
            st_bf4(MIX + srow * DM + h * 128 + 4 * dv4, m); }
        __syncthreads();
    }
}

__device__ __forceinline__ void phase2_misc(const Params& P, int tid, int lane, int wave, int bid, int G) {
    unsigned char* ws = P.ws; const bf16* PROJ = (const bf16*)(ws + WS_PROJ); bf16* MIX = (bf16*)(ws + WS_MIX);
    { float* NCP = P.out + O_NCP; for (int i = bid * 512 + tid; i < 36864; i += G * 512) { const int b = i / 4608, rem = i - b * 4608, j = rem / 1536, col = rem - j * 1536; NCP[i] = bf2f(PROJ[(size_t)(b * 2048 + 2045 + j) * NIN + col]); } }
    const int gw = bid * 8 + wave;
    if (gw < MSA) { const int bs = gw; const size_t srow = (size_t)MPR + bs; const float* lng = P.in[12]; const float* lnb = P.in[13]; float* NSV = P.out + O_NSV;
        const u32x4 raw = *(const u32x4*)(PROJ + srow * NIN + 2560 + 8 * lane); const u32x4 uraw = *(const u32x4*)(PROJ + srow * NIN + 2048 + 8 * lane);
        float x[8] = {bflo(raw.x), bfhi(raw.x), bflo(raw.y), bfhi(raw.y), bflo(raw.z), bfhi(raw.z), bflo(raw.w), bfhi(raw.w)};
        const float uu[8] = {bflo(uraw.x), bfhi(uraw.x), bflo(uraw.y), bfhi(uraw.y), bflo(uraw.z), bfhi(uraw.z), bflo(uraw.w), bfhi(uraw.w)};
        float s = 0.f;
#pragma unroll
        for (int e = 0; e < 8; ++e) s += x[e];
        const float mean = wave_sum(s) * (1.f / 512.f); float s2 = 0.f;
#pragma unroll
        for (int e = 0; e < 8; ++e) { x[e] -= mean; s2 += x[e] * x[e]; }
        const float rstd = rsqrtf(wave_sum(s2) * (1.f / 512.f) + EPS); const int h = lane >> 4; const float w00 = P.in[14][(size_t)h * 16384], b0 = P.in[15][h * 128];
        float vg[8], sg[8];
#pragma unroll
        for (int e = 0; e < 8; ++e) { vg[e] = x[e] * rstd * lng[8 * lane + e] + lnb[8 * lane + e]; sg[e] = uu[e] * (w00 * vg[e] + b0); }
        *(f32x4*)(NSV + (size_t)bs * 512 + 8 * lane) = (f32x4){vg[0], vg[1], vg[2], vg[3]}; *(f32x4*)(NSV + (size_t)bs * 512 + 8 * lane + 4) = (f32x4){vg[4], vg[5], vg[6], vg[7]};
        u32x4 o; o.x = pk2(sg[0], sg[1]); o.y = pk2(sg[2], sg[3]); o.z = pk2(sg[4], sg[5]); o.w = pk2(sg[6], sg[7]); *(u32x4*)(MIX + srow * DM + 512 + 8 * lane) = o; }
}

constexpr int ST_BYTES = 60416;
__device__ __forceinline__ void glds16(const void* g, LAS unsigned char* l) { __builtin_amdgcn_global_load_lds((const unsigned*)g, (LAS unsigned*)l, 16, 0, 0); }
__device__ __forceinline__ void scan_issue1(const bf16* FRB, const bf16* ATf, const float* DECF, int unit, int sl, LAS unsigned char* L, int lane) {
    const bf16* w = FRB + FR_W + (size_t)unit * 8192 + lane * 8; const bf16* at = ATf + (size_t)unit * 4096 + lane * 8; const bf16* uu = FRB + FR_U + ((size_t)unit * 8 + sl) * 1024 + lane * 8;
#pragma unroll
    for (int f = 0; f < 16; ++f) glds16(w + f * 512, L + f * 1024);
#pragma unroll
    for (int f = 0; f < 8; ++f) glds16(at + f * 512, L + 49152 + f * 1024);
    glds16(uu, L + 57344); glds16(uu + 512, L + 58368);
    glds16(DECF + (size_t)unit * 256 + lane * 4, L + 59392);
}
__device__ __forceinline__ void scan_issue2(const bf16* FRB, int unit, LAS unsigned char* L, int lane) {
    const bf16* qg = FRB + FR_QG + (size_t)unit * 8192 + lane * 8; const bf16* kg = FRB + FR_KG + (size_t)unit * 8192 + lane * 8;
#pragma unroll
    for (int f = 0; f < 16; ++f) glds16(qg + f * 512, L + 16384 + f * 1024);
#pragma unroll
    for (int f = 0; f < 16; ++f) glds16(kg + f * 512, L + 32768 + f * 1024);
}
__device__ __forceinline__ void gdn_scan(const Params& P, LAS unsigned char* lds, volatile LAS unsigned* flg, int lane, int wave, int bid, int G) {
    if (wave > 2) return;
    asm volatile("" : "+v"(lane));
    unsigned char* ws = P.ws; const bf16* FRB = (const bf16*)P.out; const bf16* ATf = (const bf16*)(ws + WS_AT); const float* DECF = (const float*)(ws + WS_DECF);
    bf16* O = (bf16*)(ws + WS_O); float* NGP = P.out + O_NGP; const int c = lane & 15, q = lane >> 4;
    int gs = 0;
    for (int job = bid; job < 256; job += G, gs += 32) {
        const int bh = (job & 7) + 8 * (job >> 6), sl = (job >> 3) & 7, b = bh >> 2, h = bh & 3;
        if (wave != 0) {
            for (int n = 0; n < 32; ++n) {
                const int s_ = gs + n; LAS unsigned char* L = lds + (s_ & 1) * ST_BYTES;
                while ((int)flg[0] < s_ - 1) __builtin_amdgcn_s_sleep(1);
                asm volatile("" ::: "memory");
                if (wave == 1) scan_issue1(FRB, ATf, DECF, (b * 32 + n) * 4 + h, sl, L, lane); else scan_issue2(FRB, (b * 32 + n) * 4 + h, L, lane);
                asm volatile("s_waitcnt vmcnt(0)" ::: "memory");
                if (lane == 0) flg[wave] = (unsigned)(s_ + 1);
                asm volatile("s_waitcnt lgkmcnt(0)" ::: "memory");
            }
            continue;
        }
        f32x4 S[8];
#pragma unroll
        for (int i = 0; i < 8; ++i) S[i] = (f32x4){0.f, 0.f, 0.f, 0.f};
        for (int n = 0; n < 32; ++n) {
            const int s_ = gs + n; LAS unsigned char* L = lds + (s_ & 1) * ST_BYTES;
            while ((int)flg[1] < s_ + 1 || (int)flg[2] < s_ + 1) __builtin_amdgcn_s_sleep(1);
            asm volatile("" ::: "memory");
            bf16x8 Wfr[16], QGfr[16]; u32x2 Ufr[4];
#pragma unroll
            for (int f = 0; f < 16; ++f) Wfr[f] = *(const LAS bf16x8*)(L + f * 1024 + lane * 16);
#pragma unroll
            for (int mt = 0; mt < 4; ++mt) Ufr[mt] = *(const LAS u32x2*)(L + 57344 + mt * 512 + lane * 8);
#pragma unroll
            for (int f = 0; f < 16; ++f) QGfr[f] = *(const LAS bf16x8*)(L + 16384 + f * 1024 + lane * 16);
            __builtin_amdgcn_sched_barrier(0);
            bf16x8 Sb[4];
#pragma unroll
            for (int ks = 0; ks < 4; ++ks) Sb[ks] = pack8(S[2 * ks], S[2 * ks + 1]);
            f32x4 va[4], oa[4];
#pragma unroll
            for (int mt = 0; mt < 4; ++mt) { va[mt] = (f32x4){0.f, 0.f, 0.f, 0.f}; oa[mt] = va[mt]; }
#pragma unroll
            for (int ks = 0; ks < 4; ++ks)
#pragma unroll
                for (int mt = 0; mt < 4; ++mt) va[mt] = mfma16(Wfr[mt * 4 + ks], Sb[ks], va[mt]);
            __builtin_amdgcn_sched_barrier(0);
            bf16x8 ATfr[8];
#pragma unroll
            for (int f = 0; f < 8; ++f) ATfr[f] = *(const LAS bf16x8*)(L + 49152 + f * 1024 + lane * 16);
            const float dec = *(const LAS float*)(L + 59392 + lane * 4);
            __builtin_amdgcn_sched_barrier(0);
#pragma unroll
            for (int ks = 0; ks < 4; ++ks)
#pragma unroll
                for (int mt = 0; mt < 4; ++mt) oa[mt] = mfma16(QGfr[mt * 4 + ks], Sb[ks], oa[mt]);
            __builtin_amdgcn_sched_barrier(0);
            bf16x8 KGfr[16];
#pragma unroll
            for (int f = 0; f < 16; ++f) KGfr[f] = *(const LAS bf16x8*)(L + 32768 + f * 1024 + lane * 16);
            __builtin_amdgcn_sched_barrier(0);
            f32x4 vn[4];
#pragma unroll
            for (int mt = 0; mt < 4; ++mt) vn[mt] = (f32x4){bflo(Ufr[mt].x) - va[mt].x, bfhi(Ufr[mt].x) - va[mt].y, bflo(Ufr[mt].y) - va[mt].z, bfhi(Ufr[mt].y) - va[mt].w};
            bf16x8 vb[2];
#pragma unroll
            for (int k2 = 0; k2 < 2; ++k2) vb[k2] = pack8(vn[2 * k2], vn[2 * k2 + 1]);
#pragma unroll
            for (int mt = 0; mt < 8; ++mt) S[mt] = S[mt] * dec;
#pragma unroll
            for (int k2 = 0; k2 < 2; ++k2) {
#pragma unroll
                for (int mt = 0; mt < 8; ++mt) S[mt] = mfma16(KGfr[mt * 2 + k2], vb[k2], S[mt]);
#pragma unroll
                for (int mt = 0; mt < 4; ++mt) oa[mt] = mfma16(ATfr[mt * 2 + k2], vb[k2], oa[mt]);
            }
#pragma unroll
            for (int mt = 0; mt < 4; ++mt) {
                const bool od = lane & 1; const float t0 = dpp_get<0xB1, 0xF>(od ? oa[mt].x : oa[mt].z), t1 = dpp_get<0xB1, 0xF>(od ? oa[mt].y : oa[mt].w);
                unsigned* op = (unsigned*)(O + ((size_t)(b * 2048 + n * 64 + 16 * mt + 4 * q + (od ? 2 : 0))) * 512 + h * 128 + 16 * sl + (c & ~1));
                op[0] = od ? pk2(t0, oa[mt].z) : pk2(oa[mt].x, t0); op[256] = od ? pk2(t1, oa[mt].w) : pk2(oa[mt].y, t1); }
            asm volatile("s_waitcnt lgkmcnt(0)" ::: "memory");
            if (lane == 0) flg[0] = (unsigned)(s_ + 1);
            asm volatile("" ::: "memory");
        }
#pragma unroll
        for (int mt = 0; mt < 8; ++mt) { float* sp = NGP + ((size_t)(b * 4 + h) * 128 + 16 * mt + 4 * q) * 128 + 16 * sl + c; sp[0] = S[mt].x; sp[128] = S[mt].y; sp[256] = S[mt].z; sp[384] = S[mt].w; }
        asm volatile("s_waitcnt vmcnt(0)" ::: "memory");
    }
}

__device__ __forceinline__ void gdn_gate(const Params& P, int lane, int wave, int bid, int G) {
    unsigned char* ws = P.ws; const bf16* PROJ = (const bf16*)(ws + WS_PROJ); bf16* MIX = (bf16*)(ws + WS_MIX); const bf16* O = (const bf16*)(ws + WS_O); const float* gnorm = P.in[11];
    float gn[8];
#pragma unroll
    for (int e = 0; e < 8; ++e) gn[e] = gnorm[8 * (lane & 15) + e];
    for (int row0 = bid * 8 + wave; row0 < MPR; row0 += G * 32) {
        f32x4 a[4], b[4]; u32x4 zr[4];
#pragma unroll
        for (int u = 0; u < 4; ++u) { const int row = min(row0 + u * G * 8, MPR - 1); const u32x4 orw = *(const u32x4*)(O + (size_t)row * 512 + 8 * lane);
            a[u] = (f32x4){bflo(orw.x), bfhi(orw.x), bflo(orw.y), bfhi(orw.y)}; b[u] = (f32x4){bflo(orw.z), bfhi(orw.z), bflo(orw.w), bfhi(orw.w)};
            zr[u] = *(const u32x4*)(PROJ + (size_t)row * NIN + 1536 + 8 * lane); }
#pragma unroll
        for (int u = 0; u < 4; ++u) { const int row = row0 + u * G * 8;
            float s = dot4(a[u]) + dot4(b[u]); s += dpp_get<0xB1, 0xF>(s); s += dpp_get<0x4E, 0xF>(s); s += dpp_get<0x141, 0xF>(s); s += dpp_get<0x140, 0xF>(s);
            const float rs = rsqrtf(s * (1.f / 128.f) + EPS);
            u32x4 o; o.x = pk2(a[u].x * rs * gn[0] * siluf_(bflo(zr[u].x)), a[u].y * rs * gn[1] * siluf_(bfhi(zr[u].x))); o.y = pk2(a[u].z * rs * gn[2] * siluf_(bflo(zr[u].y)), a[u].w * rs * gn[3] * siluf_(bfhi(zr[u].y)));
            o.z = pk2(b[u].x * rs * gn[4] * siluf_(bflo(zr[u].z)), b[u].y * rs * gn[5] * siluf_(bfhi(zr[u].z))); o.w = pk2(b[u].z * rs * gn[6] * siluf_(bflo(zr[u].w)), b[u].w * rs * gn[7] * siluf_(bfhi(zr[u].w)));
            if (row < MPR) *(u32x4*)(MIX + (size_t)row * DM + 8 * lane) = o; }
    }
}
__device__ __forceinline__ void final_norm(const Params& P, int lane, int wave, int bid, int G) {
    const float* SS3 = (const float*)(P.ws + WS_SS3); const float* gf = P.in[23]; float* out = P.out; const bf16* X3 = (const bf16*)(P.ws + WS_HID);
    f32x4 g4[4];
#pragma unroll
    for (int j = 0; j < 2; ++j) { g4[2 * j] = *(const f32x4*)(gf + 512 * j + 8 * lane); g4[2 * j + 1] = *(const f32x4*)(gf + 512 * j + 8 * lane + 4); }
    for (int row0 = MPR + bid * 8 + wave; row0 < MT; row0 += G * 32) {
        u32x4 v[4][2]; float rs[4];
#pragma unroll
        for (int u = 0; u < 4; ++u) { const int row = min(row0 + u * G * 8, MT - 1); rs[u] = sum16(SS3 + (size_t)row * 16);
#pragma unroll
            for (int j = 0; j < 2; ++j) v[u][j] = *(const u32x4*)(X3 + (size_t)row * DM + 512 * j + 8 * lane); }
#pragma unroll
        for (int u = 0; u < 4; ++u) { const int row = row0 + u * G * 8; const float r = rsqrtf(rs[u] * (1.f / DM) + EPS);
            if (row < MT) {
#pragma unroll
                for (int j = 0; j < 2; ++j) { const u32x4 w = v[u][j]; float* o = out + (size_t)row * DM + 512 * j + 8 * lane;
                    *(f32x4*)o = (f32x4){bflo(w.x), bfhi(w.x), bflo(w.y), bfhi(w.y)} * r * g4[2 * j];
                    *(f32x4*)(o + 4) = (f32x4){bflo(w.z), bfhi(w.z), bflo(w.w), bfhi(w.w)} * r * g4[2 * j + 1]; } } }
    }
}
#define XB_TMO      128
#define XB_XCNT(j)  (256  + 64 * (j))
#define XB_XSUB(j)  (1280 + 64 * (j))
#define XB_XGEN(j)  (2304 + 64 * (j))
#define XB_TOP      3328
#define XB_TOPGEN   3392
#define XCD_BAR_WORDS 3456
#define XB_SPIN_CAP (1u << 18)

__device__ __forceinline__ unsigned xb_ld(unsigned* p)              { return __hip_atomic_load(p, __ATOMIC_RELAXED, __HIP_MEMORY_SCOPE_AGENT); }
__device__ __forceinline__ unsigned xb_add(unsigned* p, unsigned v) { return __hip_atomic_fetch_add(p, v, __ATOMIC_RELAXED, __HIP_MEMORY_SCOPE_AGENT); }
__device__ __forceinline__ unsigned xb_xcc_id() { return (unsigned)__builtin_amdgcn_s_getreg((3 << 11) | 20) & 0xFu; }
#define XB_SPIN(cond, bar) do { unsigned _sp = 0; while (cond) { __builtin_amdgcn_s_sleep(1); \
    if ((++_sp & 255u) == 0u) { if (xb_ld(&(bar)[XB_TMO])) break; if (_sp > XB_SPIN_CAP) { atomicAdd(&(bar)[XB_TMO], 1u); break; } } } } while (0)

struct XcdBarrier {
    unsigned* bar; unsigned x;
    volatile LAS unsigned* st;
};

__device__ __forceinline__ XcdBarrier xcd_barrier_post(unsigned* bar, volatile LAS unsigned* st) {
    XcdBarrier b; b.bar = bar; b.x = xb_xcc_id(); b.st = st;
    if (threadIdx.x == 0) (void)xb_add(&bar[XB_XCNT(b.x)], 1u);
    return b;
}
__device__ __forceinline__ void xcd_barrier_complete(unsigned* bar, unsigned x, unsigned& nloc, unsigned& nx) {
    const unsigned G = gridDim.x * gridDim.y * gridDim.z;
    unsigned sum, cnt, mine, sp = 0u;
    for (;;) {
        sum = 0u; cnt = 0u; mine = 0u;
#pragma unroll
        for (unsigned j = 0; j < 16; ++j) { const unsigned c = xb_ld(&bar[XB_XCNT(j)]); sum += c; cnt += (c > 0u) ? 1u : 0u; mine = (j == x) ? c : mine; }
        if (sum == G) break;
        __builtin_amdgcn_s_sleep(1);
        if ((++sp & 255u) == 0u) { if (xb_ld(&bar[XB_TMO])) break; if (sp > XB_SPIN_CAP) { atomicAdd(&bar[XB_TMO], 1u); break; } }
    }
    nloc = mine > 0u ? mine : 1u; nx = cnt > 0u ? cnt : 1u;
}

__device__ __forceinline__ void xcd_barrier(const XcdBarrier& b) {
    asm volatile("s_waitcnt vmcnt(0)" ::: "memory");
    __syncthreads();
    if (threadIdx.x == 0) {
        unsigned* bar = b.bar;
        __builtin_amdgcn_s_waitcnt(0);
        unsigned nloc = b.st[0], nx = b.st[1];
        if (nloc == 0u) { xcd_barrier_complete(bar, b.x, nloc, nx); b.st[0] = nloc; b.st[1] = nx; }
        const unsigned old = xb_add(&bar[XB_XSUB(b.x)], 1u);
        const unsigned gen = old / nloc;
        if (old + 1u == (gen + 1u) * nloc) {
            __builtin_amdgcn_fence(__ATOMIC_RELEASE, "agent");
            asm volatile("s_waitcnt vmcnt(0)" ::: "memory");
            const unsigned og = xb_add(&bar[XB_TOP], 1u);
            const unsigned tg = og / nx;
            if (og + 1u == (tg + 1u) * nx) xb_add(&bar[XB_TOPGEN], 1u);
            else XB_SPIN(xb_ld(&bar[XB_TOPGEN]) == tg, bar);
            __builtin_amdgcn_fence(__ATOMIC_ACQUIRE, "agent");
            xb_add(&bar[XB_XGEN(b.x)], 1u);
            asm volatile("s_waitcnt vmcnt(0)" ::: "memory");
        } else {
            XB_SPIN(xb_ld(&bar[XB_XGEN(b.x)]) == gen, bar);
            __builtin_amdgcn_fence(__ATOMIC_ACQUIRE, "agent");
            asm volatile("s_waitcnt vmcnt(0)" ::: "memory");
        }
    }
    __syncthreads();
}

__global__ void __launch_bounds__(512, 2) mega_fwd(Params P) {
    extern __shared__ __attribute__((aligned(16))) unsigned char lds_raw[];
    LAS unsigned char* lds = (LAS unsigned char*)lds_raw;
    const int bid = blockIdx.x, G = gridDim.x;
#define FRESH() int tid = threadIdx.x; asm volatile("" : "+v"(tid)); const int lane = tid & 63, wave = __builtin_amdgcn_readfirstlane(tid >> 6), gw = bid * 8 + wave, NGW = G * 8; (void)gw; (void)NGW; (void)lane

    volatile LAS unsigned* st = (volatile LAS unsigned*)(lds + LDS_BYTES - 64);
    if (threadIdx.x < 16) st[threadIdx.x] = 0u;
    __syncthreads();
    unsigned char* ws = P.ws;
    XcdBarrier bar = xcd_barrier_post((unsigned*)(ws + WS_CTL), st);
#define GRID_BAR() xcd_barrier(bar)
    bf16* XB = (bf16*)(ws + WS_XB); bf16* MIX = (bf16*)(ws + WS_MIX); bf16* PROJ = (bf16*)(ws + WS_PROJ); bf16* HID = (bf16*)(ws + WS_HID); bf16* PB = (bf16*)(ws + WS_PB);
    float* SS1 = (float*)(ws + WS_SS1); float* SS2 = (float*)(ws + WS_SS2); float* SS3 = (float*)(ws + WS_SS3);

    { FRESH(); phase0(P, lds, tid, lane, wave, bid, G); }
    GRID_BAR();
    {   FRESH();
        pg8::Gemm g{XB, (const bf16*)(ws + WS_WIN), MPR, NIN, DM}; pg8::StaticOrder S; S.init(MPR, NIN, G, bid);
        EpiGen<F1> E{F1{nullptr, (const float*)(ws + WS_RS0), PROJ}}; EpiGen8<F1> E8{E.f};
        pg8::gemm_phase<EpiGen8<F1>, pg8::StaticOrder, true, true>(lds, g, S, E8);
        small_gemm<2, 4>(XB + (size_t)MPR * DM, (const bf16*)(ws + WS_WIN), NIN, DM, E.f, lds, bid, G, wave, lane);
    }
    GRID_BAR();
    if ((bid & 3) == 1) { FRESH(); sample_gdn(P, lds, tid, lane, wave, bid, G); }
    if ((bid & 3) == 2) { FRESH(); sgu_prompt(P, lds, tid, lane, wave, bid, G); }
    { FRESH(); gdn_prep(P, lds, tid, lane, wave, bid, G); }
    if ((bid & 3) != 2) { FRESH(); sgu_prompt(P, lds, tid, lane, wave, bid, G); }
    if ((bid & 3) != 1) { FRESH(); sample_gdn(P, lds, tid, lane, wave, bid, G); }
    { FRESH(); phase2_misc(P, tid, lane, wave, bid, G); }
    GRID_BAR();
    { FRESH(); gdn_scan(P, lds, st + 4, lane, wave, bid, G);
      if (wave >= 3 && wave <= 5) weight_items(P, (LAS float*)(lds + 2 * ST_BYTES + (wave - 3) * 8448), lane, 1536, 6784, bid * 3 + (wave - 3), G * 3); }
    GRID_BAR();
    { FRESH(); gdn_gate(P, lane, wave, bid, G); }
    GRID_BAR();
    {   FRESH();
        pg8::Gemm g{MIX, (const bf16*)(ws + WS_WOUT), MPR, DM, DM}; pg8::StaticOrder S; S.init(MPR, DM, G, bid);
        EpiGen<F2> E{F2{SS1, XB}}; EpiGen8<F2> E8{E.f};
        pg8::gemm_phase<EpiGen8<F2>, pg8::StaticOrder, false, true>(lds, g, S, E8);
        small_gemm<1, 8>(MIX + (size_t)MPR * DM, (const bf16*)(ws + WS_WOUT), DM, DM, E.f, lds, bid, G, wave, lane);
    }
    GRID_BAR();
    {   FRESH();
        pg8::Gemm g{XB, (const bf16*)(ws + WS_WUP), MPR, FF, DM}; pg8::StaticOrder S; S.init(MPR, FF, G, bid);
        EpiGen<F3> E{F3{nullptr, SS1, HID}}; EpiGen8<F3> E8{E.f};
        pg8::gemm_phase<EpiGen8<F3>, pg8::StaticOrder, true, true>(lds, g, S, E8);
        small_gemm<2, 4>(XB + (size_t)MPR * DM, (const bf16*)(ws + WS_WUP), FF, DM, E.f, lds, bid, G, wave, lane);
    }
    GRID_BAR();
    {   FRESH();
        pg8::Gemm g{HID, (const bf16*)(ws + WS_WDN), MPR, DM, FF}; pg8::StaticOrder S; S.init(MPR, DM, G, bid);
        EpiGen<F4> E{F4{SS2, XB}}; EpiGen8<F4> E8{E.f};
        pg8::gemm_phase<EpiGen8<F4>, pg8::StaticOrder, false, true>(lds, g, S, E8);
        small_gemm<1, 8>(HID + (size_t)MPR * FF, (const bf16*)(ws + WS_WDN), DM, FF, E.f, lds, bid, G, wave, lane);
    }
    GRID_BAR();
    {   FRESH();
        bf16* PP = MIX;
        { pg8::Gemm g{PB, (const bf16*)(ws + WS_WPLE), MPR, DM, DPLE}; pg8::StaticOrder S; S.init(MPR, DM, G, bid);
          EpiGen<F5a> E{F5a{nullptr, PP}}; EpiGen8<F5a> E8{E.f};
          pg8::gemm_phase<EpiGen8<F5a>, pg8::StaticOrder, false, true>(lds, g, S, E8);
          small_gemm<1, 8>(PB + (size_t)MPR * DPLE, (const bf16*)(ws + WS_WPLE), DM, DPLE, E.f, lds, bid, G, wave, lane); }
        { pg8::Gemm g{XB, (const bf16*)(ws + WS_WG), MPR, DM, DM}; pg8::StaticOrder S; S.init(MPR, DM, G, bid);
          EpiGen<F5b> E{F5b{SS3, SS2, XB, PP, HID}};
          EpiFinal EF{SS2, XB, PP, P.out, P.in[23], (unsigned*)(ws + WS_XBUF), (unsigned*)(ws + WS_CTL + 16384)};
          pg8::gemm_phase<EpiFinal, pg8::StaticOrder, false, true>(lds, g, S, EF);
          small_gemm<1, 8>(XB + (size_t)MPR * DM, (const bf16*)(ws + WS_WG), DM, DM, E.f, lds, bid, G, wave, lane); }
    }
    GRID_BAR();
    { FRESH(); final_norm(P, lane, wave, bid, G); }
}

extern "C" void kernel_launch(void* const* d_in, const int* in_sizes, int n_in, void* d_out, int out_size, void* d_ws, size_t ws_size, hipStream_t stream) {
    static int grid = 0;
    if (grid == 0) {
        int dev = 0, cus = 0;
        if (hipGetDevice(&dev) != hipSuccess || hipDeviceGetAttribute(&cus, hipDeviceAttributeMultiprocessorCount, dev) != hipSuccess) { fprintf(stderr, "kernel_launch: device query failed\n"); grid = -1; return; }
        if (hipFuncSetAttribute((const void*)mega_fwd, hipFuncAttributeMaxDynamicSharedMemorySize, LDS_BYTES) != hipSuccess) { fprintf(stderr, "kernel_launch: hipFuncSetAttribute failed\n"); grid = -1; return; }
        int per_cu = 0;
        if (hipOccupancyMaxActiveBlocksPerMultiprocessor(&per_cu, (const void*)mega_fwd, 512, LDS_BYTES) != hipSuccess || per_cu < 1) fprintf(stderr, "kernel_launch: occupancy query reports %d\n", per_cu);
        (void)hipGetLastError();
        grid = cus < 256 ? cus : 256;
        if (n_in != 24 || ws_size < 256 * MiB) fprintf(stderr, "kernel_launch: unexpected n_in %d / ws %zu\n", n_in, ws_size);
    }
    if (grid < 0) return;
    (void)hipMemsetAsync((char*)d_ws + WS_CTL, 0, CTL_BYTES, stream);
    Params p{};
    for (int i = 0; i < 24; ++i) p.in[i] = (const float*)d_in[i];
    p.out = (float*)d_out; p.ws = (unsigned char*)d_ws;
    hipLaunchKernelGGL(mega_fwd, dim3(grid), dim3(512), LDS_BYTES, stream, p);
}
```

```cpp
#include <hip/hip_runtime.h>
#include <cstdio>
#include <cstdint>
namespace pg8 {
#define PG8_LAS __attribute__((address_space(3)))
typedef unsigned short bf16_t;
typedef short bf16x8 __attribute__((ext_vector_type(8)));
typedef float f32x4 __attribute__((ext_vector_type(4)));
typedef unsigned u32x4 __attribute__((ext_vector_type(4)));
constexpr int BM = 256, BK = 64, HALF = 128, HTB = HALF * BK * 2  , STAGE_BYTES = 8 * HTB, NXCD = 8, WGM = 8;

__host__ __device__ __forceinline__ int lds_byte(int r, int c) { const int st = (r >> 4) * 2 + (c >> 5), rr = r & 15, cc = c & 31, ob = rr * 64 + cc * 2; return st * 1024 + (ob ^ (((ob >> 9) & 1) << 5)); }
__host__ __device__ __forceinline__ void stage_rc(int b, int& R, int& C) { const int st = b / 1024, sb = b % 1024, swz = sb ^ (((sb >> 9) & 1) << 5); R = (st >> 1) * 16 + swz / 64; C = (st & 1) * 32 + (swz % 64) / 2; }
__host__ __device__ __forceinline__ int perm32(int rho) { const int n = rho >> 4, i = rho & 15; return 8 * (i >> 2) + 4 * n + (i & 3); }

struct Unit { int pm, pn; };
struct Gemm { const bf16_t* A; const bf16_t* Bt; int M, N, K; };

struct StaticOrder {
    int nM, nN, nwg, G, c;
    __host__ __device__ void init(int M, int N, int G_, int c_) { nM = M / BM; nN = N / BM; nwg = nM * nN; G = G_; c = c_; }
    __host__ __device__ bool next(int i, Unit& u) const {
        const long L = (long)i * G + c; if (L >= nwg) return false;
        int wgid = (int)L; { const int q = nwg / NXCD, r = nwg % NXCD, xcd = wgid % NXCD, off = wgid / NXCD; wgid = (xcd < r ? xcd * (q + 1) : r * (q + 1) + (xcd - r) * q) + off; }
        const int nig = WGM * nN, gid = wgid / nig, fm = gid * WGM, gsz = (nM - fm) < WGM ? (nM - fm) : WGM;
        u.pm = fm + ((wgid % nig) % gsz); u.pn = (wgid % nig) / gsz; return true;
    }
    __device__ __forceinline__ void a_ready(const Unit&) const {}
    __device__ __forceinline__ void done(const Unit&) const {}
};

__device__ __forceinline__ unsigned cvt_pk_bf16(float lo, float hi) { unsigned r; asm volatile("v_cvt_pk_bf16_f32 %0, %1, %2" : "=v"(r) : "v"(lo), "v"(hi)); return r; }
template <class Epi, class Sched, bool ALIGN_EPI = false, bool SP2 = false>
__device__ __forceinline__ void gemm_phase(PG8_LAS unsigned char* lds, const Gemm g, const Sched& S, const Epi& E) {
    int tid_ = threadIdx.x; asm volatile("" : "+v"(tid_));
    const int tid = tid_, wid = __builtin_amdgcn_readfirstlane(tid >> 6), lane = tid & 63, wr = wid >> 2, wc = wid & 3, fr = lane & 15, fq = lane >> 4;
    const int K = g.K, nt = K / BK;
    unsigned voffA[2], voffB[2];
#pragma unroll
    for (int i = 0; i < 2; ++i) { int R, C; stage_rc(tid * 16 + i * 8192, R, C); const int Rb = Epi::PERM ? ((R & ~31) + perm32(R & 31)) : R;
        voffA[i] = (unsigned)(R * K + C) * 2u; voffB[i] = (unsigned)(Rb * K + C) * 2u; }
    const size_t kstep = (size_t)(BK * 2);
    const size_t hstep = (size_t)HALF * K * 2;
    const size_t tstep = 2 * hstep;
    const unsigned ldsw = (unsigned)wid * 1024u;
    const int aoff = lds_byte(wr * 64 + fr, fq * 8), boff = lds_byte(wc * 32 + fr, fq * 8);
#define PG8_SA(b, h) (((b) * 2 + (h)) * HTB)
#define PG8_SB(b, h) ((4 + (b) * 2 + (h)) * HTB)
#define PG8_STAGE(bufoff, gbase, voff) do { _Pragma("unroll") for (int _i = 0; _i < 2; ++_i) \
        __builtin_amdgcn_global_load_lds((const unsigned*)((const char*)(gbase) + (voff)[_i]), (PG8_LAS unsigned*)(lds + (bufoff) + ldsw + _i * 8192), 16, 0, 0); } while (0)
#define PG8_LDA(dst, b, h) do { _Pragma("unroll") for (int m = 0; m < 4; ++m) _Pragma("unroll") for (int k = 0; k < 2; ++k) dst[m][k] = *(const PG8_LAS bf16x8*)(lds + PG8_SA(b, h) + aoff + m * 2048 + k * 1024); } while (0)
#define PG8_LDB(dst, b, h) do { _Pragma("unroll") for (int n = 0; n < 2; ++n) _Pragma("unroll") for (int k = 0; k < 2; ++k) dst[n][k] = *(const PG8_LAS bf16x8*)(lds + PG8_SB(b, h) + boff + n * 2048 + k * 1024); } while (0)
#define PG8_MMA(ai, bj, At, Bt) do { __builtin_amdgcn_s_setprio(1); _Pragma("unroll") for (int m = 0; m < 4; ++m) _Pragma("unroll") for (int n = 0; n < 2; ++n) _Pragma("unroll") for (int k = 0; k < 2; ++k) \
        acc[ai][bj][m][n] = __builtin_amdgcn_mfma_f32_16x16x32_bf16(Bt[n][k], At[m][k], acc[ai][bj][m][n], 0, 0, 0); __builtin_amdgcn_s_setprio(0); } while (0)
#define PG8_WAIT_V(n) asm volatile("s_waitcnt vmcnt(" #n ")" ::: "memory")
#define PG8_WAIT_L(n) asm volatile("s_waitcnt lgkmcnt(" #n ")" ::: "memory")
#define PG8_BAR __builtin_amdgcn_s_barrier()
#define PG8_SCHED __builtin_amdgcn_sched_barrier(0)
    Unit cur, nxt; int ui = 0;
    if (!S.next(0, cur)) return;
    f32x4 acc[2][2][4][2];
#pragma unroll
    for (int a = 0; a < 2; ++a)
#pragma unroll
        for (int b = 0; b < 2; ++b)
#pragma unroll
            for (int m = 0; m < 4; ++m)
#pragma unroll
                for (int n = 0; n < 2; ++n) acc[a][b][m][n] = (f32x4){0.f, 0.f, 0.f, 0.f};
    bf16x8 At[4][2], B0[2][2], B1[2][2];
    const char* cA = (const char*)g.A + (size_t)cur.pm * tstep; const char* cB = (const char*)g.Bt + (size_t)cur.pn * tstep;
    S.a_ready(cur);
    if constexpr (SP2) {
        PG8_STAGE(PG8_SB(0, 0), cB, voffB); PG8_STAGE(PG8_SB(0, 1), cB + hstep, voffB); PG8_STAGE(PG8_SA(0, 0), cA, voffA); PG8_STAGE(PG8_SA(0, 1), cA + hstep, voffA);
        if (wr == 1) PG8_BAR;
        PG8_WAIT_V(2); PG8_BAR;
        PG8_STAGE(PG8_SB(1, 0), cB + kstep, voffB); PG8_STAGE(PG8_SA(1, 0), cA + kstep, voffA); PG8_STAGE(PG8_SB(1, 1), cB + hstep + kstep, voffB);
        PG8_WAIT_V(6); PG8_BAR;
    } else {
        PG8_STAGE(PG8_SB(0, 0), cB, voffB); PG8_STAGE(PG8_SA(0, 0), cA, voffA); PG8_STAGE(PG8_SB(0, 1), cB + hstep, voffB); PG8_STAGE(PG8_SA(0, 1), cA + hstep, voffA);
        if (wr == 1) PG8_BAR;
        PG8_WAIT_V(4); PG8_BAR;
        PG8_STAGE(PG8_SB(1, 0), cB + kstep, voffB); PG8_STAGE(PG8_SA(1, 0), cA + kstep, voffA); PG8_STAGE(PG8_SB(1, 1), cB + hstep + kstep, voffB);
        PG8_WAIT_V(6); PG8_BAR;
    }
    for (;;) {
        const bool has_next = S.next(ui + 1, nxt);
        const char* nA = has_next ? (const char*)g.A + (size_t)nxt.pm * tstep : cA; const char* nB = has_next ? (const char*)g.Bt + (size_t)nxt.pn * tstep : cB;
        for (int t = 0; t < nt; t += 2) {
            const bool last = (t == nt - 2);
            const char* a1 = cA + (size_t)(t + 1) * kstep;
            const char* a2 = last ? nA : cA + (size_t)(t + 2) * kstep; const char* b2 = last ? nB : cB + (size_t)(t + 2) * kstep;
            const char* a3 = a2 + kstep; const char* b3 = b2 + kstep;
            if (last && has_next) S.a_ready(nxt);
            if constexpr (SP2) {
            PG8_LDB(B0, 0, 0); PG8_LDB(B1, 0, 1); PG8_SCHED; PG8_LDA(At, 0, 0); PG8_STAGE(PG8_SA(1, 1), a1 + hstep, voffA);
            PG8_WAIT_V(8); PG8_WAIT_L(0); PG8_BAR; PG8_MMA(0, 0, At, B0); PG8_MMA(0, 1, At, B1); PG8_BAR; PG8_SCHED;
            PG8_LDA(At, 0, 1); PG8_STAGE(PG8_SB(0, 0), b2, voffB); PG8_STAGE(PG8_SB(0, 1), b2 + hstep, voffB); PG8_STAGE(PG8_SA(0, 0), a2, voffA);
            PG8_WAIT_V(8); PG8_WAIT_L(0); PG8_BAR; PG8_MMA(1, 0, At, B0); PG8_MMA(1, 1, At, B1); PG8_BAR; PG8_SCHED;
            PG8_LDB(B0, 1, 0); PG8_LDB(B1, 1, 1); PG8_SCHED; PG8_LDA(At, 1, 0); PG8_STAGE(PG8_SA(0, 1), a2 + hstep, voffA);
            PG8_WAIT_V(8); PG8_WAIT_L(0); PG8_BAR; PG8_MMA(0, 0, At, B0); PG8_MMA(0, 1, At, B1); PG8_BAR; PG8_SCHED;
            PG8_LDA(At, 1, 1); PG8_STAGE(PG8_SB(1, 0), b3, voffB); PG8_STAGE(PG8_SB(1, 1), b3 + hstep, voffB); PG8_STAGE(PG8_SA(1, 0), a3, voffA);
            PG8_WAIT_V(8); PG8_WAIT_L(0); PG8_BAR; PG8_MMA(1, 0, At, B0); PG8_MMA(1, 1, At, B1); PG8_BAR; PG8_SCHED;
            } else {
            PG8_LDB(B0, 0, 0); PG8_SCHED; PG8_LDA(At, 0, 0); PG8_STAGE(PG8_SA(1, 1), a1 + hstep, voffA);
            PG8_WAIT_L(8); PG8_BAR; PG8_WAIT_L(0); PG8_MMA(0, 0, At, B0); PG8_BAR; PG8_SCHED;
            PG8_LDB(B1, 0, 1); PG8_STAGE(PG8_SB(0, 0), b2, voffB);
            PG8_BAR; PG8_WAIT_L(0); PG8_MMA(0, 1, At, B1); PG8_BAR;
            PG8_LDA(At, 0, 1); PG8_STAGE(PG8_SA(0, 0), a2, voffA);
            PG8_BAR; PG8_WAIT_L(0); PG8_MMA(1, 0, At, B0); PG8_BAR; PG8_SCHED;
            PG8_STAGE(PG8_SB(0, 1), b2 + hstep, voffB);
            PG8_WAIT_V(6); PG8_BAR; PG8_MMA(1, 1, At, B1); PG8_BAR;
            PG8_LDB(B0, 1, 0); PG8_SCHED; PG8_LDA(At, 1, 0); PG8_STAGE(PG8_SA(0, 1), a2 + hstep, voffA);
            PG8_WAIT_L(8); PG8_BAR; PG8_WAIT_L(0); PG8_MMA(0, 0, At, B0); PG8_BAR; PG8_SCHED;
            PG8_LDB(B1, 1, 1); PG8_STAGE(PG8_SB(1, 0), b3, voffB);
            PG8_BAR; PG8_WAIT_L(0); PG8_MMA(0, 1, At, B1); PG8_BAR;
            PG8_LDA(At, 1, 1); PG8_STAGE(PG8_SA(1, 0), a3, voffA);
            PG8_BAR; PG8_WAIT_L(0); PG8_MMA(1, 0, At, B0); PG8_BAR; PG8_SCHED;
            PG8_STAGE(PG8_SB(1, 1), b3 + hstep, voffB);
            PG8_WAIT_V(6); PG8_BAR; PG8_MMA(1, 1, At, B1); PG8_BAR;
            }
        }
        if constexpr (ALIGN_EPI) { if (wr == 0) PG8_BAR; }
        if constexpr (!Epi::AFTER_DRAIN) { E(acc, cur, wr, wc, fr, fq); S.done(cur); }
        if (!has_next) break;
#pragma unroll
        for (int a = 0; a < 2; ++a)
#pragma unroll
            for (int b = 0; b < 2; ++b)
#pragma unroll
                for (int m = 0; m < 4; ++m)
#pragma unroll
                    for (int n = 0; n < 2; ++n) acc[a][b][m][n] = (f32x4){0.f, 0.f, 0.f, 0.f};
        cur = nxt; cA = nA; cB = nB; ++ui;
        if constexpr (ALIGN_EPI) { if (wr == 1) PG8_BAR; }
    }
    PG8_WAIT_V(0);
    if constexpr (!ALIGN_EPI) { if (wr == 0) PG8_BAR; }
    PG8_BAR;
    if constexpr (Epi::AFTER_DRAIN) { E.fused(acc, cur, wr, wc, fr, fq, lds, wid, lane); S.done(cur); }
#undef PG8_SA
#undef PG8_SB
#undef PG8_STAGE
#undef PG8_LDA
#undef PG8_LDB
#undef PG8_MMA
#undef PG8_WAIT_V
#undef PG8_WAIT_L
#undef PG8_BAR
#undef PG8_SCHED
}
}

#define LAS __attribute__((address_space(3)))
typedef unsigned short bf16;
typedef float f32x4 __attribute__((ext_vector_type(4)));
typedef short bf16x8 __attribute__((ext_vector_type(8)));
typedef unsigned u32x4 __attribute__((ext_vector_type(4)));
typedef unsigned u32x2 __attribute__((ext_vector_type(2)));
#define LDS_WAIT() asm volatile("s_waitcnt lgkmcnt(0)" ::: "memory")
#define VM_WAIT() asm volatile("s_waitcnt vmcnt(0)" ::: "memory")

constexpr int MPR = 16384, MSA = 128, MT = MPR + MSA, DM = 1024, NIN = 3072, FF = 4096, DPLE = 256, SRCN = 3080;
constexpr float EPS = 1e-6f, QSCALE = 0.08838834764831845f;
constexpr int LDS_BYTES = 147456;
constexpr size_t MiB = 1u << 20;
constexpr size_t WS_RS0 = 0, WS_BETA = 128 * 1024, WS_G = 448 * 1024, WS_WSB = 1 * MiB, WS_SS1 = 2 * MiB, WS_SS2 = 3 * MiB + 256 * 1024, WS_SS3 = 4 * MiB + 512 * 1024;
constexpr size_t WS_WIN = 6 * MiB, WS_WOUT = 12 * MiB, WS_WUP = 14 * MiB, WS_WDN = 22 * MiB, WS_WG = 30 * MiB, WS_WPLE = 32 * MiB;
constexpr size_t WS_PB = 33 * MiB, WS_XB = 42 * MiB, WS_MIX = 75 * MiB, WS_PROJ = 108 * MiB, WS_HID = 108 * MiB, WS_AT = 205 * MiB, WS_O = 213 * MiB, WS_DECF = 246 * MiB, WS_XBUF = 247 * MiB, WS_CTL = 255 * MiB;
constexpr size_t CTL_BYTES = 32768;
constexpr size_t O_Y = 0, O_NCP = 16908288, O_NGP = 16945152, O_NCS = 17469440, O_NGS = 18059264, O_NSV = 26447872;
constexpr size_t FR_W = 0, FR_QG = 8 * MiB, FR_KG = 16 * MiB, FR_U = 24 * MiB;

__device__ __forceinline__ unsigned f2bf(float f) { unsigned u = __builtin_bit_cast(unsigned, f); return (u + 0x7fffu + ((u >> 16) & 1u)) >> 16; }
typedef float f32x2_t_ __attribute__((ext_vector_type(2))); typedef __bf16 bf16x2_t_ __attribute__((ext_vector_type(2)));
__device__ __forceinline__ unsigned pk2(float lo, float hi) { const f32x2_t_ v = {lo, hi}; const bf16x2_t_ b = __builtin_convertvector(v, bf16x2_t_); return __builtin_bit_cast(unsigned, b); }
__device__ __forceinline__ float bflo(unsigned u) { return __builtin_bit_cast(float, u << 16); }
__device__ __forceinline__ float bfhi(unsigned u) { return __builtin_bit_cast(float, u & 0xffff0000u); }
__device__ __forceinline__ float bf2f(bf16 v) { return __builtin_bit_cast(float, (unsigned)v << 16); }
__device__ __forceinline__ float sigmoidf_(float x) { return __builtin_amdgcn_rcpf(1.f + __expf(-x)); }
__device__ __forceinline__ float siluf_(float x) { return x * __builtin_amdgcn_rcpf(1.f + __expf(-x)); }
__device__ __forceinline__ float geluf_(float x) { const float u = 1.5957691216057308f * (x + 0.044715f * x * x * x); return x * __builtin_amdgcn_rcpf(1.f + __expf(-u)); }
template <int CTRL, int ROWMASK> __device__ __forceinline__ float dpp_get(float v) { return __builtin_bit_cast(float, __builtin_amdgcn_update_dpp(0, __builtin_bit_cast(int, v), CTRL, ROWMASK, 0xF, false)); }
__device__ __forceinline__ float wave_sum(float v) {
    v += dpp_get<0xB1, 0xF>(v); v += dpp_get<0x4E, 0xF>(v); v += dpp_get<0x141, 0xF>(v); v += dpp_get<0x140, 0xF>(v);
    v += dpp_get<0x142, 0xA>(v); v += dpp_get<0x143, 0xC>(v);
    return __builtin_bit_cast(float, __builtin_amdgcn_readlane(__builtin_bit_cast(int, v), 63));
}
__device__ __forceinline__ f32x4 mfma16(bf16x8 a, bf16x8 b, f32x4 c) { return __builtin_amdgcn_mfma_f32_16x16x32_bf16(a, b, c, 0, 0, 0); }
__device__ __forceinline__ bf16x8 pack8(f32x4 a, f32x4 b) { u32x4 w; w.x = pk2(a.x, a.y); w.y = pk2(a.z, a.w); w.z = pk2(b.x, b.y); w.w = pk2(b.z, b.w); return __builtin_bit_cast(bf16x8, w); }

struct Params { const float* in[24]; float* out; unsigned char* ws; };

template <class F> struct EpiGen {
    static constexpr bool PERM = false, AFTER_DRAIN = false;
    F f;
    __device__ __forceinline__ void operator()(const pg8::f32x4 (&acc)[2][2][4][2], const pg8::Unit& u, int wr, int wc, int fr, int fq) const {
#pragma unroll
        for (int ai = 0; ai < 2; ++ai)
#pragma unroll
            for (int m = 0; m < 4; ++m) {
                const int row = u.pm * 256 + ai * 128 + wr * 64 + m * 16 + fr;
                const float ctx = f.rowctx(row); float ss = 0.f;
#pragma unroll
                for (int bj = 0; bj < 2; ++bj)
#pragma unroll
                    for (int n = 0; n < 2; ++n) ss += f(row, u.pn * 256 + bj * 128 + wc * 32 + n * 16 + 4 * fq, acc[ai][bj][m][n], ctx);
                if (F::STATS) { ss += __shfl_xor(ss, 16); ss += __shfl_xor(ss, 32); if (fq == 0) f.ss[(size_t)row * 16 + u.pn * 4 + wc] = ss; }
            }
    }
};
template <class F> struct EpiGen8 {
    static constexpr bool PERM = true, AFTER_DRAIN = false;
    F f;
    __device__ __forceinline__ void operator()(const pg8::f32x4 (&acc)[2][2][4][2], const pg8::Unit& u, int wr, int wc, int fr, int fq) const {
#pragma unroll
        for (int ai = 0; ai < 2; ++ai)
#pragma unroll
            for (int m = 0; m < 4; ++m) {
                const int row = u.pm * 256 + ai * 128 + wr * 64 + m * 16 + fr; const float ctx = f.rowctx(row); float ss = 0.f;
#pragma unroll
                for (int bj = 0; bj < 2; ++bj) ss += f.op8(row, u.pn * 256 + bj * 128 + wc * 32 + 8 * fq, acc[ai][bj][m][0], acc[ai][bj][m][1], ctx);
                if (F::STATS) { ss += __shfl_xor(ss, 16); ss += __shfl_xor(ss, 32); if (fq == 0) f.ss[(size_t)row * 16 + u.pn * 4 + wc] = ss; }
            }
    }
};
__device__ __forceinline__ float sum16(const float* p) { const f32x4 a = *(const f32x4*)p, b = *(const f32x4*)(p + 4), c = *(const f32x4*)(p + 8), d = *(const f32x4*)(p + 12);
    return ((a.x + a.y) + (a.z + a.w)) + ((b.x + b.y) + (b.z + b.w)) + ((c.x + c.y) + (c.z + c.w)) + ((d.x + d.y) + (d.z + d.w)); }
__device__ __forceinline__ void st_bf4(bf16* p, f32x4 v) { u32x2 w; w.x = pk2(v.x, v.y); w.y = pk2(v.z, v.w); *(u32x2*)p = w; }
__device__ __forceinline__ float dot4(f32x4 v) { return (v.x * v.x + v.y * v.y) + (v.z * v.z + v.w * v.w); }

struct F1 { static constexpr bool STATS = false; float* ss; const float* rs0; bf16* proj;
    __device__ __forceinline__ float rowctx(int row) const { return rs0[row]; }
    __device__ __forceinline__ float operator()(int row, int col, f32x4 a, float rs) const { f32x4 v = a * rs;
        if (col >= 2048) { v.x = geluf_(v.x); v.y = geluf_(v.y); v.z = geluf_(v.z); v.w = geluf_(v.w); }
        st_bf4(proj + (size_t)row * NIN + col, v); return 0.f; }
    __device__ __forceinline__ float op8(int row, int col, f32x4 a0, f32x4 a1, float rs) const { f32x4 v0 = a0 * rs, v1 = a1 * rs;
        if (col >= 2048) { v0.x = geluf_(v0.x); v0.y = geluf_(v0.y); v0.z = geluf_(v0.z); v0.w = geluf_(v0.w); v1.x = geluf_(v1.x); v1.y = geluf_(v1.y); v1.z = geluf_(v1.z); v1.w = geluf_(v1.w); }
        u32x4 w; w.x = pk2(v0.x, v0.y); w.y = pk2(v0.z, v0.w); w.z = pk2(v1.x, v1.y); w.w = pk2(v1.z, v1.w); *(u32x4*)(proj + (size_t)row * NIN + col) = w; return 0.f; } };
struct F2 { static constexpr bool STATS = true; float* ss; bf16* xb;
    __device__ __forceinline__ float rowctx(int) const { return 0.f; }
    __device__ __forceinline__ float operator()(int row, int col, f32x4 a, float) const { bf16* p = xb + (size_t)row * DM + col; const u32x2 r = *(const u32x2*)p;
        const f32x4 x = (f32x4){bflo(r.x) + a.x, bfhi(r.x) + a.y, bflo(r.y) + a.z, bfhi(r.y) + a.w}; st_bf4(p, x); return dot4(x); }
    __device__ __forceinline__ float op8(int row, int col, f32x4 a0, f32x4 a1, float) const { bf16* p = xb + (size_t)row * DM + col; const u32x4 r = *(const u32x4*)p;
        const f32x4 x0 = (f32x4){bflo(r.x) + a0.x, bfhi(r.x) + a0.y, bflo(r.y) + a0.z, bfhi(r.y) + a0.w}, x1 = (f32x4){bflo(r.z) + a1.x, bfhi(r.z) + a1.y, bflo(r.w) + a1.z, bfhi(r.w) + a1.w};
        u32x4 w; w.x = pk2(x0.x, x0.y); w.y = pk2(x0.z, x0.w); w.z = pk2(x1.x, x1.y); w.w = pk2(x1.z, x1.w); *(u32x4*)p = w; return dot4(x0) + dot4(x1); } };
struct F3 { static constexpr bool STATS = false; float* ss; const float* ss1; bf16* hid;
    __device__ __forceinline__ float rowctx(int row) const { return rsqrtf(sum16(ss1 + (size_t)row * 16) * (1.f / DM) + EPS); }
    __device__ __forceinline__ float operator()(int row, int col, f32x4 a, float rs) const { f32x4 v = a * rs; v.x = fmaxf(v.x, 0.f); v.y = fmaxf(v.y, 0.f); v.z = fmaxf(v.z, 0.f); v.w = fmaxf(v.w, 0.f);
        st_bf4(hid + (size_t)row * FF + col, v * v); return 0.f; }
    __device__ __forceinline__ float op8(int row, int col, f32x4 a0, f32x4 a1, float rs) const { f32x4 v0 = a0 * rs, v1 = a1 * rs;
        v0.x = fmaxf(v0.x, 0.f); v0.y = fmaxf(v0.y, 0.f); v0.z = fmaxf(v0.z, 0.f); v0.w = fmaxf(v0.w, 0.f); v1.x = fmaxf(v1.x, 0.f); v1.y = fmaxf(v1.y, 0.f); v1.z = fmaxf(v1.z, 0.f); v1.w = fmaxf(v1.w, 0.f);
        v0 = v0 * v0; v1 = v1 * v1; u32x4 w; w.x = pk2(v0.x, v0.y); w.y = pk2(v0.z, v0.w); w.z = pk2(v1.x, v1.y); w.w = pk2(v1.z, v1.w); *(u32x4*)(hid + (size_t)row * FF + col) = w; return 0.f; } };
struct F4 { static constexpr bool STATS = true; float* ss; bf16* xb;
    __device__ __forceinline__ float rowctx(int) const { return 0.f; }
    __device__ __forceinline__ float operator()(int row, int col, f32x4 a, float) const { bf16* p = xb + (size_t)row * DM + col; const u32x2 r = *(const u32x2*)p;
        const f32x4 x = (f32x4){bflo(r.x) + a.x, bfhi(r.x) + a.y, bflo(r.y) + a.z, bfhi(r.y) + a.w}; st_bf4(p, x); return dot4(x); }
    __device__ __forceinline__ float op8(int row, int col, f32x4 a0, f32x4 a1, float) const { bf16* p = xb + (size_t)row * DM + col; const u32x4 r = *(const u32x4*)p;
        const f32x4 x0 = (f32x4){bflo(r.x) + a0.x, bfhi(r.x) + a0.y, bflo(r.y) + a0.z, bfhi(r.y) + a0.w}, x1 = (f32x4){bflo(r.z) + a1.x, bfhi(r.z) + a1.y, bflo(r.w) + a1.z, bfhi(r.w) + a1.w};
        u32x4 w; w.x = pk2(x0.x, x0.y); w.y = pk2(x0.z, x0.w); w.z = pk2(x1.x, x1.y); w.w = pk2(x1.z, x1.w); *(u32x4*)p = w; return dot4(x0) + dot4(x1); } };
struct F5a { static constexpr bool STATS = false; float* ss; bf16* pp;
    __device__ __forceinline__ float rowctx(int) const { return 0.f; }
    __device__ __forceinline__ float operator()(int row, int col, f32x4 a, float) const { st_bf4(pp + (size_t)row * DM + col, a); return 0.f; }
    __device__ __forceinline__ float op8(int row, int col, f32x4 a0, f32x4 a1, float) const { u32x4 w; w.x = pk2(a0.x, a0.y); w.y = pk2(a0.z, a0.w); w.z = pk2(a1.x, a1.y); w.w = pk2(a1.z, a1.w);
        *(u32x4*)(pp + (size_t)row * DM + col) = w; return 0.f; } };
struct F5b { static constexpr bool STATS = true; float* ss; const float* ss2; const bf16* xb; const bf16* pp; bf16* x3;
    __device__ __forceinline__ float rowctx(int row) const { return rsqrtf(sum16(ss2 + (size_t)row * 16) * (1.f / DM) + EPS); }
    __device__ __forceinline__ float operator()(int row, int col, f32x4 a, float rs) const { const size_t o = (size_t)row * DM + col; const u32x2 pr = *(const u32x2*)(pp + o), xr = *(const u32x2*)(xb + o);
        f32x4 x; x.x = bflo(xr.x) + bflo(pr.x) * sigmoidf_(a.x * rs); x.y = bfhi(xr.x) + bfhi(pr.x) * sigmoidf_(a.y * rs); x.z = bflo(xr.y) + bflo(pr.y) * sigmoidf_(a.z * rs); x.w = bfhi(xr.y) + bfhi(pr.y) * sigmoidf_(a.w * rs);
        st_bf4(x3 + o, x); return dot4(x); } };

struct EpiFinal {
    static constexpr bool PERM = true, AFTER_DRAIN = true;
    const float* ss2; const bf16* xb; const bf16* pp; float* out; const float* gfin; unsigned* xbuf; unsigned* cnt;
    __device__ __forceinline__ void fused(pg8::f32x4 (&acc)[2][2][4][2], const pg8::Unit& u, int wr, int wc, int fr, int fq, LAS unsigned char* lds, int wid, int lane) const {
        LAS float* Pt = (LAS float*)lds; LAS float* St = (LAS float*)(lds + 4096);
#pragma unroll
        for (int ai = 0; ai < 2; ++ai)
#pragma unroll
            for (int m = 0; m < 4; ++m) {
                const int row_l = ai * 128 + wr * 64 + m * 16 + fr; const size_t row = (size_t)u.pm * 256 + row_l;
                const float rs = rsqrtf(sum16(ss2 + row * 16) * (1.f / DM) + EPS); float ss = 0.f;
#pragma unroll
                for (int bj = 0; bj < 2; ++bj) { const size_t o = row * DM + u.pn * 256 + bj * 128 + wc * 32 + 8 * fq; const u32x4 pr = *(const u32x4*)(pp + o), xr = *(const u32x4*)(xb + o);
                    const f32x4 a0 = acc[ai][bj][m][0], a1 = acc[ai][bj][m][1]; f32x4 x0, x1;
                    x0.x = bflo(xr.x) + bflo(pr.x) * sigmoidf_(a0.x * rs); x0.y = bfhi(xr.x) + bfhi(pr.x) * sigmoidf_(a0.y * rs); x0.z = bflo(xr.y) + bflo(pr.y) * sigmoidf_(a0.z * rs); x0.w = bfhi(xr.y) + bfhi(pr.y) * sigmoidf_(a0.w * rs);
                    x1.x = bflo(xr.z) + bflo(pr.z) * sigmoidf_(a1.x * rs); x1.y = bfhi(xr.z) + bfhi(pr.z) * sigmoidf_(a1.y * rs); x1.z = bflo(xr.w) + bflo(pr.w) * sigmoidf_(a1.z * rs); x1.w = bfhi(xr.w) + bfhi(pr.w) * sigmoidf_(a1.w * rs);
                    acc[ai][bj][m][0] = x0; acc[ai][bj][m][1] = x1; ss += dot4(x0) + dot4(x1); }
                ss += __shfl_xor(ss, 16); ss += __shfl_xor(ss, 32);
                if (fq == 0) Pt[row_l * 4 + wc] = ss;
            }
        asm volatile("s_waitcnt lgkmcnt(0)" ::: "memory"); __builtin_amdgcn_s_barrier(); asm volatile("" ::: "memory");
        const int rl = wid * 32 + (lane & 31);
        if (lane < 32) { const f32x4 p4 = *(const LAS f32x4*)(Pt + rl * 4); const float tot = (p4.x + p4.y) + (p4.z + p4.w);
            __hip_atomic_store(xbuf + ((size_t)u.pm * 256 + rl) * 4 + u.pn, __builtin_bit_cast(unsigned, tot), __ATOMIC_RELAXED, __HIP_MEMORY_SCOPE_AGENT); }
        asm volatile("s_waitcnt vmcnt(0)" ::: "memory");
        if (lane == 0) __hip_atomic_fetch_add(cnt + 64 * u.pm, 1u, __ATOMIC_RELAXED, __HIP_MEMORY_SCOPE_AGENT);
        if (wid == 0) {
            unsigned sp = 0;
            while ((unsigned)__builtin_amdgcn_readfirstlane(__hip_atomic_load(cnt + 64 * u.pm, __ATOMIC_RELAXED, __HIP_MEMORY_SCOPE_AGENT)) < 32u) { __builtin_amdgcn_s_sleep(2); if (++sp > (1u << 22)) break; }
            __builtin_amdgcn_fence(__ATOMIC_ACQUIRE, "agent");
        }
        asm volatile("s_waitcnt vmcnt(0) lgkmcnt(0)" ::: "memory"); __builtin_amdgcn_s_barrier(); asm volatile("" ::: "memory");
        if (lane < 32) { float t = 0.f;
#pragma unroll
            for (int k = 0; k < 4; ++k) t += __builtin_bit_cast(float, __hip_atomic_load(xbuf + ((size_t)u.pm * 256 + rl) * 4 + k, __ATOMIC_RELAXED, __HIP_MEMORY_SCOPE_AGENT));
            St[rl] = rsqrtf(t * (1.f / DM) + EPS); }
        asm volatile("s_waitcnt lgkmcnt(0)" ::: "memory"); __builtin_amdgcn_s_barrier(); asm volatile("" ::: "memory");
#pragma unroll
        for (int ai = 0; ai < 2; ++ai)
#pragma unroll
            for (int m = 0; m < 4; ++m) {
                const int row_l = ai * 128 + wr * 64 + m * 16 + fr; const size_t row = (size_t)u.pm * 256 + row_l; const float r = St[row_l];
#pragma unroll
                for (int bj = 0; bj < 2; ++bj)
#pragma unroll
                    for (int n = 0; n < 2; ++n) { const int col = u.pn * 256 + bj * 128 + wc * 32 + 8 * fq + 4 * n;
                        *(f32x4*)(out + row * DM + col) = acc[ai][bj][m][n] * r * *(const f32x4*)(gfin + col); }
            }
    }
};

template <int RT, int UNR, class F> __device__ __forceinline__ void small_gemm(const bf16* A, const bf16* Bt, int N, int K, const F& f, LAS unsigned char* lds, int bid, int G, int wave, int lane) {
    const int c = lane & 15, q = lane >> 4; constexpr int NMH = 8 / RT; const int ntask = NMH * (N >> 6); const int kw = K >> 3;
    LAS f32x4* red = (LAS f32x4*)lds;
    for (int t = bid; t < ntask; t += G) {
        const int mh = t % NMH, ns = t / NMH;
        const bf16* ap = A + (size_t)(mh * RT * 16 + c) * K + wave * kw + 8 * q;
        const bf16* bp = Bt + (size_t)(ns * 64 + c) * K + wave * kw + 8 * q;
        f32x4 acc[RT][4];
#pragma unroll
        for (int i = 0; i < RT; ++i)
#pragma unroll
            for (int j = 0; j < 4; ++j) acc[i][j] = (f32x4){0.f, 0.f, 0.f, 0.f};
#pragma unroll UNR
        for (int k = 0; k < kw; k += 32) {
            bf16x8 a[RT], b[4];
#pragma unroll
            for (int i = 0; i < RT; ++i) a[i] = *(const bf16x8*)(ap + (size_t)i * 16 * K + k);
#pragma unroll
            for (int j = 0; j < 4; ++j) b[j] = *(const bf16x8*)(bp + (size_t)j * 16 * K + k);
#pragma unroll
            for (int i = 0; i < RT; ++i)
#pragma unroll
                for (int j = 0; j < 4; ++j) acc[i][j] = mfma16(b[j], a[i], acc[i][j]);
        }
#pragma unroll
        for (int i = 0; i < RT; ++i)
#pragma unroll
            for (int j = 0; j < 4; ++j) red[(wave * (RT * 4) + i * 4 + j) * 64 + lane] = acc[i][j];
        __syncthreads();
        if (wave < RT) {
            const int i = wave; const int row = MPR + mh * RT * 16 + i * 16 + c; const float ctx = f.rowctx(row); float ss = 0.f;
#pragma unroll
            for (int j = 0; j < 4; ++j) { f32x4 s = red[(i * 4 + j) * 64 + lane];
#pragma unroll
                for (int w = 1; w < 8; ++w) s += red[(w * (RT * 4) + i * 4 + j) * 64 + lane];
                ss += f(row, ns * 64 + j * 16 + 4 * q, s, ctx); }
            if (F::STATS) { ss += __shfl_xor(ss, 16); ss += __shfl_xor(ss, 32); if (q == 0) f.ss[(size_t)row * 16 + ns] = ss; }
        }
        __syncthreads();
    }
}

__device__ __forceinline__ void tr_item(const float* __restrict__ W, int N, int src_c0, bf16* WT, int K, int dst_r0, const float* __restrict__ gain, LAS float* scr, int k0, int lane) {
    const float gv = gain ? gain[k0 + lane] : 1.f;
    f32x4 wv[8];
#pragma unroll
    for (int i = 0; i < 8; ++i) wv[i] = *(const f32x4*)(W + (size_t)(k0 + 8 * i + (lane >> 3)) * N + src_c0 + 4 * (lane & 7));
#pragma unroll
    for (int i = 0; i < 8; ++i) {
        float g = 0.f;
#pragma unroll
        for (int r = 0; r < 8; ++r) { const float gr = __builtin_bit_cast(float, __builtin_amdgcn_readlane(__builtin_bit_cast(int, gv), 8 * i + r)); g = ((lane >> 3) == r) ? gr : g; }
        LAS float* d = scr + (8 * i + (lane >> 3)) * 33 + 4 * (lane & 7);
        d[0] = wv[i].x * g; d[1] = wv[i].y * g; d[2] = wv[i].z * g; d[3] = wv[i].w * g;
    }
    LDS_WAIT();
    const int c = lane & 7;
#pragma unroll
    for (int j = 0; j < 4; ++j) { const int n = (lane >> 3) + 8 * j; const LAS float* s = scr + (8 * c) * 33 + n;
        u32x4 o; o.x = pk2(s[0], s[33]); o.y = pk2(s[66], s[99]); o.z = pk2(s[132], s[165]); o.w = pk2(s[198], s[231]);
        *(u32x4*)(WT + (size_t)(dst_r0 + n) * K + k0 + 8 * c) = o; }
    LDS_WAIT();
}

__device__ __forceinline__ void weight_items(const Params& P, LAS float* scr, int lane, int first, int last, int start, int stride) {
    unsigned char* ws = P.ws; const float* w_in = P.in[7]; const float* g_mix = P.in[6];
    for (int it = first + start; it < last; it += stride) {
        int r = it;
        if (r < 1536) { const int nb = r >> 4, kb = r & 15; tr_item(w_in, SRCN, nb * 32 + (nb >= 64 ? 8 : 0), (bf16*)(ws + WS_WIN), 1024, nb * 32, g_mix, scr, kb * 64, lane); continue; } r -= 1536;
        if (r < 512) { const int nb = r >> 4, kb = r & 15; tr_item(P.in[16], 1024, nb * 32, (bf16*)(ws + WS_WOUT), 1024, nb * 32, nullptr, scr, kb * 64, lane); continue; } r -= 512;
        if (r < 2048) { const int nb = r >> 4, kb = r & 15; tr_item(P.in[18], 4096, nb * 32, (bf16*)(ws + WS_WUP), 1024, nb * 32, P.in[17], scr, kb * 64, lane); continue; } r -= 2048;
        if (r < 2048) { const int nb = r >> 6, kb = r & 63; tr_item(P.in[19], 1024, nb * 32, (bf16*)(ws + WS_WDN), 4096, nb * 32, nullptr, scr, kb * 64, lane); continue; } r -= 2048;
        if (r < 512) { const int nb = r >> 4, kb = r & 15; tr_item(P.in[22], 1024, nb * 32, (bf16*)(ws + WS_WG), 1024, nb * 32, P.in[20], scr, kb * 64, lane); continue; } r -= 512;
        { const int nb = r >> 2, kb = r & 3; tr_item(P.in[21], 1024, nb * 32, (bf16*)(ws + WS_WPLE), 256, nb * 32, nullptr, scr, kb * 64, lane); }
    }
}

__device__ __forceinline__ void phase0(const Params& P, LAS unsigned char* lds, int tid, int lane, int wave, int bid, int G) {
    unsigned char* ws = P.ws; const int gw = bid * 8 + wave, NGW = G * 8, gt = bid * 512 + tid, NGT = G * 512;
    const float* w_in = P.in[7]; const float* g_mix = P.in[6];
    LAS f32x4* W8 = (LAS f32x4*)(lds + 67584);
    for (int idx = tid; idx < 2048; idx += 512) {
        const int l = idx & 63, half = (idx >> 6) & 1, je = idx >> 7; const int k = 256 * (je >> 2) + 4 * l + (je & 3);
        const float g = g_mix[k]; const float* s = w_in + (size_t)k * SRCN + 2048 + 4 * half;
        W8[idx] = (f32x4){s[0] * g, s[1] * g, s[2] * g, s[3] * g};
    }
    { const float* w_s = P.in[14]; bf16* WSB = (bf16*)(ws + WS_WSB);
      for (int i = gt; i < 65536; i += NGT) { const int t = (i >> 7) & 127, s = i & 127; WSB[i] = (bf16)f2bf(s <= t ? w_s[i] : 0.f); } }
    { bf16* PB = (bf16*)(ws + WS_PB); const float* pp = P.in[4]; const float* ps = P.in[5];
      for (int i = gt; i < MT * 32; i += NGT) { const int row = i >> 5, c8 = i & 31; const float* src = row < MPR ? pp + (size_t)row * DPLE + c8 * 8 : ps + (size_t)(row - MPR) * DPLE + c8 * 8;
          const f32x4 a = *(const f32x4*)src, b = *(const f32x4*)(src + 4); u32x4 o; o.x = pk2(a.x, a.y); o.y = pk2(a.z, a.w); o.z = pk2(b.x, b.y); o.w = pk2(b.z, b.w); *(u32x4*)(PB + (size_t)i * 8) = o; } }
    weight_items(P, (LAS float*)(lds + wave * 8448), lane, 0, 1536, gw, NGW);
    __syncthreads();
    float* RS0 = (float*)(ws + WS_RS0); float* BETA = (float*)(ws + WS_BETA); float* GG = (float*)(ws + WS_G); bf16* XB = (bf16*)(ws + WS_XB);
    const float* a_log = P.in[9]; const float* dt_bias = P.in[10];
    f32x4 vnx[4];
    { const int row = gw < MT ? gw : MT - 1; const float* xr = row < MPR ? P.in[0] + (size_t)row * DM : P.in[1] + (size_t)(row - MPR) * DM;
#pragma unroll
      for (int j = 0; j < 4; ++j) vnx[j] = *(const f32x4*)(xr + 256 * j + 4 * lane); }
    for (int row = gw; row < MT; row += NGW) {
        f32x4 v[4]; float ss = 0.f;
#pragma unroll
        for (int j = 0; j < 4; ++j) { v[j] = vnx[j]; ss += dot4(v[j]); }
        { const int rn = (row + NGW < MT) ? row + NGW : row; const float* xr = rn < MPR ? P.in[0] + (size_t)rn * DM : P.in[1] + (size_t)(rn - MPR) * DM;
#pragma unroll
          for (int j = 0; j < 4; ++j) vnx[j] = *(const f32x4*)(xr + 256 * j + 4 * lane); }
#pragma unroll
        for (int j = 0; j < 4; ++j) st_bf4(XB + (size_t)row * DM + 256 * j + 4 * lane, v[j]);
        f32x4 d0 = (f32x4){0.f, 0.f, 0.f, 0.f}, d1 = d0;
#pragma unroll
        for (int j = 0; j < 4; ++j)
#pragma unroll
            for (int e = 0; e < 4; ++e) { const float xv = v[j][e]; d0 += W8[((j * 4 + e) * 2 + 0) * 64 + lane] * xv; d1 += W8[((j * 4 + e) * 2 + 1) * 64 + lane] * xv; }
        const bool b0 = lane & 1, b1 = lane & 2, b2 = lane & 4;
        float t0 = (b0 ? d1.x : d0.x) + __shfl_xor(b0 ? d0.x : d1.x, 1), t1 = (b0 ? d1.y : d0.y) + __shfl_xor(b0 ? d0.y : d1.y, 1);
        float t2 = (b0 ? d1.z : d0.z) + __shfl_xor(b0 ? d0.z : d1.z, 1), t3 = (b0 ? d1.w : d0.w) + __shfl_xor(b0 ? d0.w : d1.w, 1);
        float u0 = (b1 ? t2 : t0) + __shfl_xor(b1 ? t0 : t2, 2), u1 = (b1 ? t3 : t1) + __shfl_xor(b1 ? t1 : t3, 2);
        float w = (b2 ? u1 : u0) + __shfl_xor(b2 ? u0 : u1, 4);
        w += __shfl_xor(w, 8); w += __shfl_xor(w, 16); w += __shfl_xor(w, 32);
        ss = wave_sum(ss); const float rs = rsqrtf(ss * (1.f / DM) + EPS);
        if (lane < 8) { const int hh = 2 * ((lane >> 1) & 1) + ((lane >> 2) & 1);
            if (!(lane & 1)) BETA[(size_t)row * 4 + hh] = sigmoidf_(w * rs);
            else { const float xa = w * rs + dt_bias[hh]; const float sp = fmaxf(xa, 0.f) + log1pf(expf(-fabsf(xa))); GG[(size_t)row * 4 + hh] = -expf(a_log[hh]) * sp; } }
        if (lane == 0) RS0[row] = rs;
    }
}

__device__ __forceinline__ void gdn_prep(const Params& P, LAS unsigned char* lds, int tid, int lane, int wave, int bid, int G) {
    unsigned char* ws = P.ws; const bf16* PROJ = (const bf16*)(ws + WS_PROJ); const float* BETA = (const float*)(ws + WS_BETA); const float* GG = (const float*)(ws + WS_G);
    bf16* FRB = (bf16*)P.out; bf16* ATf = (bf16*)(ws + WS_AT); float* DECF = (float*)(ws + WS_DECF); const float* wconv = P.in[8];
    const int tid0 = tid;
    for (int u0 = bid * 2; u0 < 1024; u0 += G * 2) {
        int tid = tid0; asm volatile("" : "+v"(tid));
        const int lane = tid & 63, wv = __builtin_amdgcn_readfirstlane(tid >> 6), hb = wv >> 2, t = tid & 255, w4 = wv & 3, c = lane & 15, q = lane >> 4;
        LAS unsigned char* base = lds + hb * 70656;
        LAS bf16* q_l = (LAS bf16*)base; LAS bf16* k_l = (LAS bf16*)(base + 17408); LAS bf16* v_l = (LAS bf16*)(base + 34816);
        LAS float* A_l = (LAS float*)(base + 52224); LAS float* gc = (LAS float*)(base + 69632); LAS float* bt = gc + 64;
        const int unit = u0 + hb, cg = unit >> 2, h = unit & 3, n = cg & 31; const int row0 = cg * 64, tokb = 16 * w4;
        float y[3][16][2];
#pragma unroll
        for (int g3 = 0; g3 < 3; ++g3) {
            const int col = g3 * 512 + h * 128 + 2 * lane;
            const float w0a = wconv[col], w0b = wconv[col + 1], w1a = wconv[1536 + col], w1b = wconv[1536 + col + 1], w2a = wconv[3072 + col], w2b = wconv[3072 + col + 1], w3a = wconv[4608 + col], w3b = wconv[4608 + col + 1];
            const bf16* src = PROJ + (size_t)(row0 + tokb) * NIN + col;
            unsigned raw[19];
            const bool nohist = (n == 0 && w4 == 0);
#pragma unroll
            for (int i = 0; i < 19; ++i) raw[i] = (i < 3 && nohist) ? 0u : *(const unsigned*)(src + (ptrdiff_t)(i - 3) * NIN);
            typedef float f32x2c __attribute__((ext_vector_type(2)));
            const f32x2c w0 = (f32x2c){w0a, w0b}, w1 = (f32x2c){w1a, w1b}, w2 = (f32x2c){w2a, w2b}, w3 = (f32x2c){w3a, w3b};
            f32x2c xr2[19];
#pragma unroll
            for (int i = 0; i < 19; ++i) xr2[i] = (f32x2c){bflo(raw[i]), bfhi(raw[i])};
#pragma unroll
            for (int i = 0; i < 16; ++i) { const f32x2c yy = w0 * xr2[i] + w1 * xr2[i + 1] + w2 * xr2[i + 2] + w3 * xr2[i + 3];
                y[g3][i][0] = siluf_(yy.x); y[g3][i][1] = siluf_(yy.y); }
        }
#pragma unroll
        for (int g3 = 0; g3 < 2; ++g3)
#pragma unroll
            for (int i = 0; i < 16; ++i) { const float s = wave_sum(y[g3][i][0] * y[g3][i][0] + y[g3][i][1] * y[g3][i][1]); const float r = rsqrtf(s + 1e-6f); y[g3][i][0] *= r; y[g3][i][1] *= r; }
#pragma unroll
        for (int i = 0; i < 16; ++i) {
            *(LAS unsigned*)(q_l + (tokb + i) * 136 + 2 * lane) = pk2(y[0][i][0], y[0][i][1]);
            *(LAS unsigned*)(k_l + (tokb + i) * 136 + 2 * lane) = pk2(y[1][i][0], y[1][i][1]);
            *(LAS unsigned*)(v_l + (tokb + i) * 136 + 2 * lane) = pk2(y[2][i][0], y[2][i][1]);
        }
        if (w4 == 0) {
            int lane = tid; asm volatile("" : "+v"(lane)); lane &= 63;
            float g = GG[(size_t)(row0 + lane) * 4 + h];
#pragma unroll
            for (int o = 1; o < 64; o <<= 1) { const float tt = __shfl_up(g, o); if (lane >= o) g += tt; }
            const float btv = BETA[(size_t)(row0 + lane) * 4 + h]; gc[lane] = g; bt[lane] = btv; gc[128 + lane] = btv * __expf(g); gc[192 + lane] = __expf(__shfl(g, 63) - g);
            const float dl = __expf(__shfl(g, 63));
            *(f32x4*)(DECF + (size_t)unit * 256 + lane * 4) = (f32x4){dl, dl, dl, dl};
        }
        __syncthreads();
        {
            const int it = w4; bf16x8 qf[4], kif[4];
#pragma unroll
            for (int kd = 0; kd < 4; ++kd) { qf[kd] = *(const LAS bf16x8*)(q_l + (16 * it + c) * 136 + 32 * kd + 8 * q); kif[kd] = *(const LAS bf16x8*)(k_l + (16 * it + c) * 136 + 32 * kd + 8 * q); }
            const int ii = 16 * it + c; const float gci = gc[ii];
            float atv[2][8];
#pragma unroll
            for (int jt = 0; jt < 4; ++jt) {
                if (jt <= it) {
                    f32x4 aq = (f32x4){0.f, 0.f, 0.f, 0.f}, ak = aq;
#pragma unroll
                    for (int kd = 0; kd < 4; ++kd) { const bf16x8 kjf = *(const LAS bf16x8*)(k_l + (16 * jt + c) * 136 + 32 * kd + 8 * q); aq = mfma16(kjf, qf[kd], aq); ak = mfma16(kif[kd], kjf, ak); }
                    const f32x4 gj = *(const LAS f32x4*)(gc + 16 * jt + 4 * q); f32x4 av;
                    const f32x4 gi4 = *(const LAS f32x4*)(gc + 16 * it + 4 * q), bi4 = *(const LAS f32x4*)(bt + 16 * it + 4 * q); const float gcj = gc[16 * jt + c];
#pragma unroll
                    for (int r = 0; r < 4; ++r) { const int j = 16 * jt + 4 * q + r; const float dec = (j <= ii) ? __expf(gci - gj[r]) : 0.f;
                        atv[jt >> 1][(jt & 1) * 4 + r] = aq[r] * dec * QSCALE;
                        const int i2 = 16 * it + 4 * q + r, j2 = 16 * jt + c; av[r] = (j2 < i2) ? ak[r] * bi4[r] * __expf(gi4[r] - gcj) : 0.f; }
                    *(LAS f32x4*)(A_l + (16 * jt + c) * 68 + 16 * it + 4 * q) = av;
                } else {
#pragma unroll
                    for (int r = 0; r < 4; ++r) atv[jt >> 1][(jt & 1) * 4 + r] = 0.f;
                }
            }
#pragma unroll
            for (int ks = 0; ks < 2; ++ks) { u32x4 o; o.x = pk2(atv[ks][0], atv[ks][1]); o.y = pk2(atv[ks][2], atv[ks][3]); o.z = pk2(atv[ks][4], atv[ks][5]); o.w = pk2(atv[ks][6], atv[ks][7]);
                *(u32x4*)(ATf + ((size_t)unit * 8 + it * 2 + ks) * 512 + lane * 8) = o; }
        }
        {
            const float gl = gc[63];
#pragma unroll
            for (int e = 0; e < 4; ++e) {
                const int f = w4 + 4 * e;
                { const int mt = f >> 2, ks = f & 3, tok = 16 * mt + c; const float sc = __expf(gc[tok]) * QSCALE;
                  const u32x2 lo = *(const LAS u32x2*)(q_l + tok * 136 + 32 * ks + 4 * q), hi = *(const LAS u32x2*)(q_l + tok * 136 + 32 * ks + 16 + 4 * q);
                  u32x4 o; o.x = pk2(bflo(lo.x) * sc, bfhi(lo.x) * sc); o.y = pk2(bflo(lo.y) * sc, bfhi(lo.y) * sc); o.z = pk2(bflo(hi.x) * sc, bfhi(hi.x) * sc); o.w = pk2(bflo(hi.y) * sc, bfhi(hi.y) * sc);
                  *(u32x4*)(FRB + FR_QG + (size_t)unit * 8192 + f * 512 + lane * 8) = o; }
                { const int mt = f >> 1, ks2 = f & 1; float kv[8];
#pragma unroll
                  for (int jj = 0; jj < 8; ++jj) { const int tok = 32 * ks2 + 16 * (jj >> 2) + 4 * q + (jj & 3); kv[jj] = bf2f(k_l[tok * 136 + 16 * mt + c]) * gc[192 + tok]; }
                  u32x4 o; o.x = pk2(kv[0], kv[1]); o.y = pk2(kv[2], kv[3]); o.z = pk2(kv[4], kv[5]); o.w = pk2(kv[6], kv[7]);
                  *(u32x4*)(FRB + FR_KG + (size_t)unit * 8192 + f * 512 + lane * 8) = o; }
            }
        }
        int t5 = t; asm volatile("" : "+v"(t5));
        const int col = t5 & 127, kind = __builtin_amdgcn_readfirstlane(t5 >> 7);
        typedef float f32x2s __attribute__((ext_vector_type(2)));
        f32x2s sp[32];
        {
            const LAS bf16* srcl = kind ? k_l : v_l;
#pragma unroll
            for (int i = 0; i < 64; ++i) { const float m = (kind ? gc + 128 : bt)[i]; sp[i >> 1][i & 1] = bf2f(srcl[i * 136 + col]) * m; }
        }
        __syncthreads();
        {
#pragma clang loop unroll(full)
            for (int j = 0; j < 63; ++j) {
                f32x4 avc[16];
#pragma unroll
                for (int v = (j + 1) >> 2; v < 16; ++v) avc[v] = *(const LAS f32x4*)(A_l + j * 68 + 4 * v);
                __builtin_amdgcn_sched_barrier(0);
                const float sj = sp[j >> 1][j & 1]; const f32x2s sj2 = (f32x2s){sj, sj};
#pragma unroll
                for (int v = (j + 1) >> 2; v < 16; ++v) { const f32x4 a = avc[v];
                    sp[2 * v] -= (f32x2s){a.x, a.y} * sj2; sp[2 * v + 1] -= (f32x2s){a.z, a.w} * sj2; }
                __builtin_amdgcn_sched_barrier(0);
            }
        }
        {
            LAS bf16* dstl = kind ? k_l : v_l;
#pragma unroll
            for (int i = 0; i < 64; ++i) dstl[i * 136 + col] = (bf16)f2bf(sp[i >> 1][i & 1]);
        }
        __syncthreads();
        { int l7 = tid; asm volatile("" : "+v"(l7)); const int c = l7 & 15, q = (l7 >> 4) & 3, lane = l7 & 63;
#pragma unroll
        for (int e = 0; e < 4; ++e) { const int f = w4 + 4 * e, mt = f >> 2, ks = f & 3, tok = 16 * mt + c;
            const u32x2 lo = *(const LAS u32x2*)(k_l + tok * 136 + 32 * ks + 4 * q), hi = *(const LAS u32x2*)(k_l + tok * 136 + 32 * ks + 16 + 4 * q);
            *(u32x4*)(FRB + FR_W + (size_t)unit * 8192 + f * 512 + lane * 8) = (u32x4){lo.x, lo.y, hi.x, hi.y}; }
#pragma unroll
        for (int e = 0; e < 8; ++e) { const int f = w4 + 4 * e, sl = f >> 2, mt = f & 3; const LAS bf16* s = v_l + (16 * mt + 4 * q) * 136 + 16 * sl + c;
            u32x2 o; o.x = (unsigned)s[0] | ((unsigned)s[136] << 16); o.y = (unsigned)s[272] | ((unsigned)s[408] << 16);
            *(u32x2*)(FRB + FR_U + ((size_t)unit * 32 + f) * 256 + lane * 4) = o; }
        }
        __syncthreads();
    }
}

__device__ __forceinline__ void sgu_prompt(const Params& P, LAS unsigned char* lds, int tid, int lane, int wave, int bid, int G) {
    asm volatile("" : "+v"(tid)); lane = tid & 63;
    unsigned char* ws = P.ws; const bf16* PROJ = (const bf16*)(ws + WS_PROJ); bf16* MIX = (bf16*)(ws + WS_MIX); const bf16* WSB = (const bf16*)(ws + WS_WSB);
    const float* lng = P.in[12]; const float* lnb = P.in[13]; const float* b_s = P.in[15];
    LAS bf16* vgT = (LAS bf16*)lds; const int c = lane & 15, q = lane >> 4;
    float lg[8], lb[8];
#pragma unroll
    for (int e = 0; e < 8; ++e) { lg[e] = lng[8 * lane + e]; lb[e] = lnb[8 * lane + e]; }
    for (int su = bid; su < 256; su += G) {
        const int hp = (su >> 3) & 1, bn = (su & 7) | ((su >> 4) << 3), b = bn >> 4, n = bn & 15; const int row0 = b * 2048 + n * 128;
        u32x4 rawv[16];
#pragma unroll
        for (int i = 0; i < 16; ++i) rawv[i] = *(const u32x4*)(PROJ + (size_t)(row0 + 16 * wave + i) * NIN + 2560 + 8 * lane);
        unsigned pkv[8][8];
#pragma unroll
        for (int i2 = 0; i2 < 8; ++i2) {
            float xa[8], xb2[8];
#pragma unroll
            for (int hh = 0; hh < 2; ++hh) {
                const u32x4 raw = rawv[2 * i2 + hh];
                float x[8] = {bflo(raw.x), bfhi(raw.x), bflo(raw.y), bfhi(raw.y), bflo(raw.z), bfhi(raw.z), bflo(raw.w), bfhi(raw.w)};
                float s = 0.f;
#pragma unroll
                for (int e = 0; e < 8; ++e) s += x[e];
                const float mean = wave_sum(s) * (1.f / 512.f); float s2 = 0.f;
#pragma unroll
                for (int e = 0; e < 8; ++e) { x[e] -= mean; s2 += x[e] * x[e]; }
                const float rstd = rsqrtf(wave_sum(s2) * (1.f / 512.f) + EPS);
#pragma unroll
                for (int e = 0; e < 8; ++e) { const float vn_ = x[e] * rstd * lg[e] + lb[e]; if (hh == 0) xa[e] = vn_; else xb2[e] = vn_; }
            }
#pragma unroll
            for (int e = 0; e < 8; ++e) pkv[e][i2] = pk2(xa[e], xb2[e]);
        }
        if ((q >> 1) == hp) {
#pragma unroll
            for (int e = 0; e < 8; ++e) {
                LAS bf16* rowp = vgT + (q & 1) * 17408 + (8 * c + e) * 136;
                *(LAS u32x4*)(rowp + 8 * ((2 * wave) ^ c)) = (u32x4){pkv[e][0], pkv[e][1], pkv[e][2], pkv[e][3]};
                *(LAS u32x4*)(rowp + 8 * ((2 * wave + 1) ^ c)) = (u32x4){pkv[e][4], pkv[e][5], pkv[e][6], pkv[e][7]};
            }
        }
        __syncthreads();
#pragma unroll 1
        for (int hh = 0; hh < 2; ++hh) { const int h = 2 * hp + hh; const LAS bf16* vgh = vgT + hh * 17408;
        f32x4 acc[8]; u32x2 upre[8]; const float bias_pre = b_s[h * 128 + 16 * wave + c];
#pragma unroll
        for (int nt = 0; nt < 8; ++nt) { acc[nt] = (f32x4){0.f, 0.f, 0.f, 0.f}; upre[nt] = *(const u32x2*)(PROJ + ((size_t)row0 + 16 * wave + c) * NIN + 2048 + h * 128 + 16 * nt + 4 * q); }
        for (int ks = 0; ks <= (wave >> 1); ++ks) {
            const bf16x8 bfr = *(const bf16x8*)(WSB + (size_t)(h * 128 + 16 * wave + c) * 128 + 32 * ks + 8 * q);
#pragma unroll
            for (int nt = 0; nt < 8; ++nt) { const int d = 16 * nt + c; const bf16x8 afr = *(const LAS bf16x8*)(vgh + d * 136 + 8 * ((4 * ks + q) ^ ((d >> 3) & 15))); acc[nt] = mfma16(afr, bfr, acc[nt]); }
        }
        { const int tt = 16 * wave + c; const size_t row = (size_t)row0 + tt; const float bias = bias_pre;
#pragma unroll
          for (int nt = 0; nt < 8; ++nt) { const int d0 = 16 * nt + 4 * q; const u32x2 ur = upre[nt];
              f32x4 o; o.x = bflo(ur.x) * (acc[nt].x + bias); o.y = bfhi(ur.x) * (acc[nt].y + bias); o.z = bflo(ur.y) * (acc[nt].z + bias); o.w = bfhi(ur.y) * (acc[nt].w + bias);
              st_bf4(MIX + row * DM + 512 + h * 128 + d0, o); } }
        }
        __syncthreads();
    }
}

__device__ __forceinline__ void sample_gdn(const Params& P, LAS unsigned char* lds, int tid, int lane, int wave, int bid, int G) {
    asm volatile("" : "+v"(tid)); lane = tid & 63;
    unsigned char* ws = P.ws; const bf16* PROJ = (const bf16*)(ws + WS_PROJ); bf16* MIX = (bf16*)(ws + WS_MIX); const float* BETA = (const float*)(ws + WS_BETA); const float* GG = (const float*)(ws + WS_G);
    const float* sconv = P.in[2]; const float* sgdn = P.in[3]; const float* wconv = P.in[8]; const float* gnorm = P.in[11];
    float* NCS = P.out + O_NCS; float* NGS = P.out + O_NGS;
    LAS float* sm = (LAS float*)lds; LAS float* scal = sm + 384; LAS f32x4* red = (LAS f32x4*)(sm + 512);
    const int dv4 = tid & 31, dkg = tid >> 5;
    for (int su = bid; su < 512; su += G) {
        const int bs = su >> 2, h = su & 3; const size_t srow = (size_t)MPR + bs;
        const float* S0 = sgdn + (size_t)(bs * 4 + h) * 16384 + (size_t)(8 * dkg) * 128 + 4 * dv4;
        f32x4 s0[8];
#pragma unroll
        for (int i = 0; i < 8; ++i) s0[i] = *(const f32x4*)(S0 + (size_t)i * 128);
        if (tid < 384) { const int g3 = tid >> 7, ch = tid & 127, col = g3 * 512 + h * 128 + ch;
            const float x = bf2f(PROJ[srow * NIN + col]); const float h0 = sconv[(size_t)(bs * 3 + 0) * 1536 + col], h1 = sconv[(size_t)(bs * 3 + 1) * 1536 + col], h2 = sconv[(size_t)(bs * 3 + 2) * 1536 + col];
            const float yv = siluf_(wconv[col] * h0 + wconv[1536 + col] * h1 + wconv[3072 + col] * h2 + wconv[4608 + col] * x);
            NCS[(size_t)(bs * 3 + 0) * 1536 + col] = h1; NCS[(size_t)(bs * 3 + 1) * 1536 + col] = h2; NCS[(size_t)(bs * 3 + 2) * 1536 + col] = x;
            sm[g3 * 128 + ch] = yv; }
        __syncthreads();
        if (wave < 2) { const float a = sm[wave * 128 + lane], b2 = sm[wave * 128 + 64 + lane]; const float s = wave_sum(a * a + b2 * b2); if (lane == 0) scal[wave] = rsqrtf(s + 1e-6f); }
        __syncthreads();
        const float qn = scal[0], kn = scal[1];
        const float beta = BETA[srow * 4 + h], eg = __expf(GG[srow * 4 + h]);
        float kk[8], qq[8]; f32x4 p = (f32x4){0.f, 0.f, 0.f, 0.f};
#pragma unroll
        for (int i = 0; i < 8; ++i) { kk[i] = sm[128 + 8 * dkg + i] * kn; qq[i] = sm[8 * dkg + i] * qn; p += s0[i] * kk[i]; }
        red[dkg * 32 + dv4] = p;
        __syncthreads();
        f32x4 kS = red[dv4];
#pragma unroll
        for (int g = 1; g < 16; ++g) kS += red[g * 32 + dv4];
        const f32x4 v4 = *(const LAS f32x4*)(sm + 256 + 4 * dv4); const f32x4 vnew = (v4 - kS * eg) * beta;
        __syncthreads();
        f32x4 po = (f32x4){0.f, 0.f, 0.f, 0.f}; float* S1 = NGS + (size_t)(bs * 4 + h) * 16384 + (size_t)(8 * dkg) * 128 + 4 * dv4;
#pragma unroll
        for (int i = 0; i < 8; ++i) { const f32x4 s1 = s0[i] * eg + vnew * kk[i]; *(f32x4*)(S1 + (size_t)i * 128) = s1; po += s1 * qq[i]; }
        red[dkg * 32 + dv4] = po;
        __syncthreads();
        if (tid < 32) { f32x4 o = red[dv4];
#pragma unroll
            for (int g = 1; g < 16; ++g) o += red[g * 32 + dv4];
            o = o * QSCALE; float s = dot4(o); s += __shfl_xor(s, 1); s += __shfl_xor(s, 2); s += __shfl_xor(s, 4); s += __shfl_xor(s, 8); s += __shfl_xor(s, 16);
            const float rs = rsqrtf(s * (1.f / 128.f) + EPS); const u32x2 zr = *(const u32x2*)(PROJ + srow * NIN + 1536 + h * 128 + 4 * dv4); const f32x4 gn = *(const f32x4*)(gnorm + 4 * dv4);
            f32x4 m; m.x = o.x * rs * gn.x * siluf_(bflo(zr.x)); m.y = o.y * rs * gn.y * siluf_(bfhi(zr.x)); m.z = o.z * rs * gn.z * siluf_(bflo(zr.y)); m.w = o.w * rs * gn.w * siluf_(bfhi(zr.y));
            st_bf4(MIX + srow * DM + h * 128 + 4 * dv4, m); }
        __syncthreads();
    }
}

__device__ __forceinline__ void phase2_misc(const Params& P, int tid, int lane, int wave, int bid, int G) {
    unsigned char* ws = P.ws; const bf16* PROJ = (const bf16*)(ws + WS_PROJ); bf16* MIX = (bf16*)(ws + WS_MIX);
    { float* NCP = P.out + O_NCP; for (int i = bid * 512 + tid; i < 36864; i += G * 512) { const int b = i / 4608, rem = i - b * 4608, j = rem / 1536, col = rem - j * 1536; NCP[i] = bf2f(PROJ[(size_t)(b * 2048 + 2045 + j) * NIN + col]); } }
    const int gw = bid * 8 + wave;
    if (gw < MSA) { const int bs = gw; const size_t srow = (size_t)MPR + bs; const float* lng = P.in[12]; const float* lnb = P.in[13]; float* NSV = P.out + O_NSV;
        const u32x4 raw = *(const u32x4*)(PROJ + srow * NIN + 2560 + 8 * lane); const u32x4 uraw = *(const u32x4*)(PROJ + srow * NIN + 2048 + 8 * lane);
        float x[8] = {bflo(raw.x), bfhi(raw.x), bflo(raw.y), bfhi(raw.y), bflo(raw.z), bfhi(raw.z), bflo(raw.w), bfhi(raw.w)};
        const float uu[8] = {bflo(uraw.x), bfhi(uraw.x), bflo(uraw.y), bfhi(uraw.y), bflo(uraw.z), bfhi(uraw.z), bflo(uraw.w), bfhi(uraw.w)};
        float s = 0.f;
#pragma unroll
        for (int e = 0; e < 8; ++e) s += x[e];
        const float mean = wave_sum(s) * (1.f / 512.f); float s2 = 0.f;
#pragma unroll
        for (int e = 0; e < 8; ++e) { x[e] -= mean; s2 += x[e] * x[e]; }
        const float rstd = rsqrtf(wave_sum(s2) * (1.f / 512.f) + EPS); const int h = lane >> 4; const float w00 = P.in[14][(size_t)h * 16384], b0 = P.in[15][h * 128];
        float vg[8], sg[8];
#pragma unroll
        for (int e = 0; e < 8; ++e) { vg[e] = x[e] * rstd * lng[8 * lane + e] + lnb[8 * lane + e]; sg[e] = uu[e] * (w00 * vg[e] + b0); }
        *(f32x4*)(NSV + (size_t)bs * 512 + 8 * lane) = (f32x4){vg[0], vg[1], vg[2], vg[3]}; *(f32x4*)(NSV + (size_t)bs * 512 + 8 * lane + 4) = (f32x4){vg[4], vg[5], vg[6], vg[7]};
        u32x4 o; o.x = pk2(sg[0], sg[1]); o.y = pk2(sg[2], sg[3]); o.z = pk2(sg[4], sg[5]); o.w = pk2(sg[6], sg[7]); *(u32x4*)(MIX + srow * DM + 512 + 8 * lane) = o; }
}

constexpr int ST_BYTES = 60416;
__device__ __forceinline__ void glds16(const void* g, LAS unsigned char* l) { __builtin_amdgcn_global_load_lds((const unsigned*)g, (LAS unsigned*)l, 16, 0, 0); }
__device__ __forceinline__ void scan_issue1(const bf16* FRB, const bf16* ATf, const float* DECF, int unit, int sl, LAS unsigned char* L, int lane) {
    const bf16* w = FRB + FR_W + (size_t)unit * 8192 + lane * 8; const bf16* at = ATf + (size_t)unit * 4096 + lane * 8; const bf16* uu = FRB + FR_U + ((size_t)unit * 8 + sl) * 1024 + lane * 8;
#pragma unroll
    for (int f = 0; f < 16; ++f) glds16(w + f * 512, L + f * 1024);
#pragma unroll
    for (int f = 0; f < 8; ++f) glds16(at + f * 512, L + 49152 + f * 1024);
    glds16(uu, L + 57344); glds16(uu + 512, L + 58368);
    glds16(DECF + (size_t)unit * 256 + lane * 4, L + 59392);
}
__device__ __forceinline__ void scan_issue2(const bf16* FRB, int unit, LAS unsigned char* L, int lane) {
    const bf16* qg = FRB + FR_QG + (size_t)unit * 8192 + lane * 8; const bf16* kg = FRB + FR_KG + (size_t)unit * 8192 + lane * 8;
#pragma unroll
    for (int f = 0; f < 16; ++f) glds16(qg + f * 512, L + 16384 + f * 1024);
#pragma unroll
    for (int f = 0; f < 16; ++f) glds16(kg + f * 512, L + 32768 + f * 1024);
}
__device__ __forceinline__ void gdn_scan(const Params& P, LAS unsigned char* lds, volatile LAS unsigned* flg, int lane, int wave, int bid, int G) {
    if (wave > 2) return;
    asm volatile("" : "+v"(lane));
    unsigned char* ws = P.ws; const bf16* FRB = (const bf16*)P.out; const bf16* ATf = (const bf16*)(ws + WS_AT); const float* DECF = (const float*)(ws + WS_DECF);
    bf16* O = (bf16*)(ws + WS_O); float* NGP = P.out + O_NGP; const int c = lane & 15, q = lane >> 4;
    int gs = 0;
    for (int job = bid; job < 256; job += G, gs += 32) {
        const int bh = (job & 7) + 8 * (job >> 6), sl = (job >> 3) & 7, b = bh >> 2, h = bh & 3;
        if (wave != 0) {
            for (int n = 0; n < 32; ++n) {
                const int s_ = gs + n; LAS unsigned char* L = lds + (s_ & 1) * ST_BYTES;
                while ((int)flg[0] < s_ - 1) __builtin_amdgcn_s_sleep(1);
                asm volatile("" ::: "memory");
                if (wave == 1) scan_issue1(FRB, ATf, DECF, (b * 32 + n) * 4 + h, sl, L, lane); else scan_issue2(FRB, (b * 32 + n) * 4 + h, L, lane);
                asm volatile("s_waitcnt vmcnt(0)" ::: "memory");
                if (lane == 0) flg[wave] = (unsigned)(s_ + 1);
                asm volatile("s_waitcnt lgkmcnt(0)" ::: "memory");
            }
            continue;
        }
        f32x4 S[8];
#pragma unroll
        for (int i = 0; i < 8; ++i) S[i] = (f32x4){0.f, 0.f, 0.f, 0.f};
        for (int n = 0; n < 32; ++n) {
            const int s_ = gs + n; LAS unsigned char* L = lds + (s_ & 1) * ST_BYTES;
            while ((int)flg[1] < s_ + 1 || (int)flg[2] < s_ + 1) __builtin_amdgcn_s_sleep(1);
            asm volatile("" ::: "memory");
            bf16x8 Wfr[16], QGfr[16]; u32x2 Ufr[4];
#pragma unroll
            for (int f = 0; f < 16; ++f) Wfr[f] = *(const LAS bf16x8*)(L + f * 1024 + lane * 16);
#pragma unroll
            for (int mt = 0; mt < 4; ++mt) Ufr[mt] = *(const LAS u32x2*)(L + 57344 + mt * 512 + lane * 8);
#pragma unroll
            for (int f = 0; f < 16; ++f) QGfr[f] = *(const LAS bf16x8*)(L + 16384 + f * 1024 + lane * 16);
            __builtin_amdgcn_sched_barrier(0);
            bf16x8 Sb[4];
#pragma unroll
            for (int ks = 0; ks < 4; ++ks) Sb[ks] = pack8(S[2 * ks], S[2 * ks + 1]);
            f32x4 va[4], oa[4];
#pragma unroll
            for (int mt = 0; mt < 4; ++mt) { va[mt] = (f32x4){0.f, 0.f, 0.f, 0.f}; oa[mt] = va[mt]; }
#pragma unroll
            for (int ks = 0; ks < 4; ++ks)
#pragma unroll
                for (int mt = 0; mt < 4; ++mt) va[mt] = mfma16(Wfr[mt * 4 + ks], Sb[ks], va[mt]);
            __builtin_amdgcn_sched_barrier(0);
            bf16x8 ATfr[8];
#pragma unroll
            for (int f = 0; f < 8; ++f) ATfr[f] = *(const LAS bf16x8*)(L + 49152 + f * 1024 + lane * 16);
            const float dec = *(const LAS float*)(L + 59392 + lane * 4);
            __builtin_amdgcn_sched_barrier(0);
#pragma unroll
            for (int ks = 0; ks < 4; ++ks)
#pragma unroll
                for (int mt = 0; mt < 4; ++mt) oa[mt] = mfma16(QGfr[mt * 4 + ks], Sb[ks], oa[mt]);
            __builtin_amdgcn_sched_barrier(0);
            bf16x8 KGfr[16];
#pragma unroll
            for (int f = 0; f < 16; ++f) KGfr[f] = *(const LAS bf16x8*)(L + 32768 + f * 1024 + lane * 16);
            __builtin_amdgcn_sched_barrier(0);
            f32x4 vn[4];
#pragma unroll
            for (int mt = 0; mt < 4; ++mt) vn[mt] = (f32x4){bflo(Ufr[mt].x) - va[mt].x, bfhi(Ufr[mt].x) - va[mt].y, bflo(Ufr[mt].y) - va[mt].z, bfhi(Ufr[mt].y) - va[mt].w};
            bf16x8 vb[2];
#pragma unroll
            for (int k2 = 0; k2 < 2; ++k2) vb[k2] = pack8(vn[2 * k2], vn[2 * k2 + 1]);
#pragma unroll
            for (int mt = 0; mt < 8; ++mt) S[mt] = S[mt] * dec;
#pragma unroll
            for (int k2 = 0; k2 < 2; ++k2) {
#pragma unroll
                for (int mt = 0; mt < 8; ++mt) S[mt] = mfma16(KGfr[mt * 2 + k2], vb[k2], S[mt]);
#pragma unroll
                for (int mt = 0; mt < 4; ++mt) oa[mt] = mfma16(ATfr[mt * 2 + k2], vb[k2], oa[mt]);
            }
#pragma unroll
            for (int mt = 0; mt < 4; ++mt) {
                const bool od = lane & 1; const float t0 = dpp_get<0xB1, 0xF>(od ? oa[mt].x : oa[mt].z), t1 = dpp_get<0xB1, 0xF>(od ? oa[mt].y : oa[mt].w);
                unsigned* op = (unsigned*)(O + ((size_t)(b * 2048 + n * 64 + 16 * mt + 4 * q + (od ? 2 : 0))) * 512 + h * 128 + 16 * sl + (c & ~1));
                op[0] = od ? pk2(t0, oa[mt].z) : pk2(oa[mt].x, t0); op[256] = od ? pk2(t1, oa[mt].w) : pk2(oa[mt].y, t1); }
            asm volatile("s_waitcnt lgkmcnt(0)" ::: "memory");
            if (lane == 0) flg[0] = (unsigned)(s_ + 1);
            asm volatile("" ::: "memory");
        }
#pragma unroll
        for (int mt = 0; mt < 8; ++mt) { float* sp = NGP + ((size_t)(b * 4 + h) * 128 + 16 * mt + 4 * q) * 128 + 16 * sl + c; sp[0] = S[mt].x; sp[128] = S[mt].y; sp[256] = S[mt].z; sp[384] = S[mt].w; }
        asm volatile("s_waitcnt vmcnt(0)" ::: "memory");
    }
}

__device__ __forceinline__ void gdn_gate(const Params& P, int lane, int wave, int bid, int G) {
    unsigned char* ws = P.ws; const bf16* PROJ = (const bf16*)(ws + WS_PROJ); bf16* MIX = (bf16*)(ws + WS_MIX); const bf16* O = (const bf16*)(ws + WS_O); const float* gnorm = P.in[11];
    float gn[8];
#pragma unroll
    for (int e = 0; e < 8; ++e) gn[e] = gnorm[8 * (lane & 15) + e];
    for (int row0 = bid * 8 + wave; row0 < MPR; row0 += G * 32) {
        f32x4 a[4], b[4]; u32x4 zr[4];
#pragma unroll
        for (int u = 0; u < 4; ++u) { const int row = min(row0 + u * G * 8, MPR - 1); const u32x4 orw = *(const u32x4*)(O + (size_t)row * 512 + 8 * lane);
            a[u] = (f32x4){bflo(orw.x), bfhi(orw.x), bflo(orw.y), bfhi(orw.y)}; b[u] = (f32x4){bflo(orw.z), bfhi(orw.z), bflo(orw.w), bfhi(orw.w)};
            zr[u] = *(const u32x4*)(PROJ + (size_t)row * NIN + 1536 + 8 * lane); }
#pragma unroll
        for (int u = 0; u < 4; ++u) { const int row = row0 + u * G * 8;
            float s = dot4(a[u]) + dot4(b[u]); s += dpp_get<0xB1, 0xF>(s); s += dpp_get<0x4E, 0xF>(s); s += dpp_get<0x141, 0xF>(s); s += dpp_get<0x140, 0xF>(s);
            const float rs = rsqrtf(s * (1.f / 128.f) + EPS);
            u32x4 o; o.x = pk2(a[u].x * rs * gn[0] * siluf_(bflo(zr[u].x)), a[u].y * rs * gn[1] * siluf_(bfhi(zr[u].x))); o.y = pk2(a[u].z * rs * gn[2] * siluf_(bflo(zr[u].y)), a[u].w * rs * gn[3] * siluf_(bfhi(zr[u].y)));
            o.z = pk2(b[u].x * rs * gn[4] * siluf_(bflo(zr[u].z)), b[u].y * rs * gn[5] * siluf_(bfhi(zr[u].z))); o.w = pk2(b[u].z * rs * gn[6] * siluf_(bflo(zr[u].w)), b[u].w * rs * gn[7] * siluf_(bfhi(zr[u].w)));
            if (row < MPR) *(u32x4*)(MIX + (size_t)row * DM + 8 * lane) = o; }
    }
}
__device__ __forceinline__ void final_norm(const Params& P, int lane, int wave, int bid, int G) {
    const float* SS3 = (const float*)(P.ws + WS_SS3); const float* gf = P.in[23]; float* out = P.out; const bf16* X3 = (const bf16*)(P.ws + WS_HID);
    f32x4 g4[4];
#pragma unroll
    for (int j = 0; j < 2; ++j) { g4[2 * j] = *(const f32x4*)(gf + 512 * j + 8 * lane); g4[2 * j + 1] = *(const f32x4*)(gf + 512 * j + 8 * lane + 4); }
    for (int row0 = MPR + bid * 8 + wave; row0 < MT; row0 += G * 32) {
        u32x4 v[4][2]; float rs[4];
#pragma unroll
        for (int u = 0; u < 4; ++u) { const int row = min(row0 + u * G * 8, MT - 1); rs[u] = sum16(SS3 + (size_t)row * 16);
#pragma unroll
            for (int j = 0; j < 2; ++j) v[u][j] = *(const u32x4*)(X3 + (size_t)row * DM + 512 * j + 8 * lane); }
#pragma unroll
        for (int u = 0; u < 4; ++u) { const int row = row0 + u * G * 8; const float r = rsqrtf(rs[u] * (1.f / DM) + EPS);
            if (row < MT) {
#pragma unroll
                for (int j = 0; j < 2; ++j) { const u32x4 w = v[u][j]; float* o = out + (size_t)row * DM + 512 * j + 8 * lane;
                    *(f32x4*)o = (f32x4){bflo(w.x), bfhi(w.x), bflo(w.y), bfhi(w.y)} * r * g4[2 * j];
                    *(f32x4*)(o + 4) = (f32x4){bflo(w.z), bfhi(w.z), bflo(w.w), bfhi(w.w)} * r * g4[2 * j + 1]; } } }
    }
}
#define XB_TMO      128
#define XB_XCNT(j)  (256  + 64 * (j))
#define XB_XSUB(j)  (1280 + 64 * (j))
#define XB_XGEN(j)  (2304 + 64 * (j))
#define XB_TOP      3328
#define XB_TOPGEN   3392
#define XCD_BAR_WORDS 3456
#define XB_SPIN_CAP (1u << 18)

__device__ __forceinline__ unsigned xb_ld(unsigned* p)              { return __hip_atomic_load(p, __ATOMIC_RELAXED, __HIP_MEMORY_SCOPE_AGENT); }
__device__ __forceinline__ unsigned xb_add(unsigned* p, unsigned v) { return __hip_atomic_fetch_add(p, v, __ATOMIC_RELAXED, __HIP_MEMORY_SCOPE_AGENT); }
__device__ __forceinline__ unsigned xb_xcc_id() { return (unsigned)__builtin_amdgcn_s_getreg((3 << 11) | 20) & 0xFu; }
#define XB_SPIN(cond, bar) do { unsigned _sp = 0; while (cond) { __builtin_amdgcn_s_sleep(1); \
    if ((++_sp & 255u) == 0u) { if (xb_ld(&(bar)[XB_TMO])) break; if (_sp > XB_SPIN_CAP) { atomicAdd(&(bar)[XB_TMO], 1u); break; } } } } while (0)

struct XcdBarrier {
    unsigned* bar; unsigned x;
    volatile LAS unsigned* st;
};

__device__ __forceinline__ XcdBarrier xcd_barrier_post(unsigned* bar, volatile LAS unsigned* st) {
    XcdBarrier b; b.bar = bar; b.x = xb_xcc_id(); b.st = st;
    if (threadIdx.x == 0) (void)xb_add(&bar[XB_XCNT(b.x)], 1u);
    return b;
}
__device__ __forceinline__ void xcd_barrier_complete(unsigned* bar, unsigned x, unsigned& nloc, unsigned& nx) {
    const unsigned G = gridDim.x * gridDim.y * gridDim.z;
    unsigned sum, cnt, mine, sp = 0u;
    for (;;) {
        sum = 0u; cnt = 0u; mine = 0u;
#pragma unroll
        for (unsigned j = 0; j < 16; ++j) { const unsigned c = xb_ld(&bar[XB_XCNT(j)]); sum += c; cnt += (c > 0u) ? 1u : 0u; mine = (j == x) ? c : mine; }
        if (sum == G) break;
        __builtin_amdgcn_s_sleep(1);
        if ((++sp & 255u) == 0u) { if (xb_ld(&bar[XB_TMO])) break; if (sp > XB_SPIN_CAP) { atomicAdd(&bar[XB_TMO], 1u); break; } }
    }
    nloc = mine > 0u ? mine : 1u; nx = cnt > 0u ? cnt : 1u;
}

__device__ __forceinline__ void xcd_barrier(const XcdBarrier& b) {
    asm volatile("s_waitcnt vmcnt(0)" ::: "memory");
    __syncthreads();
    if (threadIdx.x == 0) {
        unsigned* bar = b.bar;
        __builtin_amdgcn_s_waitcnt(0);
        unsigned nloc = b.st[0], nx = b.st[1];
        if (nloc == 0u) { xcd_barrier_complete(bar, b.x, nloc, nx); b.st[0] = nloc; b.st[1] = nx; }
        const unsigned old = xb_add(&bar[XB_XSUB(b.x)], 1u);
        const unsigned gen = old / nloc;
        if (old + 1u == (gen + 1u) * nloc) {
            __builtin_amdgcn_fence(__ATOMIC_RELEASE, "agent");
            asm volatile("s_waitcnt vmcnt(0)" ::: "memory");
            const unsigned og = xb_add(&bar[XB_TOP], 1u);
            const unsigned tg = og / nx;
            if (og + 1u == (tg + 1u) * nx) xb_add(&bar[XB_TOPGEN], 1u);
            else XB_SPIN(xb_ld(&bar[XB_TOPGEN]) == tg, bar);
            __builtin_amdgcn_fence(__ATOMIC_ACQUIRE, "agent");
            xb_add(&bar[XB_XGEN(b.x)], 1u);
            asm volatile("s_waitcnt vmcnt(0)" ::: "memory");
        } else {
            XB_SPIN(xb_ld(&bar[XB_XGEN(b.x)]) == gen, bar);
            __builtin_amdgcn_fence(__ATOMIC_ACQUIRE, "agent");
            asm volatile("s_waitcnt vmcnt(0)" ::: "memory");
        }
    }
    __syncthreads();
}

__global__ void __launch_bounds__(512, 2) mega_fwd(Params P) {
    extern __shared__ __attribute__((aligned(16))) unsigned char lds_raw[];
    LAS unsigned char* lds = (LAS unsigned char*)lds_raw;
    const int bid = blockIdx.x, G = gridDim.x;
#define FRESH() int tid = threadIdx.x; asm volatile("" : "+v"(tid)); const int lane = tid & 63, wave = __builtin_amdgcn_readfirstlane(tid >> 6), gw = bid * 8 + wave, NGW = G * 8; (void)gw; (void)NGW; (void)lane

    volatile LAS unsigned* st = (volatile LAS unsigned*)(lds + LDS_BYTES - 64);
    if (threadIdx.x < 16) st[threadIdx.x] = 0u;
    __syncthreads();
    unsigned char* ws = P.ws;
    XcdBarrier bar = xcd_barrier_post((unsigned*)(ws + WS_CTL), st);
#define GRID_BAR() xcd_barrier(bar)
    bf16* XB = (bf16*)(ws + WS_XB); bf16* MIX = (bf16*)(ws + WS_MIX); bf16* PROJ = (bf16*)(ws + WS_PROJ); bf16* HID = (bf16*)(ws + WS_HID); bf16* PB = (bf16*)(ws + WS_PB);
    float* SS1 = (float*)(ws + WS_SS1); float* SS2 = (float*)(ws + WS_SS2); float* SS3 = (float*)(ws + WS_SS3);

    { FRESH(); phase0(P, lds, tid, lane, wave, bid, G); }
    GRID_BAR();
    {   FRESH();
        pg8::Gemm g{XB, (const bf16*)(ws + WS_WIN), MPR, NIN, DM}; pg8::StaticOrder S; S.init(MPR, NIN, G, bid);
        EpiGen<F1> E{F1{nullptr, (const float*)(ws + WS_RS0), PROJ}}; EpiGen8<F1> E8{E.f};
        pg8::gemm_phase<EpiGen8<F1>, pg8::StaticOrder, true, true>(lds, g, S, E8);
        small_gemm<2, 4>(XB + (size_t)MPR * DM, (const bf16*)(ws + WS_WIN), NIN, DM, E.f, lds, bid, G, wave, lane);
    }
    GRID_BAR();
    if ((bid & 3) == 1) { FRESH(); sample_gdn(P, lds, tid, lane, wave, bid, G); }
    if ((bid & 3) == 2) { FRESH(); sgu_prompt(P, lds, tid, lane, wave, bid, G); }
    { FRESH(); gdn_prep(P, lds, tid, lane, wave, bid, G); }
    if ((bid & 3) == 3) { FRESH(); sample_gdn(P, lds, tid, lane, wave, bid, G); }
    if ((bid & 3) != 2) { FRESH(); sgu_prompt(P, lds, tid, lane, wave, bid, G); }
    if ((bid & 3) == 0 || (bid & 3) == 2) { FRESH(); sample_gdn(P, lds, tid, lane, wave, bid, G); }
    { FRESH(); phase2_misc(P, tid, lane, wave, bid, G); }
    GRID_BAR();
    { FRESH(); gdn_scan(P, lds, st + 4, lane, wave, bid, G);
      if (wave >= 3 && wave <= 5) weight_items(P, (LAS float*)(lds + 2 * ST_BYTES + (wave - 3) * 8448), lane, 1536, 6784, bid * 3 + (wave - 3), G * 3); }
    GRID_BAR();
    { FRESH(); gdn_gate(P, lane, wave, bid, G); }
    GRID_BAR();
    {   FRESH();
        pg8::Gemm g{MIX, (const bf16*)(ws + WS_WOUT), MPR, DM, DM}; pg8::StaticOrder S; S.init(MPR, DM, G, bid);
        EpiGen<F2> E{F2{SS1, XB}}; EpiGen8<F2> E8{E.f};
        pg8::gemm_phase<EpiGen8<F2>, pg8::StaticOrder, false, true>(lds, g, S, E8);
        small_gemm<1, 8>(MIX + (size_t)MPR * DM, (const bf16*)(ws + WS_WOUT), DM, DM, E.f, lds, bid, G, wave, lane);
    }
    GRID_BAR();
    {   FRESH();
        pg8::Gemm g{XB, (const bf16*)(ws + WS_WUP), MPR, FF, DM}; pg8::StaticOrder S; S.init(MPR, FF, G, bid);
        EpiGen<F3> E{F3{nullptr, SS1, HID}}; EpiGen8<F3> E8{E.f};
        pg8::gemm_phase<EpiGen8<F3>, pg8::StaticOrder, true, true>(lds, g, S, E8);
        small_gemm<2, 4>(XB + (size_t)MPR * DM, (const bf16*)(ws + WS_WUP), FF, DM, E.f, lds, bid, G, wave, lane);
    }
    GRID_BAR();
    {   FRESH();
        pg8::Gemm g{HID, (const bf16*)(ws + WS_WDN), MPR, DM, FF}; pg8::StaticOrder S; S.init(MPR, DM, G, bid);
        EpiGen<F4> E{F4{SS2, XB}}; EpiGen8<F4> E8{E.f};
        pg8::gemm_phase<EpiGen8<F4>, pg8::StaticOrder, false, true>(lds, g, S, E8);
        small_gemm<1, 8>(HID + (size_t)MPR * FF, (const bf16*)(ws + WS_WDN), DM, FF, E.f, lds, bid, G, wave, lane);
    }
    GRID_BAR();
    {   FRESH();
        bf16* PP = MIX;
        { pg8::Gemm g{PB, (const bf16*)(ws + WS_WPLE), MPR, DM, DPLE}; pg8::StaticOrder S; S.init(MPR, DM, G, bid);
          EpiGen<F5a> E{F5a{nullptr, PP}}; EpiGen8<F5a> E8{E.f};
          pg8::gemm_phase<EpiGen8<F5a>, pg8::StaticOrder, false, true>(lds, g, S, E8);
          small_gemm<1, 8>(PB + (size_t)MPR * DPLE, (const bf16*)(ws + WS_WPLE), DM, DPLE, E.f, lds, bid, G, wave, lane); }
        { pg8::Gemm g{XB, (const bf16*)(ws + WS_WG), MPR, DM, DM}; pg8::StaticOrder S; S.init(MPR, DM, G, bid);
          EpiGen<F5b> E{F5b{SS3, SS2, XB, PP, HID}};
          EpiFinal EF{SS2, XB, PP, P.out, P.in[23], (unsigned*)(ws + WS_XBUF), (unsigned*)(ws + WS_CTL + 16384)};
          pg8::gemm_phase<EpiFinal, pg8::StaticOrder, false, true>(lds, g, S, EF);
          small_gemm<1, 8>(XB + (size_t)MPR * DM, (const bf16*)(ws + WS_WG), DM, DM, E.f, lds, bid, G, wave, lane); }
    }
    GRID_BAR();
    { FRESH(); final_norm(P, lane, wave, bid, G); }
}

extern "C" void kernel_launch(void* const* d_in, const int* in_sizes, int n_in, void* d_out, int out_size, void* d_ws, size_t ws_size, hipStream_t stream) {
    static int grid = 0;
    if (grid == 0) {
        int dev = 0, cus = 0;
        if (hipGetDevice(&dev) != hipSuccess || hipDeviceGetAttribute(&cus, hipDeviceAttributeMultiprocessorCount, dev) != hipSuccess) { fprintf(stderr, "kernel_launch: device query failed\n"); grid = -1; return; }
        if (hipFuncSetAttribute((const void*)mega_fwd, hipFuncAttributeMaxDynamicSharedMemorySize, LDS_BYTES) != hipSuccess) { fprintf(stderr, "kernel_launch: hipFuncSetAttribute failed\n"); grid = -1; return; }
        int per_cu = 0;
        if (hipOccupancyMaxActiveBlocksPerMultiprocessor(&per_cu, (const void*)mega_fwd, 512, LDS_BYTES) != hipSuccess || per_cu < 1) fprintf(stderr, "kernel_launch: occupancy query reports %d\n", per_cu);
        (void)hipGetLastError();
        grid = cus < 256 ? cus : 256;
        if (n_in != 24 || ws_size < 256 * MiB) fprintf(stderr, "kernel_launch: unexpected n_in %d / ws %zu\n", n_in, ws_size);
    }
    if (grid < 0) return;
    (void)hipMemsetAsync((char*)d_ws + WS_CTL, 0, CTL_BYTES, stream);
    Params p{};
    for (int i = 0; i < 24; ++i) p.in[i] = (const float*)d_in[i];
    p.out = (float*)d_out; p.ws = (unsigned char*)d_ws;
    hipLaunchKernelGGL(mega_fwd, dim3(grid), dim3(512), LDS_BYTES, stream, p);
}
```
